# Optimizing an MI355X kernel written in HIP

```python
import math
import jax, jax.numpy as jnp
from jax import lax
import numpy as np

D_MODEL = 1024
BATCH = 4
SEQ = 4096
DEPTH = 2

GRID_W = 64
CTX_LEN = 256
GLA_HEADS = 4
GLA_DK = 32
GLA_DV = 64
GLA_GATE_RANK = 16
GLA_GATE_NORM = 16.0
GLA_CHUNK = 64
GQA_HEADS = 8
GQA_KV_HEADS = 2
GQA_GROUP = GQA_HEADS // GQA_KV_HEADS
GQA_HD = 64
DIFF_HEADS = 4
DIFF_QK = 32
DIFF_V = 64

ROPE_THETA = 10000.0
Q_BLOCK = 128
NORM_EPS = 1e-6
MIX_WIDTH = GLA_HEADS * GLA_DV + GQA_HEADS * GQA_HD + DIFF_HEADS * DIFF_V
IN_WIDTHS = (GLA_HEADS * GLA_DK, GLA_HEADS * GLA_DK, GLA_HEADS * GLA_DV, GLA_HEADS * GLA_DV,
             GLA_GATE_RANK, GLA_GATE_RANK,
             GQA_HEADS * GQA_HD, GQA_KV_HEADS * GQA_HD, GQA_KV_HEADS * GQA_HD,
             DIFF_HEADS * 2 * DIFF_QK, DIFF_HEADS * 2 * DIFF_QK, DIFF_HEADS * DIFF_V)
IN_WIDTH = sum(IN_WIDTHS)
D_FF = 2816
N_EXPERTS = 8
TOP_K = 2
D_FF_EXPERT = 3584
N_DENSE = (DEPTH + 1) // 2
N_MOE = DEPTH // 2

kernel_name = "hybrid_gla_gqa_diffattn_moe_dit_block"


def rms_norm(x, w):
    xf = x.astype(jnp.float32)
    y = xf * lax.rsqrt(jnp.mean(xf * xf, axis=-1, keepdims=True) + NORM_EPS)
    return (y * w.astype(jnp.float32)).astype(x.dtype)


def modulate(h, shift, scale):
    return h * (1.0 + scale) + shift


def rope_1d(x, pos):
    L, d = x.shape[1], x.shape[-1]
    half = d // 2
    freqs = ROPE_THETA ** (-jnp.arange(half, dtype=jnp.float32) / half)
    ang = pos[:, None] * freqs[None, :]
    bshape = (L,) + (1,) * (x.ndim - 3) + (half,)
    cos = jnp.cos(ang).reshape(bshape)
    sin = jnp.sin(ang).reshape(bshape)
    x1 = x[..., :half].astype(jnp.float32)
    x2 = x[..., half:].astype(jnp.float32)
    return jnp.concatenate([x1 * cos - x2 * sin, x1 * sin + x2 * cos], axis=-1).astype(x.dtype)


def axial_rope(x, rows, cols):
    d = x.shape[-1]
    return jnp.concatenate([rope_1d(x[..., : d // 2], rows), rope_1d(x[..., d // 2:], cols)], axis=-1)


def gla_chunk_scan(q, k, v, log_a, s0):
    B, L, H, dk = q.shape
    dv = v.shape[-1]
    n = L // GLA_CHUNK

    def chunked(t):
        return t.reshape(B, n, GLA_CHUNK, H, t.shape[-1]).transpose(1, 0, 3, 2, 4).astype(jnp.float32)

    qc, kc, vc, gc = chunked(q * GLA_DK ** -0.5), chunked(k), chunked(v), chunked(log_a)
    b = jnp.cumsum(gc, axis=-2)
    b_last = b[..., -1:, :]
    q_dec = qc * jnp.exp(b)
    causal = jnp.tril(jnp.ones((GLA_CHUNK, GLA_CHUNK), dtype=bool))
    A = jnp.einsum("nbhcd,nbhsd->nbhcs", q_dec, kc * jnp.exp(-b))
    A = jnp.where(causal, A, 0.0)
    o_intra = jnp.einsum("nbhcs,nbhse->nbhce", A, vc)
    kv = jnp.einsum("nbhcd,nbhce->nbhde", kc * jnp.exp(b_last - b), vc)
    decay = jnp.exp(b[..., -1, :])

    def step(S, inp):
        dec, kv_n = inp
        return dec[..., None] * S + kv_n, S

    s_final, s_in = lax.scan(step, s0.astype(jnp.float32), (decay, kv))
    o_inter = jnp.einsum("nbhcd,nbhde->nbhce", q_dec, s_in)
    o = (o_intra + o_inter).transpose(1, 0, 3, 2, 4).reshape(B, L, H, dv)
    return o.astype(v.dtype), s_final


def gla_bidirectional(q, k, v, la_f, la_b, s0_f, s0_b):
    o_f, s_f = gla_chunk_scan(q, k, v, la_f, s0_f)
    flip = lambda t: jnp.flip(t, axis=1)
    o_b, s_b = gla_chunk_scan(flip(q), flip(k), flip(v), flip(la_b), s0_b)
    return o_f + flip(o_b), s_f, s_b


def gqa_attend(q, k, v):
    s = jnp.einsum("bqkgd,bskd->bkgqs", q, k).astype(jnp.float32) * q.shape[-1] ** -0.5
    p = jax.nn.softmax(s, axis=-1).astype(v.dtype)
    return jnp.einsum("bkgqs,bskd->bqkgd", p, v)


def diff_attend(q, k, v, lam):
    s = jnp.einsum("bqhmd,bshmd->bhmqs", q, k).astype(jnp.float32) * q.shape[-1] ** -0.5
    p = jax.nn.softmax(s, axis=-1)
    p = p[:, :, 0] - lam * p[:, :, 1]
    return jnp.einsum("bhqs,bshd->bqhd", p.astype(v.dtype), v)


def sweep_query_blocks(attend, q):
    B, L = q.shape[:2]
    nb = L // Q_BLOCK
    qb = jnp.moveaxis(q.reshape((B, nb, Q_BLOCK) + q.shape[2:]), 1, 0)
    ob = lax.map(attend, qb)
    return jnp.moveaxis(ob, 0, 1).reshape((B, L) + ob.shape[3:])


def swiglu(h, w_gate, w_up, w_down):
    return (jax.nn.silu(h @ w_gate) * (h @ w_up)) @ w_down


def moe_swiglu(h, w_router, w_gate, w_up, w_down):
    logits = (h @ w_router).astype(jnp.float32)
    top_v, top_i = lax.top_k(logits, TOP_K)
    top_w = jax.nn.softmax(top_v, axis=-1)
    combine = jnp.sum(jax.nn.one_hot(top_i, N_EXPERTS, dtype=jnp.float32) * top_w[..., None], axis=-2)
    combine = combine.astype(h.dtype)
    out = jnp.zeros_like(h)
    for e in range(N_EXPERTS):
        out = out + combine[..., e:e + 1] * swiglu(h, w_gate[e], w_up[e], w_down[e])
    return out


def hybrid_mixer(h, hc, rows, cols, w_in, w_out, gla_a2_f, gla_ab_f, gla_a2_b, gla_ab_b, gla_norm,
                 q_norm, k_norm, lq1, lk1, lq2, lk2, diff_norm, lambda_init, need_ctx_out):
    splits = [int(s) for s in np.cumsum(IN_WIDTHS)[:-1]]
    P = jnp.split(h @ w_in, splits, axis=-1)
    Pc = jnp.split(hc @ w_in, splits, axis=-1)
    heads = lambda t, *shape: t.reshape(t.shape[:2] + shape)

    def gla_in(p):
        q = heads(p[0], GLA_HEADS, GLA_DK)
        k = heads(p[1], GLA_HEADS, GLA_DK)
        v = heads(p[2], GLA_HEADS, GLA_DV)
        la_f = heads(jax.nn.log_sigmoid(p[4] @ gla_a2_f + gla_ab_f) / GLA_GATE_NORM, GLA_HEADS, GLA_DK)
        la_b = heads(jax.nn.log_sigmoid(p[5] @ gla_a2_b + gla_ab_b) / GLA_GATE_NORM, GLA_HEADS, GLA_DK)
        return q, k, v, la_f, la_b

    zero_state = jnp.zeros((hc.shape[0], GLA_HEADS, GLA_DK, GLA_DV), jnp.float32)
    gla_c, s_f, s_b = gla_bidirectional(*gla_in(Pc), zero_state, zero_state)
    gla_l, _, _ = gla_bidirectional(*gla_in(P), s_f, s_b)
    gla_out = lambda o, r: rms_norm(o, gla_norm).reshape(r.shape) * jax.nn.silu(r)

    def gqa_in(p, rope):
        q = rms_norm(heads(p[6], GQA_KV_HEADS, GQA_GROUP, GQA_HD), q_norm)
        k = rms_norm(heads(p[7], GQA_KV_HEADS, GQA_HD), k_norm)
        v = heads(p[8], GQA_KV_HEADS, GQA_HD)
        if rope:
            q, k = axial_rope(q, rows, cols), axial_rope(k, rows, cols)
        return q, k, v

    gq, gk, gv = gqa_in(P, True)
    gqc, gkc, gvc = gqa_in(Pc, False)
    gk_all = jnp.concatenate([gk, gkc], axis=1)
    gv_all = jnp.concatenate([gv, gvc], axis=1)
    gqa_l = sweep_query_blocks(lambda qb: gqa_attend(qb, gk_all, gv_all), gq)
    gqa_l = gqa_l.reshape(gqa_l.shape[:2] + (-1,))

    lam = (jnp.exp(jnp.sum((lq1 * lk1).astype(jnp.float32)))
           - jnp.exp(jnp.sum((lq2 * lk2).astype(jnp.float32))) + lambda_init)

    def diff_in(p, rope):
        q = heads(p[9], DIFF_HEADS, 2, DIFF_QK)
        k = heads(p[10], DIFF_HEADS, 2, DIFF_QK)
        v = heads(p[11], DIFF_HEADS, DIFF_V)
        if rope:
            q, k = axial_rope(q, rows, cols), axial_rope(k, rows, cols)
        return q, k, v

    dq, dk, dv = diff_in(P, True)
    dqc, dkc, dvc = diff_in(Pc, False)
    dk_all = jnp.concatenate([dk, dkc], axis=1)
    dv_all = jnp.concatenate([dv, dvc], axis=1)
    diff_l = sweep_query_blocks(lambda qb: diff_attend(qb, dk_all, dv_all, lam), dq)
    diff_out = lambda o: (rms_norm(o, diff_norm) * (1.0 - lambda_init)).reshape(o.shape[:2] + (-1,))

    y = jnp.concatenate([gla_out(gla_l, P[3]), gqa_l, diff_out(diff_l)], axis=-1) @ w_out
    yc = None
    if need_ctx_out:
        gqa_c = gqa_attend(gqc, gkc, gvc)
        gqa_c = gqa_c.reshape(gqa_c.shape[:2] + (-1,))
        diff_c = diff_attend(dqc, dkc, dvc, lam)
        yc = jnp.concatenate([gla_out(gla_c, Pc[3]), gqa_c, diff_out(diff_c)], axis=-1) @ w_out
    return y, yc


def setup_inputs(seed: int = 0) -> dict:
    key = jax.random.key(seed)
    ks = iter(jax.random.split(key, 40))
    nrm = lambda shape, scale: jax.random.normal(next(ks), shape, jnp.float32) * scale
    gain = lambda shape: 1.0 + nrm(shape, 0.02)
    D = D_MODEL
    return {
        "x": nrm((BATCH, SEQ, D), 1.0),
        "c": nrm((BATCH, D), 1.0),
        "ctx": nrm((BATCH, CTX_LEN, D), 1.0),
        "c_ctx": nrm((D,), 1.0),
        "w_mod": nrm((DEPTH, D, 6 * D), 0.5 * D ** -0.5),
        "b_mod": nrm((DEPTH, 6 * D), 0.02),
        "norm_mix": gain((DEPTH, D)),
        "norm_ffn": gain((DEPTH, D)),
        "w_in": nrm((DEPTH, D, IN_WIDTH), D ** -0.5),
        "w_out": nrm((DEPTH, MIX_WIDTH, D), MIX_WIDTH ** -0.5),
        "gla_a2_f": nrm((DEPTH, GLA_GATE_RANK, GLA_HEADS * GLA_DK), GLA_GATE_RANK ** -0.5),
        "gla_ab_f": nrm((DEPTH, GLA_HEADS * GLA_DK), 0.1),
        "gla_a2_b": nrm((DEPTH, GLA_GATE_RANK, GLA_HEADS * GLA_DK), GLA_GATE_RANK ** -0.5),
        "gla_ab_b": nrm((DEPTH, GLA_HEADS * GLA_DK), 0.1),
        "gla_norm": gain((DEPTH, GLA_DV)),
        "gqa_q_norm": gain((DEPTH, GQA_HD)),
        "gqa_k_norm": gain((DEPTH, GQA_HD)),
        "diff_lam_q1": nrm((DEPTH, DIFF_QK), 0.1),
        "diff_lam_k1": nrm((DEPTH, DIFF_QK), 0.1),
        "diff_lam_q2": nrm((DEPTH, DIFF_QK), 0.1),
        "diff_lam_k2": nrm((DEPTH, DIFF_QK), 0.1),
        "diff_norm": gain((DEPTH, DIFF_V)),
        "ffn_gate": nrm((N_DENSE, D, D_FF), D ** -0.5),
        "ffn_up": nrm((N_DENSE, D, D_FF), D ** -0.5),
        "ffn_down": nrm((N_DENSE, D_FF, D), D_FF ** -0.5),
        "moe_router": nrm((N_MOE, D, N_EXPERTS), D ** -0.5),
        "moe_gate": nrm((N_MOE, N_EXPERTS, D, D_FF_EXPERT), D ** -0.5),
        "moe_up": nrm((N_MOE, N_EXPERTS, D, D_FF_EXPERT), D ** -0.5),
        "moe_down": nrm((N_MOE, N_EXPERTS, D_FF_EXPERT, D), D_FF_EXPERT ** -0.5),
        "norm_f": gain((D,)),
    }


def reference(x, c, ctx, c_ctx, w_mod, b_mod, norm_mix, norm_ffn, w_in, w_out,
              gla_a2_f, gla_ab_f, gla_a2_b, gla_ab_b, gla_norm, gqa_q_norm, gqa_k_norm,
              diff_lam_q1, diff_lam_k1, diff_lam_q2, diff_lam_k2, diff_norm,
              ffn_gate, ffn_up, ffn_down, moe_router, moe_gate, moe_up, moe_down, norm_f):
    L = x.shape[1]
    ROWS = L // GRID_W
    rows = jnp.repeat(jnp.arange(ROWS, dtype=jnp.float32), GRID_W)
    cols = jnp.tile(jnp.arange(GRID_W, dtype=jnp.float32), ROWS)
    xc = ctx
    for l in range(DEPTH):
        need_ctx = l < DEPTH - 1
        mod = jax.nn.silu(c) @ w_mod[l] + b_mod[l]
        mod_c = jax.nn.silu(c_ctx) @ w_mod[l] + b_mod[l]
        sh_a, sc_a, g_a, sh_f, sc_f, g_f = jnp.split(mod[:, None, :], 6, axis=-1)
        csh_a, csc_a, cg_a, csh_f, csc_f, cg_f = jnp.split(mod_c, 6, axis=-1)

        h = modulate(rms_norm(x, norm_mix[l]), sh_a, sc_a)
        hc = modulate(rms_norm(xc, norm_mix[l]), csh_a, csc_a)
        y, yc = hybrid_mixer(h, hc, rows, cols, w_in[l], w_out[l],
                             gla_a2_f[l], gla_ab_f[l], gla_a2_b[l], gla_ab_b[l], gla_norm[l],
                             gqa_q_norm[l], gqa_k_norm[l],
                             diff_lam_q1[l], diff_lam_k1[l], diff_lam_q2[l], diff_lam_k2[l], diff_norm[l],
                             0.8 - 0.6 * math.exp(-0.3 * l), need_ctx)
        x = x + g_a * y

        i = l // 2
        if l % 2 == 0:
            ffn = lambda t: swiglu(t, ffn_gate[i], ffn_up[i], ffn_down[i])
        else:
            ffn = lambda t: moe_swiglu(t, moe_router[i], moe_gate[i], moe_up[i], moe_down[i])
        x = x + g_f * ffn(modulate(rms_norm(x, norm_ffn[l]), sh_f, sc_f))
        if need_ctx:
            xc = xc + cg_a * yc
            xc = xc + cg_f * ffn(modulate(rms_norm(xc, norm_ffn[l]), csh_f, csc_f))
    return rms_norm(x, norm_f)
```

```cpp
#include <hip/hip_runtime.h>
#include <cstdio>
#include <cstdint>
#include <cmath>

#ifndef MK_ONE_LAUNCH
#define MK_ONE_LAUNCH 0
#endif

constexpr int D = 1024, NB = 4, SEQ = 4096, CTXL = 256;
constexpr int MLAT = NB * SEQ, MCTX = NB * CTXL, MT = MLAT + MCTX;
constexpr int LK = SEQ + CTXL;
constexpr int NP = 2560;
constexpr int INW = 2336;
constexpr int DFF = 2816, NE = 8, DFFE = 3584;
constexpr int MOE_ROWS = 34816;
constexpr int NCH = 68;
constexpr float EPS = 1e-6f;
constexpr float LOG2E = 1.4426950408889634f;
constexpr int PC_GLQ = 0, PC_GLK = 128, PC_GLV = 256, PC_GLR = 512, PC_ZF = 768, PC_ZB = 896, PC_GQ = 1024, PC_GK = 1536, PC_GV = 1664, PC_DQ = 1792, PC_DK = 2048, PC_DV = 2304;

__device__ __forceinline__ int ltid() { int t = threadIdx.x; asm volatile("" : "+v"(t)); return t; }

namespace pg8 {
#define PG8_LAS __attribute__((address_space(3)))
typedef unsigned short bf16_t;
typedef short bf16x8 __attribute__((ext_vector_type(8)));
typedef float f32x4 __attribute__((ext_vector_type(4)));
typedef unsigned u32x4 __attribute__((ext_vector_type(4)));
constexpr int BM = 256, BK = 64, HALF = 128, HTB = HALF * BK * 2  , STAGE_BYTES = 8 * HTB, NXCD = 8, WGM = 8;

__host__ __device__ __forceinline__ int lds_byte(int r, int c) { const int st = (r >> 4) * 2 + (c >> 5), rr = r & 15, cc = c & 31, ob = rr * 64 + cc * 2; return st * 1024 + (ob ^ (((ob >> 9) & 1) << 5)); }
__host__ __device__ __forceinline__ void stage_rc(int b, int& R, int& C) { const int st = b / 1024, sb = b % 1024, swz = sb ^ (((sb >> 9) & 1) << 5); R = (st >> 1) * 16 + swz / 64; C = (st & 1) * 32 + (swz % 64) / 2; }
__host__ __device__ __forceinline__ int perm32(int rho) { const int n = rho >> 4, i = rho & 15; return 8 * (i >> 2) + 4 * n + (i & 3); }

struct Unit { int pm, pn; };
struct Gemm { const bf16_t* A; const bf16_t* Bt; int M, N, K; };

struct StaticOrder {
    int nM, nN, nwg, G, c;
    __host__ __device__ void init(int M, int N, int G_, int c_) { nM = M / BM; nN = N / BM; nwg = nM * nN; G = G_; c = c_; }
    __host__ __device__ bool next(int i, Unit& u) const {
        const long L = (long)i * G + c; if (L >= nwg) return false;
        int wgid = (int)L; { const int q = nwg / NXCD, r = nwg % NXCD, xcd = wgid % NXCD, off = wgid / NXCD; wgid = (xcd < r ? xcd * (q + 1) : r * (q + 1) + (xcd - r) * q) + off; }
        const int nig = WGM * nN, gid = wgid / nig, fm = gid * WGM, gsz = (nM - fm) < WGM ? (nM - fm) : WGM;
        u.pm = fm + ((wgid % nig) % gsz); u.pn = (wgid % nig) / gsz; return true;
    }
    __device__ __forceinline__ void a_ready(const Unit&) const {}
    __device__ __forceinline__ void done(const Unit&) const {}
};


__device__ __forceinline__ unsigned cvt_pk_bf16(float lo, float hi) { unsigned r; asm volatile("v_cvt_pk_bf16_f32 %0, %1, %2" : "=v"(r) : "v"(lo), "v"(hi)); return r; }

struct EpiStoreBf16 {
    static constexpr bool PERM = true, AFTER_DRAIN = false;
    bf16_t* O; int ldc;
    __device__ __forceinline__ void operator()(const f32x4 (&acc)[2][2][4][2], const Unit& u, int wr, int wc, int fr, int fq) const {
        const int row0 = u.pm * BM + wr * 64 + fr, col0 = u.pn * BM + wc * 32 + 8 * fq;
#pragma unroll
        for (int ai = 0; ai < 2; ++ai)
#pragma unroll
            for (int m = 0; m < 4; ++m) { bf16_t* rowp = O + (size_t)(row0 + ai * HALF + m * 16) * ldc + col0;
#pragma unroll
                for (int bj = 0; bj < 2; ++bj) { const f32x4 v0 = acc[ai][bj][m][0], v1 = acc[ai][bj][m][1];
                    u32x4 w; w.x = cvt_pk_bf16(v0[0], v0[1]); w.y = cvt_pk_bf16(v0[2], v0[3]); w.z = cvt_pk_bf16(v1[0], v1[1]); w.w = cvt_pk_bf16(v1[2], v1[3]);
                    *(u32x4*)(rowp + bj * HALF) = w; } }
    }
};

struct EpiResid {
    static constexpr bool PERM = false, AFTER_DRAIN = false;
    const float* base_lat; const float* base_ctx; float* out_lat; float* out_ctx; const float* gate;
    __device__ __forceinline__ void operator()(const f32x4 (&acc)[2][2][4][2], const Unit& u, int wr, int wc, int fr, int fq) const {
        const int r0 = u.pm * BM; const bool isctx = r0 >= 16384; const int bidx = isctx ? 4 : (r0 >> 12);
        const float* base = isctx ? base_ctx + (size_t)(r0 - 16384) * 1024 : base_lat + (size_t)r0 * 1024;
        float* out = isctx ? out_ctx + (size_t)(r0 - 16384) * 1024 : out_lat + (size_t)r0 * 1024;
        const int col0 = u.pn * BM + wc * 32 + 4 * fq;
        const float* g = gate + bidx * 6144 + col0;
        f32x4 gv[2][2];
#pragma unroll
        for (int bj = 0; bj < 2; ++bj)
#pragma unroll
            for (int n = 0; n < 2; ++n) gv[bj][n] = *(const f32x4*)(g + bj * HALF + n * 16);
#pragma unroll
        for (int ai = 0; ai < 2; ++ai)
#pragma unroll
            for (int m = 0; m < 4; ++m) { const size_t off = (size_t)(ai * HALF + wr * 64 + m * 16 + fr) * 1024 + col0;
#pragma unroll
                for (int bj = 0; bj < 2; ++bj)
#pragma unroll
                    for (int n = 0; n < 2; ++n) { const f32x4 bs = *(const f32x4*)(base + off + bj * HALF + n * 16);
                        *(f32x4*)(out + off + bj * HALF + n * 16) = bs + gv[bj][n] * acc[ai][bj][m][n]; }
                if (m & 1) asm volatile("" ::: "memory"); }
    }
};

__device__ __forceinline__ float silu_mul(float g, float up) { const float e = __builtin_amdgcn_exp2f(-g * 1.4426950408889634f); return g * __builtin_amdgcn_rcpf(1.0f + e) * up; }

struct EpiSwiGLU {
    static constexpr bool PERM = true, AFTER_DRAIN = false;
    bf16_t* O; int ldc; int nN;
    __device__ __forceinline__ void operator()(const f32x4 (&acc)[2][2][4][2], const Unit& u, int wr, int wc, int fr, int fq) const {
        const int pnr = nN ? (u.pn % nN) : u.pn;
        const int row0 = u.pm * BM + wr * 64 + fr, col0 = pnr * HALF + wc * 32 + 8 * fq;
#pragma unroll
        for (int ai = 0; ai < 2; ++ai)
#pragma unroll
            for (int m = 0; m < 4; ++m) { bf16_t* rowp = O + (size_t)(row0 + ai * HALF + m * 16) * ldc + col0;
                const f32x4 g0 = acc[ai][0][m][0], g1 = acc[ai][0][m][1], u0 = acc[ai][1][m][0], u1 = acc[ai][1][m][1];
                u32x4 w; w.x = cvt_pk_bf16(silu_mul(g0[0], u0[0]), silu_mul(g0[1], u0[1])); w.y = cvt_pk_bf16(silu_mul(g0[2], u0[2]), silu_mul(g0[3], u0[3]));
                w.z = cvt_pk_bf16(silu_mul(g1[0], u1[0]), silu_mul(g1[1], u1[1])); w.w = cvt_pk_bf16(silu_mul(g1[2], u1[2]), silu_mul(g1[3], u1[3]));
                *(u32x4*)rowp = w; }
    }
};

struct EpiMoeDown {
    static constexpr bool PERM = true, AFTER_DRAIN = false;
    bf16_t* O; const float* roww; int nN;
    __device__ __forceinline__ void operator()(const f32x4 (&acc)[2][2][4][2], const Unit& u, int wr, int wc, int fr, int fq) const {
        const int pnr = u.pn % nN;
        const int row0 = u.pm * BM + wr * 64 + fr, col0 = pnr * BM + wc * 32 + 8 * fq;
#pragma unroll
        for (int ai = 0; ai < 2; ++ai)
#pragma unroll
            for (int m = 0; m < 4; ++m) { const int row = row0 + ai * HALF + m * 16; const float wgt = roww[row]; bf16_t* rowp = O + (size_t)row * 1024 + col0;
#pragma unroll
                for (int bj = 0; bj < 2; ++bj) { const f32x4 v0 = acc[ai][bj][m][0] * wgt, v1 = acc[ai][bj][m][1] * wgt;
                    u32x4 w; w.x = cvt_pk_bf16(v0[0], v0[1]); w.y = cvt_pk_bf16(v0[2], v0[3]); w.z = cvt_pk_bf16(v1[0], v1[1]); w.w = cvt_pk_bf16(v1[2], v1[3]);
                    *(u32x4*)(rowp + bj * HALF) = w; } }
    }
};

struct MoeOrder {
    StaticOrder so; const int* panel_e; int nN;
    __device__ void init(int np, int nN_, int G_, int c_, const int* pe) { so.init(np * BM, nN_ * BM, G_, c_); panel_e = pe; nN = nN_; }
    __device__ bool next(int i, Unit& u) const { if (!so.next(i, u)) return false; u.pn += panel_e[u.pm] * nN; return true; }
    __device__ __forceinline__ void a_ready(const Unit&) const {}
    __device__ __forceinline__ void done(const Unit&) const {}
};
template <class Epi, class Sched, bool ALIGN_EPI = false, bool SP2 = false>
__device__ __forceinline__ void gemm_phase(PG8_LAS unsigned char* lds, const Gemm g, const Sched& S, const Epi& E) {
    const int tid = ltid(), wid = __builtin_amdgcn_readfirstlane(tid >> 6), lane = tid & 63, wr = wid >> 2, wc = wid & 3, fr = lane & 15, fq = lane >> 4;
    const int K = g.K, nt = K / BK;
    unsigned voffA[2], voffB[2];
#pragma unroll
    for (int i = 0; i < 2; ++i) { int R, C; stage_rc(tid * 16 + i * 8192, R, C); const int Rb = Epi::PERM ? ((R & ~31) + perm32(R & 31)) : R;
        voffA[i] = (unsigned)(R * K + C) * 2u; voffB[i] = (unsigned)(Rb * K + C) * 2u; }
    const size_t kstep = (size_t)(BK * 2);
    const size_t hstep = (size_t)HALF * K * 2;
    const size_t tstep = 2 * hstep;
    const unsigned ldsw = (unsigned)wid * 1024u;
    const int aoff = lds_byte(wr * 64 + fr, fq * 8), boff = lds_byte(wc * 32 + fr, fq * 8);
#define PG8_SA(b, h) (((b) * 2 + (h)) * HTB)
#define PG8_SB(b, h) ((4 + (b) * 2 + (h)) * HTB)
#define PG8_STAGE(bufoff, gbase, voff) do { _Pragma("unroll") for (int _i = 0; _i < 2; ++_i) \
        __builtin_amdgcn_global_load_lds((const unsigned*)((const char*)(gbase) + (voff)[_i]), (PG8_LAS unsigned*)(lds + (bufoff) + ldsw + _i * 8192), 16, 0, 0); } while (0)
#define PG8_LDA(dst, b, h) do { _Pragma("unroll") for (int m = 0; m < 4; ++m) _Pragma("unroll") for (int k = 0; k < 2; ++k) dst[m][k] = *(const PG8_LAS bf16x8*)(lds + PG8_SA(b, h) + aoff + m * 2048 + k * 1024); } while (0)
#define PG8_LDB(dst, b, h) do { _Pragma("unroll") for (int n = 0; n < 2; ++n) _Pragma("unroll") for (int k = 0; k < 2; ++k) dst[n][k] = *(const PG8_LAS bf16x8*)(lds + PG8_SB(b, h) + boff + n * 2048 + k * 1024); } while (0)
#define PG8_MMA(ai, bj, At, Bt) do { __builtin_amdgcn_s_setprio(1); _Pragma("unroll") for (int m = 0; m < 4; ++m) _Pragma("unroll") for (int n = 0; n < 2; ++n) _Pragma("unroll") for (int k = 0; k < 2; ++k) \
        acc[ai][bj][m][n] = __builtin_amdgcn_mfma_f32_16x16x32_bf16(Bt[n][k], At[m][k], acc[ai][bj][m][n], 0, 0, 0); __builtin_amdgcn_s_setprio(0); } while (0)
#define PG8_WAIT_V(n) asm volatile("s_waitcnt vmcnt(" #n ")" ::: "memory")
#define PG8_WAIT_L(n) asm volatile("s_waitcnt lgkmcnt(" #n ")" ::: "memory")
#define PG8_BAR __builtin_amdgcn_s_barrier()
#define PG8_SCHED __builtin_amdgcn_sched_barrier(0)
    Unit cur, nxt; int ui = 0;
    if (!S.next(0, cur)) return;
    f32x4 acc[2][2][4][2];
#pragma unroll
    for (int a = 0; a < 2; ++a)
#pragma unroll
        for (int b = 0; b < 2; ++b)
#pragma unroll
            for (int m = 0; m < 4; ++m)
#pragma unroll
                for (int n = 0; n < 2; ++n) acc[a][b][m][n] = (f32x4){0.f, 0.f, 0.f, 0.f};
    bf16x8 At[4][2], B0[2][2], B1[2][2];
    const char* cA = (const char*)g.A + (size_t)cur.pm * tstep; const char* cB = (const char*)g.Bt + (size_t)cur.pn * tstep;
    S.a_ready(cur);
    if constexpr (SP2) {
        PG8_STAGE(PG8_SB(0, 0), cB, voffB); PG8_STAGE(PG8_SB(0, 1), cB + hstep, voffB); PG8_STAGE(PG8_SA(0, 0), cA, voffA); PG8_STAGE(PG8_SA(0, 1), cA + hstep, voffA);
        if (wr == 1) PG8_BAR;
        PG8_WAIT_V(2); PG8_BAR;
        PG8_STAGE(PG8_SB(1, 0), cB + kstep, voffB); PG8_STAGE(PG8_SA(1, 0), cA + kstep, voffA); PG8_STAGE(PG8_SB(1, 1), cB + hstep + kstep, voffB);
        PG8_WAIT_V(6); PG8_BAR;
    } else {
        PG8_STAGE(PG8_SB(0, 0), cB, voffB); PG8_STAGE(PG8_SA(0, 0), cA, voffA); PG8_STAGE(PG8_SB(0, 1), cB + hstep, voffB); PG8_STAGE(PG8_SA(0, 1), cA + hstep, voffA);
        if (wr == 1) PG8_BAR;
        PG8_WAIT_V(4); PG8_BAR;
        PG8_STAGE(PG8_SB(1, 0), cB + kstep, voffB); PG8_STAGE(PG8_SA(1, 0), cA + kstep, voffA); PG8_STAGE(PG8_SB(1, 1), cB + hstep + kstep, voffB);
        PG8_WAIT_V(6); PG8_BAR;
    }
    for (;;) {
        const bool has_next = S.next(ui + 1, nxt);
        const char* nA = has_next ? (const char*)g.A + (size_t)nxt.pm * tstep : cA; const char* nB = has_next ? (const char*)g.Bt + (size_t)nxt.pn * tstep : cB;
        for (int t = 0; t < nt; t += 2) {
            const bool last = (t == nt - 2);
            const char* a1 = cA + (size_t)(t + 1) * kstep;
            const char* a2 = last ? nA : cA + (size_t)(t + 2) * kstep; const char* b2 = last ? nB : cB + (size_t)(t + 2) * kstep;
            const char* a3 = a2 + kstep; const char* b3 = b2 + kstep;
            if (last && has_next) S.a_ready(nxt);
            if constexpr (SP2) {
            PG8_LDB(B0, 0, 0); PG8_LDB(B1, 0, 1); PG8_SCHED; PG8_LDA(At, 0, 0); PG8_STAGE(PG8_SA(1, 1), a1 + hstep, voffA);
            PG8_WAIT_V(8); PG8_WAIT_L(0); PG8_BAR; PG8_MMA(0, 0, At, B0); PG8_MMA(0, 1, At, B1); PG8_BAR; PG8_SCHED;
            PG8_LDA(At, 0, 1); PG8_STAGE(PG8_SB(0, 0), b2, voffB); PG8_STAGE(PG8_SB(0, 1), b2 + hstep, voffB); PG8_STAGE(PG8_SA(0, 0), a2, voffA);
            PG8_WAIT_V(8); PG8_WAIT_L(0); PG8_BAR; PG8_MMA(1, 0, At, B0); PG8_MMA(1, 1, At, B1); PG8_BAR; PG8_SCHED;
            PG8_LDB(B0, 1, 0); PG8_LDB(B1, 1, 1); PG8_SCHED; PG8_LDA(At, 1, 0); PG8_STAGE(PG8_SA(0, 1), a2 + hstep, voffA);
            PG8_WAIT_V(8); PG8_WAIT_L(0); PG8_BAR; PG8_MMA(0, 0, At, B0); PG8_MMA(0, 1, At, B1); PG8_BAR; PG8_SCHED;
            PG8_LDA(At, 1, 1); PG8_STAGE(PG8_SB(1, 0), b3, voffB); PG8_STAGE(PG8_SB(1, 1), b3 + hstep, voffB); PG8_STAGE(PG8_SA(1, 0), a3, voffA);
            PG8_WAIT_V(8); PG8_WAIT_L(0); PG8_BAR; PG8_MMA(1, 0, At, B0); PG8_MMA(1, 1, At, B1); PG8_BAR; PG8_SCHED;
            } else {
            PG8_LDB(B0, 0, 0); PG8_SCHED; PG8_LDA(At, 0, 0); PG8_STAGE(PG8_SA(1, 1), a1 + hstep, voffA);
            PG8_WAIT_L(8); PG8_BAR; PG8_WAIT_L(0); PG8_MMA(0, 0, At, B0); PG8_BAR; PG8_SCHED;
            PG8_LDB(B1, 0, 1); PG8_STAGE(PG8_SB(0, 0), b2, voffB);
            PG8_BAR; PG8_WAIT_L(0); PG8_MMA(0, 1, At, B1); PG8_BAR;
            PG8_LDA(At, 0, 1); PG8_STAGE(PG8_SA(0, 0), a2, voffA);
            PG8_BAR; PG8_WAIT_L(0); PG8_MMA(1, 0, At, B0); PG8_BAR; PG8_SCHED;
            PG8_STAGE(PG8_SB(0, 1), b2 + hstep, voffB);
            PG8_WAIT_V(6); PG8_BAR; PG8_MMA(1, 1, At, B1); PG8_BAR;
            PG8_LDB(B0, 1, 0); PG8_SCHED; PG8_LDA(At, 1, 0); PG8_STAGE(PG8_SA(0, 1), a2 + hstep, voffA);
            PG8_WAIT_L(8); PG8_BAR; PG8_WAIT_L(0); PG8_MMA(0, 0, At, B0); PG8_BAR; PG8_SCHED;
            PG8_LDB(B1, 1, 1); PG8_STAGE(PG8_SB(1, 0), b3, voffB);
            PG8_BAR; PG8_WAIT_L(0); PG8_MMA(0, 1, At, B1); PG8_BAR;
            PG8_LDA(At, 1, 1); PG8_STAGE(PG8_SA(1, 0), a3, voffA);
            PG8_BAR; PG8_WAIT_L(0); PG8_MMA(1, 0, At, B0); PG8_BAR; PG8_SCHED;
            PG8_STAGE(PG8_SB(1, 1), b3 + hstep, voffB);
            PG8_WAIT_V(6); PG8_BAR; PG8_MMA(1, 1, At, B1); PG8_BAR;
            }
        }
        if constexpr (ALIGN_EPI) { if (wr == 0) PG8_BAR; }
        if constexpr (!Epi::AFTER_DRAIN) { E(acc, cur, wr, wc, fr, fq); S.done(cur); }
        if (!has_next) break;
#pragma unroll
        for (int a = 0; a < 2; ++a)
#pragma unroll
            for (int b = 0; b < 2; ++b)
#pragma unroll
                for (int m = 0; m < 4; ++m)
#pragma unroll
                    for (int n = 0; n < 2; ++n) acc[a][b][m][n] = (f32x4){0.f, 0.f, 0.f, 0.f};
        cur = nxt; cA = nA; cB = nB; ++ui;
        if constexpr (ALIGN_EPI) { if (wr == 1) PG8_BAR; }
    }
    PG8_WAIT_V(0);
    if constexpr (!ALIGN_EPI) { if (wr == 0) PG8_BAR; }
    PG8_BAR;
    if constexpr (Epi::AFTER_DRAIN) { E.fused(acc, cur, wr, wc, fr, fq, lds, wid, lane); S.done(cur); }
#undef PG8_SA
#undef PG8_SB
#undef PG8_STAGE
#undef PG8_LDA
#undef PG8_LDB
#undef PG8_MMA
#undef PG8_WAIT_V
#undef PG8_WAIT_L
#undef PG8_BAR
#undef PG8_SCHED
}

template <class Epi, class Sched>
__device__ __forceinline__ void gemm_phase_gather(PG8_LAS unsigned char* lds, const Gemm g, const Sched& S, const Epi& E, const int* rowlist) {
    const int tid = ltid(), wid = __builtin_amdgcn_readfirstlane(tid >> 6), lane = tid & 63, wr = wid >> 2, wc = wid & 3, fr = lane & 15, fq = lane >> 4;
    const int K = g.K, nt = K / BK;
    unsigned voffB[2]; int Rr[2], Cc[2];
#pragma unroll
    for (int i = 0; i < 2; ++i) { int R, C; stage_rc(tid * 16 + i * 8192, R, C); const int Rb = Epi::PERM ? ((R & ~31) + perm32(R & 31)) : R;
        Rr[i] = R; Cc[i] = C; voffB[i] = (unsigned)(Rb * K + C) * 2u; }
    const size_t kstep = (size_t)(BK * 2);
    const size_t hstep = (size_t)HALF * K * 2;
    const size_t tstep = 2 * hstep;
    const unsigned ldsw = (unsigned)wid * 1024u;
    const int aoff = lds_byte(wr * 64 + fr, fq * 8), boff = lds_byte(wc * 32 + fr, fq * 8);
#define PG8_SA(b, h) (((b) * 2 + (h)) * HTB)
#define PG8_SB(b, h) ((4 + (b) * 2 + (h)) * HTB)
#define PG8_STAGE(bufoff, gbase, voff) do { _Pragma("unroll") for (int _i = 0; _i < 2; ++_i) \
        __builtin_amdgcn_global_load_lds((const unsigned*)((const char*)(gbase) + (voff)[_i]), (PG8_LAS unsigned*)(lds + (bufoff) + ldsw + _i * 8192), 16, 0, 0); } while (0)
#define PG8_STAGEA(bufoff, koff, V, h) do { _Pragma("unroll") for (int _i = 0; _i < 2; ++_i) \
        __builtin_amdgcn_global_load_lds((const unsigned*)((const char*)g.A + (koff) + (V)[h][_i]), (PG8_LAS unsigned*)(lds + (bufoff) + ldsw + _i * 8192), 16, 0, 0); } while (0)
#define PG8_LDA(dst, b, h) do { _Pragma("unroll") for (int m = 0; m < 4; ++m) _Pragma("unroll") for (int k = 0; k < 2; ++k) dst[m][k] = *(const PG8_LAS bf16x8*)(lds + PG8_SA(b, h) + aoff + m * 2048 + k * 1024); } while (0)
#define PG8_LDB(dst, b, h) do { _Pragma("unroll") for (int n = 0; n < 2; ++n) _Pragma("unroll") for (int k = 0; k < 2; ++k) dst[n][k] = *(const PG8_LAS bf16x8*)(lds + PG8_SB(b, h) + boff + n * 2048 + k * 1024); } while (0)
#define PG8_MMA(ai, bj, At, Bt) do { __builtin_amdgcn_s_setprio(1); _Pragma("unroll") for (int m = 0; m < 4; ++m) _Pragma("unroll") for (int n = 0; n < 2; ++n) _Pragma("unroll") for (int k = 0; k < 2; ++k) \
        acc[ai][bj][m][n] = __builtin_amdgcn_mfma_f32_16x16x32_bf16(Bt[n][k], At[m][k], acc[ai][bj][m][n], 0, 0, 0); __builtin_amdgcn_s_setprio(0); } while (0)
#define PG8_WAIT_V(n) asm volatile("s_waitcnt vmcnt(" #n ")" ::: "memory")
#define PG8_WAIT_L(n) asm volatile("s_waitcnt lgkmcnt(" #n ")" ::: "memory")
#define PG8_BAR __builtin_amdgcn_s_barrier()
#define PG8_SCHED __builtin_amdgcn_sched_barrier(0)
#define PG8_ROWS(V, u) do { _Pragma("unroll") for (int _h = 0; _h < 2; ++_h) _Pragma("unroll") for (int _i = 0; _i < 2; ++_i) \
        (V)[_h][_i] = (unsigned)(rowlist[(u).pm * BM + _h * HALF + Rr[_i]] * K + Cc[_i]) * 2u; } while (0)
    Unit cur, nxt; int ui = 0;
    if (!S.next(0, cur)) return;
    f32x4 acc[2][2][4][2];
#pragma unroll
    for (int a = 0; a < 2; ++a)
#pragma unroll
        for (int b = 0; b < 2; ++b)
#pragma unroll
            for (int m = 0; m < 4; ++m)
#pragma unroll
                for (int n = 0; n < 2; ++n) acc[a][b][m][n] = (f32x4){0.f, 0.f, 0.f, 0.f};
    bf16x8 At[4][2], B0[2][2], B1[2][2];
    unsigned vC[2][2], vN[2][2];
    PG8_ROWS(vC, cur);
    const char* cB = (const char*)g.Bt + (size_t)cur.pn * tstep;
    S.a_ready(cur);
    PG8_STAGE(PG8_SB(0, 0), cB, voffB); PG8_STAGE(PG8_SB(0, 1), cB + hstep, voffB); PG8_STAGEA(PG8_SA(0, 0), (size_t)0, vC, 0); PG8_STAGEA(PG8_SA(0, 1), (size_t)0, vC, 1);
    if (wr == 1) PG8_BAR;
    PG8_WAIT_V(2); PG8_BAR;
    PG8_STAGE(PG8_SB(1, 0), cB + kstep, voffB); PG8_STAGEA(PG8_SA(1, 0), kstep, vC, 0); PG8_STAGE(PG8_SB(1, 1), cB + hstep + kstep, voffB);
    PG8_WAIT_V(6); PG8_BAR;
    for (;;) {
        const bool has_next = S.next(ui + 1, nxt);
        if (has_next) { PG8_ROWS(vN, nxt); }
        else {
#pragma unroll
            for (int h = 0; h < 2; ++h)
#pragma unroll
                for (int i = 0; i < 2; ++i) vN[h][i] = vC[h][i]; }
        const char* nB = has_next ? (const char*)g.Bt + (size_t)nxt.pn * tstep : cB;
        for (int t = 0; t < nt; t += 2) {
            const bool last = (t == nt - 2);
            const size_t k1 = (size_t)(t + 1) * kstep;
            const size_t k2 = last ? (size_t)0 : (size_t)(t + 2) * kstep;
            unsigned v2[2][2];
#pragma unroll
            for (int h = 0; h < 2; ++h)
#pragma unroll
                for (int i = 0; i < 2; ++i) v2[h][i] = last ? vN[h][i] : vC[h][i];
            const char* b2 = last ? nB : cB + (size_t)(t + 2) * kstep;
            const size_t k3 = k2 + kstep; const char* b3 = b2 + kstep;
            if (last && has_next) S.a_ready(nxt);
            PG8_LDB(B0, 0, 0); PG8_LDB(B1, 0, 1); PG8_SCHED; PG8_LDA(At, 0, 0); PG8_STAGEA(PG8_SA(1, 1), k1, vC, 1);
            PG8_WAIT_V(8); PG8_WAIT_L(0); PG8_BAR; PG8_MMA(0, 0, At, B0); PG8_MMA(0, 1, At, B1); PG8_BAR; PG8_SCHED;
            PG8_LDA(At, 0, 1); PG8_STAGE(PG8_SB(0, 0), b2, voffB); PG8_STAGE(PG8_SB(0, 1), b2 + hstep, voffB); PG8_STAGEA(PG8_SA(0, 0), k2, v2, 0);
            PG8_WAIT_V(8); PG8_WAIT_L(0); PG8_BAR; PG8_MMA(1, 0, At, B0); PG8_MMA(1, 1, At, B1); PG8_BAR; PG8_SCHED;
            PG8_LDB(B0, 1, 0); PG8_LDB(B1, 1, 1); PG8_SCHED; PG8_LDA(At, 1, 0); PG8_STAGEA(PG8_SA(0, 1), k2, v2, 1);
            PG8_WAIT_V(8); PG8_WAIT_L(0); PG8_BAR; PG8_MMA(0, 0, At, B0); PG8_MMA(0, 1, At, B1); PG8_BAR; PG8_SCHED;
            PG8_LDA(At, 1, 1); PG8_STAGE(PG8_SB(1, 0), b3, voffB); PG8_STAGE(PG8_SB(1, 1), b3 + hstep, voffB); PG8_STAGEA(PG8_SA(1, 0), k3, v2, 0);
            PG8_WAIT_V(8); PG8_WAIT_L(0); PG8_BAR; PG8_MMA(1, 0, At, B0); PG8_MMA(1, 1, At, B1); PG8_BAR; PG8_SCHED;
        }
        if (wr == 0) PG8_BAR;
        E(acc, cur, wr, wc, fr, fq); S.done(cur);
        if (!has_next) break;
#pragma unroll
        for (int a = 0; a < 2; ++a)
#pragma unroll
            for (int b = 0; b < 2; ++b)
#pragma unroll
                for (int m = 0; m < 4; ++m)
#pragma unroll
                    for (int n = 0; n < 2; ++n) acc[a][b][m][n] = (f32x4){0.f, 0.f, 0.f, 0.f};
        cur = nxt; cB = nB; ++ui;
#pragma unroll
        for (int h = 0; h < 2; ++h)
#pragma unroll
            for (int i = 0; i < 2; ++i) vC[h][i] = vN[h][i];
        if (wr == 1) PG8_BAR;
    }
    PG8_WAIT_V(0);
    PG8_BAR;
#undef PG8_SA
#undef PG8_SB
#undef PG8_STAGE
#undef PG8_STAGEA
#undef PG8_LDA
#undef PG8_LDB
#undef PG8_MMA
#undef PG8_WAIT_V
#undef PG8_WAIT_L
#undef PG8_BAR
#undef PG8_SCHED
#undef PG8_ROWS
}
}
#define GAS __attribute__((address_space(1)))
#define LAS __attribute__((address_space(3)))
typedef unsigned short bf16;
typedef unsigned v4u __attribute__((ext_vector_type(4)));
typedef float f32x4 __attribute__((ext_vector_type(4)));
typedef short bf16x8 __attribute__((ext_vector_type(8)));
typedef GAS unsigned gu32;
typedef GAS unsigned long long gu64;
#define RLX_AGENT __ATOMIC_RELAXED, __HIP_MEMORY_SCOPE_AGENT
#define LDS_WAIT() asm volatile("s_waitcnt lgkmcnt(0)" ::: "memory")
#define VM_WAIT() asm volatile("s_waitcnt vmcnt(0)" ::: "memory")
__device__ __forceinline__ unsigned long long rt() { return __builtin_amdgcn_s_memrealtime(); }
__device__ __forceinline__ unsigned f2bf(float f) { unsigned u = __builtin_bit_cast(unsigned, f); return (u + 0x7fffu + ((u >> 16) & 1u)) >> 16; }
__device__ __forceinline__ unsigned pk2(float lo, float hi) { return f2bf(lo) | (f2bf(hi) << 16); }

#define XB_TMO      128
#define XB_XCNT(j)  (256  + 64 * (j))
#define XB_XSUB(j)  (1280 + 64 * (j))
#define XB_XGEN(j)  (2304 + 64 * (j))
#define XB_TOP      3328
#define XB_TOPGEN   3392
#define XCD_BAR_WORDS 3456
#define XB_SPIN_CAP (1u << 18)

__device__ __forceinline__ unsigned xb_ld(unsigned* p)              { return __hip_atomic_load(p, __ATOMIC_RELAXED, __HIP_MEMORY_SCOPE_AGENT); }
__device__ __forceinline__ unsigned xb_add(unsigned* p, unsigned v) { return __hip_atomic_fetch_add(p, v, __ATOMIC_RELAXED, __HIP_MEMORY_SCOPE_AGENT); }
__device__ __forceinline__ unsigned xb_xcc_id() { return (unsigned)__builtin_amdgcn_s_getreg((3 << 11) | 20) & 0xFu; }
#define XB_SPIN(cond, bar) do { unsigned _sp = 0; while (cond) { __builtin_amdgcn_s_sleep(1); \
    if ((++_sp & 255u) == 0u) { if (xb_ld(&(bar)[XB_TMO])) break; if (_sp > XB_SPIN_CAP) { atomicAdd(&(bar)[XB_TMO], 1u); break; } } } } while (0)

struct XcdBarrier {
    unsigned* bar; unsigned x;
    volatile LAS unsigned* st;
};

__device__ __forceinline__ XcdBarrier xcd_barrier_post(unsigned* bar, volatile LAS unsigned* st) {
    XcdBarrier b; b.bar = bar; b.x = xb_xcc_id(); b.st = st;
    if (threadIdx.x == 0) (void)xb_add(&bar[XB_XCNT(b.x)], 1u);
    return b;
}
__device__ __forceinline__ void xcd_barrier_complete(unsigned* bar, unsigned x, unsigned& nloc, unsigned& nx) {
    const unsigned G = gridDim.x * gridDim.y * gridDim.z;
    unsigned sum, cnt, mine, sp = 0u;
    for (;;) {
        sum = 0u; cnt = 0u; mine = 0u;
#pragma unroll
        for (unsigned j = 0; j < 16; ++j) { const unsigned c = xb_ld(&bar[XB_XCNT(j)]); sum += c; cnt += (c > 0u) ? 1u : 0u; mine = (j == x) ? c : mine; }
        if (sum == G) break;
        __builtin_amdgcn_s_sleep(1);
        if ((++sp & 255u) == 0u) { if (xb_ld(&bar[XB_TMO])) break; if (sp > XB_SPIN_CAP) { atomicAdd(&bar[XB_TMO], 1u); break; } }
    }
    nloc = mine > 0u ? mine : 1u; nx = cnt > 0u ? cnt : 1u;
}

__device__ __forceinline__ void xcd_barrier(const XcdBarrier& b) {
    asm volatile("s_waitcnt vmcnt(0)" ::: "memory");
    __syncthreads();
    if (threadIdx.x == 0) {
        unsigned* bar = b.bar;
        __builtin_amdgcn_s_waitcnt(0);
        unsigned nloc = b.st[0], nx = b.st[1];
        if (nloc == 0u) { xcd_barrier_complete(bar, b.x, nloc, nx); b.st[0] = nloc; b.st[1] = nx; }
        const unsigned old = xb_add(&bar[XB_XSUB(b.x)], 1u);
        const unsigned gen = old / nloc;
        if (old + 1u == (gen + 1u) * nloc) {
            __builtin_amdgcn_fence(__ATOMIC_RELEASE, "agent");
            asm volatile("s_waitcnt vmcnt(0)" ::: "memory");
            const unsigned og = xb_add(&bar[XB_TOP], 1u);
            const unsigned tg = og / nx;
            if (og + 1u == (tg + 1u) * nx) xb_add(&bar[XB_TOPGEN], 1u);
            else XB_SPIN(xb_ld(&bar[XB_TOPGEN]) == tg, bar);
            __builtin_amdgcn_fence(__ATOMIC_ACQUIRE, "agent");
            xb_add(&bar[XB_XGEN(b.x)], 1u);
            asm volatile("s_waitcnt vmcnt(0)" ::: "memory");
        } else {
            XB_SPIN(xb_ld(&bar[XB_XGEN(b.x)]) == gen, bar);
            __builtin_amdgcn_fence(__ATOMIC_ACQUIRE, "agent");
            asm volatile("s_waitcnt vmcnt(0)" ::: "memory");
        }
    }
    __syncthreads();
}

typedef short s16x4 __attribute__((ext_vector_type(4)));
typedef float f32x16 __attribute__((ext_vector_type(16)));
typedef float f32x2 __attribute__((ext_vector_type(2)));
__device__ __forceinline__ float bflo(unsigned u) { return __builtin_bit_cast(float, u << 16); }
__device__ __forceinline__ float bfhi(unsigned u) { return __builtin_bit_cast(float, u & 0xffff0000u); }
__device__ __forceinline__ void unpack8(const v4u w, float (&x)[8]) { x[0] = bflo(w.x); x[1] = bfhi(w.x); x[2] = bflo(w.y); x[3] = bfhi(w.y); x[4] = bflo(w.z); x[5] = bfhi(w.z); x[6] = bflo(w.w); x[7] = bfhi(w.w); }
__device__ __forceinline__ v4u pack8(const float (&x)[8]) { v4u w; w.x = pk2(x[0], x[1]); w.y = pk2(x[2], x[3]); w.z = pk2(x[4], x[5]); w.w = pk2(x[6], x[7]); return w; }
__device__ __forceinline__ float wave_sum(float v) {
#pragma unroll
    for (int o = 1; o < 64; o <<= 1) v += __shfl_xor(v, o);
    return v;
}

namespace att {
constexpr int KST = 144;
constexpr int TILEB = 64 * KST;
constexpr int L_K = 0, L_V = 2 * TILEB, L_WSF = 4 * TILEB, L_OST = L_WSF + 8 * 512, OST_W = 68 * 32 * 4;
constexpr int LDS_BYTES = L_OST + 8 * OST_W;
__device__ __forceinline__ int crow(int r, int hi) { return (r & 3) + 8 * (r >> 2) + 4 * hi; }
typedef short v4i16_t __attribute__((ext_vector_type(4)));
__device__ __forceinline__ s16x4 vtr(const LAS unsigned char* p) { return __builtin_bit_cast(s16x4, __builtin_amdgcn_ds_read_tr16_b64_v4i16((LAS v4i16_t*)p)); }
__device__ __forceinline__ unsigned cvtpk(float lo, float hi) { typedef float f2 __attribute__((ext_vector_type(2))); typedef __bf16 b2 __attribute__((ext_vector_type(2))); f2 v = {lo, hi}; b2 b = __builtin_convertvector(v, b2); return __builtin_bit_cast(unsigned, b); }

template <int DQK>
__device__ __forceinline__ void attn_pass(LAS unsigned char* lds, const bf16* Qw, int qld, const bf16* Kp, int kld, const bf16* Vp, int vld, int ntiles, f32x16 (&o)[2], float& l_out) {
    const int tid = ltid(), lane = tid & 63, r32 = lane & 31, hi = lane >> 5; const int wid = __builtin_amdgcn_readfirstlane(tid >> 6);
    constexpr int KS = DQK / 16;
    constexpr int KCH = DQK / 8;
    bf16x8 qr[KS];
#pragma unroll
    for (int s = 0; s < KS; ++s) qr[s] = *(const bf16x8*)(Qw + (size_t)r32 * qld + s * 16 + hi * 8);
    LAS float* wsf = (LAS float*)(lds + L_WSF) + wid * 128;
    const int kkey = tid / KCH, kch = tid % KCH; const bool kact = tid < 64 * KCH;
    const int vkey = tid >> 3, vch = tid & 7;
    const bf16* kg = Kp + (size_t)kkey * kld + kch * 8;
    const bf16* vg = Vp + (size_t)vkey * vld + vch * 8;
    const int klds = L_K + kkey * KST + kch * 16, vlds = L_V + vkey * KST + vch * 16;
    v4u kreg = (v4u){0u, 0u, 0u, 0u}, vreg;
    if (kact) kreg = *(const v4u*)kg;
    vreg = *(const v4u*)vg;
    __syncthreads();
    if (kact) *(LAS v4u*)(lds + klds) = kreg;
    *(LAS v4u*)(lds + vlds) = vreg;
    __syncthreads();
    o[0] = f32x16{}; o[1] = f32x16{};
    float m = -INFINITY, l = 0.f;
    const int kfr = r32 * KST + hi * 16;
    const int vfr = (((lane & 15) >> 2) + 4 * hi) * KST + (16 * ((lane >> 4) & 1) + 4 * (lane & 3)) * 2;
    for (int t = 0; t < ntiles; ++t) {
        const int cb = (t & 1) * TILEB, nb = ((t + 1) & 1) * TILEB;
        const bool pre = (t + 1 < ntiles);
        if (pre) { if (kact) kreg = *(const v4u*)(kg + (size_t)(t + 1) * 64 * kld); vreg = *(const v4u*)(vg + (size_t)(t + 1) * 64 * vld); }
        f32x16 p[2];
#pragma unroll
        for (int kh = 0; kh < 2; ++kh) {
            p[kh] = f32x16{};
#pragma unroll
            for (int s = 0; s < KS; ++s) { const bf16x8 kf = *(const LAS bf16x8*)(lds + L_K + cb + kh * 32 * KST + kfr + s * 32);
                p[kh] = __builtin_amdgcn_mfma_f32_32x32x16_bf16(kf, qr[s], p[kh], 0, 0, 0); }
        }
        float mx = p[0][0];
#pragma unroll
        for (int r = 0; r < 16; ++r) { mx = fmaxf(mx, p[0][r]); mx = fmaxf(mx, p[1][r]); }
        mx = fmaxf(mx, __shfl_xor(mx, 32));
        const float mnew = fmaxf(m, mx);
        const float alpha = __builtin_amdgcn_exp2f(m - mnew);
        float rs = 0.f;
#pragma unroll
        for (int kh = 0; kh < 2; ++kh)
#pragma unroll
            for (int r = 0; r < 16; ++r) { const float e = __builtin_amdgcn_exp2f(p[kh][r] - mnew); p[kh][r] = e; rs += e; }
        l = l * alpha + rs;
        if (__any(mnew > m)) {
            if (hi == 0) wsf[r32] = alpha;
#pragma unroll
            for (int r4 = 0; r4 < 4; ++r4) { const f32x4 a = *(const LAS f32x4*)(wsf + 8 * r4 + 4 * hi);
#pragma unroll
                for (int i = 0; i < 4; ++i) { o[0][4 * r4 + i] *= a[i]; o[1][4 * r4 + i] *= a[i]; } }
        }
        m = mnew;
#pragma unroll
        for (int kh = 0; kh < 2; ++kh)
#pragma unroll
            for (int s2 = 0; s2 < 2; ++s2) {
                v4u pw; pw.x = cvtpk(p[kh][8 * s2 + 0], p[kh][8 * s2 + 1]); pw.y = cvtpk(p[kh][8 * s2 + 2], p[kh][8 * s2 + 3]); pw.z = cvtpk(p[kh][8 * s2 + 4], p[kh][8 * s2 + 5]); pw.w = cvtpk(p[kh][8 * s2 + 6], p[kh][8 * s2 + 7]);
                const bf16x8 pa = __builtin_bit_cast(bf16x8, pw);
#pragma unroll
                for (int dh = 0; dh < 2; ++dh) {
                    const LAS unsigned char* vb = lds + L_V + cb + vfr + (32 * kh + 16 * s2) * KST + dh * 64;
                    const s16x4 lo = vtr(vb), hh = vtr(vb + 8 * KST);
                    const bf16x8 vf = (bf16x8){lo[0], lo[1], lo[2], lo[3], hh[0], hh[1], hh[2], hh[3]};
                    o[dh] = __builtin_amdgcn_mfma_f32_32x32x16_bf16(pa, vf, o[dh], 0, 0, 0);
                }
            }
        if (pre) { if (kact) *(LAS v4u*)(lds + klds + nb) = kreg; *(LAS v4u*)(lds + vlds + nb) = vreg; }
        __syncthreads();
    }
    l_out = l + __shfl_xor(l, 32);
}
__device__ __forceinline__ void scale_rows(LAS unsigned char* lds, f32x16 (&o)[2], float f) {
    const int tid_ = ltid(); const int lane = tid_ & 63, r32 = lane & 31, hi = lane >> 5; const int wid = __builtin_amdgcn_readfirstlane(tid_ >> 6);
    LAS float* wsf = (LAS float*)(lds + L_WSF) + wid * 128 + 64;
    if (hi == 0) wsf[r32] = f;
#pragma unroll
    for (int r4 = 0; r4 < 4; ++r4) { const f32x4 a = *(const LAS f32x4*)(wsf + 8 * r4 + 4 * hi);
#pragma unroll
        for (int i = 0; i < 4; ++i) { o[0][4 * r4 + i] *= a[i]; o[1][4 * r4 + i] *= a[i]; } }
}
__device__ __forceinline__ void stage_o(LAS unsigned char* lds, const f32x16 (&o)[2]) {
    const int tid_ = ltid(); const int lane = tid_ & 63, r32 = lane & 31, hi = lane >> 5; const int wid = __builtin_amdgcn_readfirstlane(tid_ >> 6);
    LAS float* stg = (LAS float*)(lds + L_OST + wid * OST_W);
#pragma unroll
    for (int r = 0; r < 16; ++r) { const int q = crow(r, hi); stg[q * 68 + r32] = o[0][r]; stg[q * 68 + 32 + r32] = o[1][r]; }
}
__device__ __forceinline__ void gqa_unit(LAS unsigned char* lds, const bf16* Q  , int qld, const bf16* Kp, const bf16* Vp, int kvld, int ntiles, bf16* Out  , int old) {
    const int tid_ = ltid(); const int lane = tid_ & 63; const int wid = __builtin_amdgcn_readfirstlane(tid_ >> 6);
    f32x16 o[2]; float l;
    attn_pass<64>(lds, Q + (size_t)wid * 32 * qld, qld, Kp, kvld, Vp, kvld, ntiles, o, l);
    scale_rows(lds, o, 1.0f / l);
    stage_o(lds, o);
    const LAS float* stg = (const LAS float*)(lds + L_OST + wid * OST_W);
#pragma unroll
    for (int i = 0; i < 4; ++i) { const int row = i * 8 + (lane >> 3), ch = lane & 7; float x[8];
#pragma unroll
        for (int j = 0; j < 8; ++j) x[j] = stg[row * 68 + ch * 8 + j];
        *(v4u*)(Out + (size_t)(wid * 32 + row) * old + ch * 8) = pack8(x); }
}
__device__ __forceinline__ void diff_unit(LAS unsigned char* lds, const bf16* Q  , int qld, const bf16* Kp, int kld, const bf16* Vp, int vld, int ntiles, float lam, const float* nw, float oscale, bf16* Out, int old) {
    const int tid_ = ltid(); const int lane = tid_ & 63; const int wid = __builtin_amdgcn_readfirstlane(tid_ >> 6);
    f32x16 o0[2], o1[2]; float l;
    attn_pass<32>(lds, Q + (size_t)wid * 32 * qld, qld, Kp, kld, Vp, vld, ntiles, o0, l);
    scale_rows(lds, o0, 1.0f / l);
    attn_pass<32>(lds, Q + (size_t)wid * 32 * qld + 32, qld, Kp + 32, kld, Vp, vld, ntiles, o1, l);
    scale_rows(lds, o1, lam / l);
#pragma unroll
    for (int r = 0; r < 16; ++r) { o0[0][r] -= o1[0][r]; o0[1][r] -= o1[1][r]; }
    stage_o(lds, o0);
    const LAS float* stg = (const LAS float*)(lds + L_OST + wid * OST_W);
#pragma unroll
    for (int i = 0; i < 4; ++i) { const int row = i * 8 + (lane >> 3), ch = lane & 7; float x[8]; float ss = 0.f;
#pragma unroll
        for (int j = 0; j < 8; ++j) { x[j] = stg[row * 68 + ch * 8 + j]; ss += x[j] * x[j]; }
        ss += __shfl_xor(ss, 1); ss += __shfl_xor(ss, 2); ss += __shfl_xor(ss, 4);
        const float rstd = 1.0f / sqrtf(ss * (1.0f / 64.0f) + EPS) * oscale;
#pragma unroll
        for (int j = 0; j < 8; ++j) x[j] = x[j] * rstd * nw[ch * 8 + j];
        *(v4u*)(Out + (size_t)(wid * 32 + row) * old + ch * 8) = pack8(x); }
}
}

namespace gla {
constexpr int RS = 33;
constexpr int O_K = 0, O_ZF = 64 * RS * 4, O_ZB = 2 * 64 * RS * 4, O_Q = 3 * 64 * RS * 4, O_V = 4 * 64 * RS * 4;
constexpr int O_W1 = O_V + 64 * 64 * 4, O_W2 = O_W1 + 64 * RS * 4, O_W3 = O_W2 + 64 * RS * 4, O_W4 = O_W3 + 64 * RS * 4, O_A = O_W4 + 64 * RS * 4;
constexpr int LDS_BYTES = O_A + 64 * 65 * 4;
__device__ __forceinline__ int chunk_row0(int b, int c) { return c < 4 ? MLAT + b * CTXL + c * 64 : b * SEQ + (c - 4) * 64; }
__device__ __forceinline__ float log_sigmoid(float z) { return fminf(z, 0.f) - log1pf(expf(-fabsf(z))); }

template <bool WITH_Q>
__device__ __forceinline__ void load_chunk(LAS unsigned char* lds, const bf16* P, int row0, int h, const float* ab_f, const float* ab_b) {
    const int tid = ltid();
    LAS float* Lk = (LAS float*)(lds + O_K); LAS float* Lf = (LAS float*)(lds + O_ZF); LAS float* Lb = (LAS float*)(lds + O_ZB); LAS float* Lq = (LAS float*)(lds + O_Q); LAS float* Lv = (LAS float*)(lds + O_V);
    for (int idx = tid; idx < 64 * 24; idx += 512) {
        const int t = idx / 24, ch = idx % 24; const bf16* pr = P + (size_t)(row0 + t) * NP; float x[8];
        if (ch < 4) { unpack8(*(const v4u*)(pr + PC_GLK + 32 * h + 8 * ch), x);
#pragma unroll
            for (int j = 0; j < 8; ++j) Lk[t * RS + 8 * ch + j] = x[j]; }
        else if (ch < 8) { const int c4 = ch - 4; unpack8(*(const v4u*)(pr + PC_ZF + 32 * h + 8 * c4), x);
#pragma unroll
            for (int j = 0; j < 8; ++j) Lf[t * RS + 8 * c4 + j] = log_sigmoid(x[j] + ab_f[32 * h + 8 * c4 + j]) * (1.0f / 16.0f); }
        else if (ch < 12) { const int c4 = ch - 8; unpack8(*(const v4u*)(pr + PC_ZB + 32 * h + 8 * c4), x);
#pragma unroll
            for (int j = 0; j < 8; ++j) Lb[t * RS + 8 * c4 + j] = log_sigmoid(x[j] + ab_b[32 * h + 8 * c4 + j]) * (1.0f / 16.0f); }
        else if (ch < 16) { if (WITH_Q) { const int c4 = ch - 12; unpack8(*(const v4u*)(pr + PC_GLQ + 32 * h + 8 * c4), x);
#pragma unroll
            for (int j = 0; j < 8; ++j) Lq[t * RS + 8 * c4 + j] = x[j] * 0.17677669529663687f; } }
        else { const int c8 = ch - 16; unpack8(*(const v4u*)(pr + PC_GLV + 64 * h + 8 * c8), x);
#pragma unroll
            for (int j = 0; j < 8; ++j) Lv[t * 64 + 8 * c8 + j] = x[j]; }
    }
    __syncthreads();
    if (tid < 32) { float s = 0.f; for (int t = 0; t < 64; ++t) { s += Lf[t * RS + tid]; Lf[t * RS + tid] = s; } }
    else if (tid < 64) { const int d = tid - 32; float s = 0.f; for (int t = 63; t >= 0; --t) { s += Lb[t * RS + d]; Lb[t * RS + d] = s; } }
    __syncthreads();
}

__device__ __forceinline__ void g1_unit(LAS unsigned char* lds, const bf16* P, int b, int h, int c, const float* ab_f, const float* ab_b, float* KV, float* DEC) {
    const int tid = ltid();
    __syncthreads();
    load_chunk<false>(lds, P, chunk_row0(b, c), h, ab_f, ab_b);
    LAS float* Lk = (LAS float*)(lds + O_K); LAS float* Lf = (LAS float*)(lds + O_ZF); LAS float* Lb = (LAS float*)(lds + O_ZB); LAS float* Lv = (LAS float*)(lds + O_V);
    LAS float* Wf = (LAS float*)(lds + O_W1); LAS float* Wb = (LAS float*)(lds + O_W2);
    for (int idx = tid; idx < 64 * 32; idx += 512) { const int t = idx >> 5, d = idx & 31; const float k = Lk[t * RS + d];
        Wf[t * RS + d] = k * expf(Lf[63 * RS + d] - Lf[t * RS + d]);
        Wb[t * RS + d] = k * expf(Lb[0 * RS + d] - Lb[t * RS + d]); }
    __syncthreads();
    const int e = tid & 63, dg = tid >> 6;
    float af[4] = {0.f, 0.f, 0.f, 0.f}, abk[4] = {0.f, 0.f, 0.f, 0.f};
    for (int t = 0; t < 64; ++t) { const float v = Lv[t * 64 + e];
#pragma unroll
        for (int i = 0; i < 4; ++i) { af[i] += Wf[t * RS + 4 * dg + i] * v; abk[i] += Wb[t * RS + 4 * dg + i] * v; } }
    const int sf = c, sb = c < 4 ? 3 - c : 71 - c;
    const int bhf = (b * 4 + h) * 2, bhb = bhf + 1;
    float* kvf = KV + ((size_t)bhf * NCH + sf) * 2048; float* kvb = KV + ((size_t)bhb * NCH + sb) * 2048;
#pragma unroll
    for (int i = 0; i < 4; ++i) { kvf[(4 * dg + i) * 64 + e] = af[i]; kvb[(4 * dg + i) * 64 + e] = abk[i]; }
    if (tid < 32) DEC[((size_t)bhf * NCH + sf) * 32 + tid] = expf(Lf[63 * RS + tid]);
    else if (tid < 64) DEC[((size_t)bhb * NCH + sb) * 32 + (tid - 32)] = expf(Lb[0 * RS + (tid - 32)]);
}

__device__ __forceinline__ void g2_scan(float* KV, const float* DEC, int gtid, int gthreads) {
    for (int idx = gtid; idx < 32 * 2048; idx += gthreads) {
        const int bhd = idx >> 11, el = idx & 2047, d = el >> 6;
        float* kv = KV + (size_t)bhd * NCH * 2048 + el; const float* dc = DEC + (size_t)bhd * NCH * 32 + d;
        float S = 0.f;
#pragma unroll 4
        for (int s = 0; s < NCH; ++s) { const float x = kv[(size_t)s * 2048]; const float g = dc[s * 32]; kv[(size_t)s * 2048] = S; S = g * S + x; }
    }
}

__device__ __forceinline__ void g3_unit(LAS unsigned char* lds, const bf16* P, int b, int h, int c, const float* ab_f, const float* ab_b, const float* KV, const float* gnorm, bf16* MIX) {
    const int tid = ltid(), lane = tid & 63;
    __syncthreads();
    const int row0 = chunk_row0(b, c);
    load_chunk<true>(lds, P, row0, h, ab_f, ab_b);
    LAS float* Lk = (LAS float*)(lds + O_K); LAS float* Lf = (LAS float*)(lds + O_ZF); LAS float* Lb = (LAS float*)(lds + O_ZB); LAS float* Lq = (LAS float*)(lds + O_Q); LAS float* Lv = (LAS float*)(lds + O_V);
    LAS float* Qf = (LAS float*)(lds + O_W1); LAS float* Kf = (LAS float*)(lds + O_W2); LAS float* Qb = (LAS float*)(lds + O_W3); LAS float* Kb = (LAS float*)(lds + O_W4); LAS float* A = (LAS float*)(lds + O_A);
    for (int idx = tid; idx < 64 * 32; idx += 512) { const int t = idx >> 5, d = idx & 31; const float q = Lq[t * RS + d], k = Lk[t * RS + d], bf_ = Lf[t * RS + d], bb_ = Lb[t * RS + d];
        Qf[t * RS + d] = q * expf(bf_); Kf[t * RS + d] = k * expf(-bf_); Qb[t * RS + d] = q * expf(bb_); Kb[t * RS + d] = k * expf(-bb_); }
    __syncthreads();
    {
        const int s = lane, tg = tid >> 6; float accf[8], accb[8];
#pragma unroll
        for (int i = 0; i < 8; ++i) { accf[i] = 0.f; accb[i] = 0.f; }
        for (int d = 0; d < 32; ++d) { const float kf = Kf[s * RS + d], kb = Kb[s * RS + d];
#pragma unroll
            for (int i = 0; i < 8; ++i) { accf[i] += Qf[(8 * tg + i) * RS + d] * kf; accb[i] += Qb[(8 * tg + i) * RS + d] * kb; } }
#pragma unroll
        for (int i = 0; i < 8; ++i) { const int t = 8 * tg + i; A[t * 65 + s] = (s <= t ? accf[i] : 0.f) + (s >= t ? accb[i] : 0.f); }
    }
    __syncthreads();
    const int e = lane, tg = tid >> 6;
    float o[8];
#pragma unroll
    for (int i = 0; i < 8; ++i) o[i] = 0.f;
    for (int s = 0; s < 64; ++s) { const float v = Lv[s * 64 + e];
#pragma unroll
        for (int i = 0; i < 8; ++i) o[i] += A[(8 * tg + i) * 65 + s] * v; }
    const int sf = c, sb = c < 4 ? 3 - c : 71 - c; const int bhf = (b * 4 + h) * 2, bhb = bhf + 1;
    const float* Sf = KV + ((size_t)bhf * NCH + sf) * 2048; const float* Sb = KV + ((size_t)bhb * NCH + sb) * 2048;
    for (int d = 0; d < 32; ++d) { const float sfv = Sf[d * 64 + e], sbv = Sb[d * 64 + e];
#pragma unroll
        for (int i = 0; i < 8; ++i) o[i] += Qf[(8 * tg + i) * RS + d] * sfv + Qb[(8 * tg + i) * RS + d] * sbv; }
    const float gw = gnorm[e];
#pragma unroll
    for (int i = 0; i < 8; ++i) { const int t = 8 * tg + i; const float ms = wave_sum(o[i] * o[i]) * (1.0f / 64.0f); const float y = o[i] / sqrtf(ms + EPS) * gw;
        const size_t row = (size_t)(row0 + t); const float r = bflo((unsigned)P[row * NP + PC_GLR + 64 * h + e]);
        const float sg = r / (1.0f + expf(-r));
        MIX[row * 1024 + 64 * h + e] = (bf16)f2bf(y * sg); }
}
}

constexpr size_t MiB = 1u << 20;
constexpr size_t WS_CTL = 0, CTL_ZERO_BYTES = 64 * 1024;
constexpr size_t WS_MOD = 1 * MiB;
constexpr size_t WS_ROPE = 1 * MiB + 512 * 1024;
constexpr size_t WS_TOKE = 2 * MiB;
constexpr size_t WS_TOKW = 2 * MiB + 256 * 1024;
constexpr size_t WS_POS = 2 * MiB + 512 * 1024;
constexpr size_t WS_ROWL = 3 * MiB;
constexpr size_t WS_ROWW = 3 * MiB + 256 * 1024;
constexpr size_t WS_PANE = 3 * MiB + 512 * 1024;
constexpr size_t WS_DEC = 4 * MiB;
constexpr size_t WS_WIN = 8 * MiB, WS_WOUT = 18 * MiB, WS_WGU = 22 * MiB, WS_WDN = 33 * MiB;
constexpr size_t WS_XCTX = 39 * MiB;
constexpr size_t WS_H = 43 * MiB;
constexpr size_t WS_MGU = 77 * MiB, WS_MDN = 189 * MiB;
constexpr size_t WS_P = 245 * MiB;
constexpr size_t WS_GQ = 330 * MiB, WS_GK = 347 * MiB, WS_GV = 351 * MiB + 512 * 1024;
constexpr size_t WS_DQ = 356 * MiB, WS_DK = 364 * MiB + 512 * 1024, WS_DV = 373 * MiB;
constexpr size_t WS_KV = 382 * MiB;
constexpr size_t WS_MIX = 399 * MiB;
constexpr size_t WS_ACT = 245 * MiB;
constexpr size_t WS_ACT2 = 245 * MiB;
constexpr size_t WS_Y2 = 77 * MiB;
constexpr size_t WS_END = 483 * MiB;
static_assert(WS_P + (size_t)MT * NP * 2 <= WS_GQ && WS_GQ + (size_t)MT * 512 * 2 <= WS_GK && WS_GK + (size_t)NB * LK * 128 * 2 <= WS_GV && WS_GV + (size_t)NB * LK * 128 * 2 <= WS_DQ, "ws map 1");
static_assert(WS_DQ + (size_t)MT * 256 * 2 <= WS_DK && WS_DK + (size_t)NB * LK * 256 * 2 <= WS_DV && WS_DV + (size_t)NB * LK * 256 * 2 <= WS_KV && WS_KV + (size_t)32 * NCH * 2048 * 4 <= WS_MIX && WS_MIX + (size_t)MT * 1024 * 2 <= WS_END, "ws map 2");
static_assert(WS_ACT + (size_t)MT * DFF * 2 <= WS_KV && WS_ACT2 + (size_t)MOE_ROWS * DFFE * 2 <= WS_END && WS_Y2 + (size_t)MOE_ROWS * 1024 * 2 <= WS_MDN, "ws map 3");
static_assert(WS_WIN + (size_t)2 * NP * D * 2 <= WS_WOUT && WS_WOUT + (size_t)2 * D * D * 2 <= WS_WGU && WS_WGU + (size_t)2 * DFF * D * 2 <= WS_WDN && WS_WDN + (size_t)D * DFF * 2 <= WS_XCTX && WS_XCTX + (size_t)MCTX * D * 4 <= WS_H && WS_H + (size_t)MT * D * 2 <= WS_MGU, "ws map 4");
static_assert(WS_MGU + (size_t)NE * 2 * DFFE * D * 2 <= WS_MDN && WS_MDN + (size_t)NE * D * DFFE * 2 <= WS_P, "ws map 5");
constexpr int CW_TMO = 0, CW_CODE = 1, CW_BAR = 4096;

constexpr int RING_OFF = 0, RING_BYTES = 131072;
constexpr int LDSCTL_OFF = RING_BYTES, MISC_OFF = LDSCTL_OFF + 320;
constexpr int LDS_BYTES = 147456;
constexpr int NWAVES = 8;

struct Frame {
    LAS unsigned char* lds; volatile LAS unsigned* MISC; gu32* ctl;
    int tid, lane, wave, vcu, G;
    unsigned char* ws; float* out;
    const float *x, *c, *ctx, *c_ctx, *w_mod, *b_mod, *norm_mix, *norm_ffn, *w_in, *w_out, *a2_f, *ab_f, *a2_b, *ab_b, *gla_norm, *q_norm, *k_norm, *lq1, *lk1, *lq2, *lk2, *diff_norm,
                *ffn_gate, *ffn_up, *ffn_down, *moe_router, *moe_gate, *moe_up, *moe_down, *norm_f;
};
#define WSP(T, off) ((T*)(F.ws + (off)))
#define RELAUNDER(F) do { const int t_ = ltid(); (F).tid = t_; (F).lane = t_ & 63; (F).wave = __builtin_amdgcn_readfirstlane(t_ >> 6); } while (0)

__device__ __forceinline__ void p0_transpose_item(const float* W, int K, int N, bf16* WT, int dst_row0, LAS float* scr, int k0, int n0, int lane) {
#pragma unroll 8
    for (int i = 0; i < 32; ++i) { const int kk = 2 * i + (lane >> 5); scr[kk * 33 + (lane & 31)] = W[(size_t)(k0 + kk) * N + n0 + (lane & 31)]; }
    LDS_WAIT(); asm volatile("" ::: "memory");
    const int c = lane & 7;
#pragma unroll
    for (int j = 0; j < 4; ++j) { const int n = (lane >> 3) + 8 * j; const LAS float* s = scr + (8 * c) * 33 + n;
        v4u o; o.x = pk2(s[0 * 33], s[1 * 33]); o.y = pk2(s[2 * 33], s[3 * 33]); o.z = pk2(s[4 * 33], s[5 * 33]); o.w = pk2(s[6 * 33], s[7 * 33]);
        *(GAS v4u*)(WT + (size_t)(dst_row0 + n) * K + k0 + 8 * c) = o; }
    LDS_WAIT(); asm volatile("" ::: "memory");
}
__device__ __forceinline__ int gu_row(int n0, int up) { return 256 * (n0 >> 7) + (up ? 128 : 0) + (n0 & 127); }

__device__ __forceinline__ void p0_prologue(Frame& F) {
    RELAUNDER(F);
    {
        LAS float* s5 = (LAS float*)(F.lds + RING_OFF);
        LAS float* red = (LAS float*)(F.lds + RING_OFF + 5 * 1024 * 4);
        bool have = false;
        for (int u = blockIdx.x; u < 192; u += F.G) {
            if (!have) { for (int i = F.tid; i < 5 * 1024; i += 512) { const int r = i >> 10, k = i & 1023; const float v = r < 4 ? F.c[r * 1024 + k] : F.c_ctx[k]; s5[i] = v / (1.0f + expf(-v)); } have = true; }
            __syncthreads();
            const int l = u / 96, cg = u % 96; const float* W = F.w_mod + (size_t)l * 1024 * 6144 + cg * 64 + F.lane;
            float a0 = 0.f, a1 = 0.f, a2 = 0.f, a3 = 0.f, a4 = 0.f; const int kb = F.wave * 128;
#pragma unroll 16
            for (int k = 0; k < 128; ++k) { const float w = W[(size_t)(kb + k) * 6144];
                a0 += s5[kb + k] * w; a1 += s5[1024 + kb + k] * w; a2 += s5[2048 + kb + k] * w; a3 += s5[3072 + kb + k] * w; a4 += s5[4096 + kb + k] * w; }
            red[(F.wave * 5 + 0) * 64 + F.lane] = a0; red[(F.wave * 5 + 1) * 64 + F.lane] = a1; red[(F.wave * 5 + 2) * 64 + F.lane] = a2; red[(F.wave * 5 + 3) * 64 + F.lane] = a3; red[(F.wave * 5 + 4) * 64 + F.lane] = a4;
            __syncthreads();
            if (F.tid < 320) { const int r = F.tid >> 6, col = F.tid & 63; float s = F.b_mod[l * 6144 + cg * 64 + col];
#pragma unroll
                for (int w = 0; w < 8; ++w) s += red[(w * 5 + r) * 64 + col];
                WSP(float, WS_MOD)[(l * 5 + r) * 6144 + cg * 64 + col] = s; }
            __syncthreads();
        }
        __syncthreads();
    }
    if ((int)blockIdx.x == F.G - 1) {
        float* rope = WSP(float, WS_ROPE);
        for (int idx = F.tid; idx < 1024 + 512; idx += 512) {
            const bool gq = idx < 1024; const int j = gq ? idx : idx - 1024; const int pos = gq ? (j >> 4) : (j >> 3), fi = gq ? (j & 15) : (j & 7);
            const double base = gq ? 0.56234132519034908 : 0.31622776601683794;
            double f = 1.0; for (int q = 0; q < fi; ++q) f *= base;
            const double ang = (double)pos * f;
            const double nq = __builtin_rint(ang * 0.63661977236758134);
            const double r = (ang - nq * 1.5707963267948966) - nq * 6.123233995736766e-17;
            const double r2 = r * r;
            double sn = r * (1.0 + r2 * (-1.0 / 6 + r2 * (1.0 / 120 + r2 * (-1.0 / 5040 + r2 * (1.0 / 362880 + r2 * (-1.0 / 39916800 + r2 * (1.0 / 6227020800.0 + r2 * (-1.0 / 1307674368000.0))))))));
            double cs = 1.0 + r2 * (-0.5 + r2 * (1.0 / 24 + r2 * (-1.0 / 720 + r2 * (1.0 / 40320 + r2 * (-1.0 / 3628800 + r2 * (1.0 / 479001600.0 + r2 * (-1.0 / 87178291200.0 + r2 * (1.0 / 20922789888000.0))))))));
            const int qd = ((int)nq) & 3;
            const double cv = qd == 0 ? cs : qd == 1 ? -sn : qd == 2 ? -cs : sn;
            const double sv = qd == 0 ? sn : qd == 1 ? cs : qd == 2 ? -sn : -cs;
            if (gq) { rope[j] = (float)cv; rope[1024 + j] = (float)sv; } else { rope[2048 + j] = (float)cv; rope[2560 + j] = (float)sv; }
        }
    }
    const int gw = F.vcu * NWAVES + F.wave, NGW = F.G * NWAVES;
    for (int it = gw; it < 2 * 2 * 128 * 2; it += NGW) {
        const int kb = it & 1, j = (it >> 1) & 127, dir = (it >> 8) & 1, l = it >> 9;
        const float* a2 = (dir ? F.a2_b : F.a2_f) + l * 16 * 128 + j; float a[16];
#pragma unroll
        for (int r = 0; r < 16; ++r) a[r] = a2[r * 128];
        const int k0 = kb * 512 + F.lane * 8; float o[8];
#pragma unroll
        for (int kk = 0; kk < 8; ++kk) { const float* wr = F.w_in + (size_t)l * D * INW + (size_t)(k0 + kk) * INW + 768 + 16 * dir; float s = 0.f;
#pragma unroll
            for (int r = 0; r < 16; ++r) s += wr[r] * a[r];
            o[kk] = s; }
        *(GAS v4u*)(WSP(bf16, WS_WIN) + ((size_t)l * NP + 768 + 128 * dir + j) * D + k0) = pack8(o);
    }
    LAS float* scr = (LAS float*)(F.lds + RING_OFF + 32768 + F.wave * 8704);
    constexpr int I_IN = 16 * 73, I_OUT = 16 * 32, I_FG = 16 * 88, I_FD = 44 * 32, I_MG = 16 * 112, I_MD = 56 * 32;
    constexpr int NITEMS = 2 * I_IN + 2 * I_OUT + 2 * I_FG + I_FD + 16 * I_MG + 8 * I_MD;
    for (int it = gw; it < NITEMS; it += NGW) {
        int r = it;
        if (r < 2 * I_IN) { const int l = r / I_IN; r -= l * I_IN; const int kb = r / 73, nb = r % 73; if (nb == 24) continue;
            const int n0 = nb * 32; p0_transpose_item(F.w_in + (size_t)l * D * INW, D, INW, WSP(bf16, WS_WIN) + (size_t)l * NP * D, n0 < 768 ? n0 : n0 + 224, scr, kb * 64, n0, F.lane); continue; }
        r -= 2 * I_IN;
        if (r < 2 * I_OUT) { const int l = r / I_OUT; r -= l * I_OUT; const int kb = r / 32, nb = r % 32;
            p0_transpose_item(F.w_out + (size_t)l * D * D, D, D, WSP(bf16, WS_WOUT) + (size_t)l * D * D, nb * 32, scr, kb * 64, nb * 32, F.lane); continue; }
        r -= 2 * I_OUT;
        if (r < 2 * I_FG) { const int up = r / I_FG; r -= up * I_FG; const int kb = r / 88, nb = r % 88;
            p0_transpose_item(up ? F.ffn_up : F.ffn_gate, D, DFF, WSP(bf16, WS_WGU), gu_row(nb * 32, up), scr, kb * 64, nb * 32, F.lane); continue; }
        r -= 2 * I_FG;
        if (r < I_FD) { const int kb = r / 32, nb = r % 32;
            p0_transpose_item(F.ffn_down, DFF, D, WSP(bf16, WS_WDN), nb * 32, scr, kb * 64, nb * 32, F.lane); continue; }
        r -= I_FD;
        if (r < 16 * I_MG) { const int eu = r / I_MG; r -= eu * I_MG; const int e = eu >> 1, up = eu & 1; const int kb = r / 112, nb = r % 112;
            p0_transpose_item((up ? F.moe_up : F.moe_gate) + (size_t)e * D * DFFE, D, DFFE, WSP(bf16, WS_MGU) + (size_t)e * 2 * DFFE * D, gu_row(nb * 32, up), scr, kb * 64, nb * 32, F.lane); continue; }
        r -= 16 * I_MG;
        { const int e = r / I_MD; r -= e * I_MD; const int kb = r / 32, nb = r % 32;
            p0_transpose_item(F.moe_down + (size_t)e * DFFE * D, DFFE, D, WSP(bf16, WS_MDN) + (size_t)e * D * DFFE, nb * 32, scr, kb * 64, nb * 32, F.lane); }
    }
}

template <bool ROUTER>
__device__ __forceinline__ void phase_norm(Frame& F, int l, int which, const float* xlat, const float* xctx) {
    RELAUNDER(F);
    const int gw = F.vcu * NWAVES + F.wave, NGW = F.G * NWAVES;
    const float* nw = (which ? F.norm_ffn : F.norm_mix) + l * 1024;
    const float* mod = WSP(float, WS_MOD) + (size_t)l * 5 * 6144;
    bf16* H = WSP(bf16, WS_H);
    for (int chunk = gw; chunk < MT / 8; chunk += NGW) {
        const int row0 = chunk * 8; const int bidx = row0 < MLAT ? (row0 >> 12) : 4;
        const float* sh = mod + bidx * 6144 + (which ? 3 : 0) * 1024; const float* sc = mod + bidx * 6144 + (which ? 4 : 1) * 1024;
        f32x4 cw[4], cs[4];
#pragma unroll
        for (int j = 0; j < 4; ++j) { const int col = 4 * F.lane + 256 * j; const f32x4 w = *(const f32x4*)(nw + col), s1 = *(const f32x4*)(sc + col); cw[j] = w * (s1 + 1.0f); cs[j] = *(const f32x4*)(sh + col); }
        for (int r = 0; r < 8; ++r) {
            const int row = row0 + r; const float* xr = row < MLAT ? xlat + (size_t)row * 1024 : xctx + (size_t)(row - MLAT) * 1024;
            f32x4 v[4]; float ss = 0.f;
#pragma unroll
            for (int j = 0; j < 4; ++j) { v[j] = *(const f32x4*)(xr + 4 * F.lane + 256 * j); ss += (v[j].x * v[j].x + v[j].y * v[j].y) + (v[j].z * v[j].z + v[j].w * v[j].w); }
            const float rstd = 1.0f / sqrtf(wave_sum(ss) * (1.0f / 1024.0f) + EPS);
#pragma unroll
            for (int j = 0; j < 4; ++j) { v[j] = v[j] * rstd * cw[j] + cs[j];
                *(GAS unsigned long long*)(H + (size_t)row * 1024 + 4 * F.lane + 256 * j) = (unsigned long long)pk2(v[j].x, v[j].y) | ((unsigned long long)pk2(v[j].z, v[j].w) << 32); }
            if (ROUTER && row < MLAT) {
                const float* wr = F.moe_router; float lg[8];
#pragma unroll
                for (int e = 0; e < 8; ++e) lg[e] = 0.f;
#pragma unroll
                for (int j = 0; j < 4; ++j)
#pragma unroll
                    for (int i = 0; i < 4; ++i) { const float* wp = wr + (size_t)(4 * F.lane + 256 * j + i) * 8; const f32x4 w0 = *(const f32x4*)wp, w1 = *(const f32x4*)(wp + 4); const float hv = v[j][i];
                        lg[0] += hv * w0.x; lg[1] += hv * w0.y; lg[2] += hv * w0.z; lg[3] += hv * w0.w; lg[4] += hv * w1.x; lg[5] += hv * w1.y; lg[6] += hv * w1.z; lg[7] += hv * w1.w; }
#pragma unroll
                for (int e = 0; e < 8; ++e) lg[e] = wave_sum(lg[e]);
                int i0 = 0; float v0 = lg[0];
#pragma unroll
                for (int e = 1; e < 8; ++e) if (lg[e] > v0) { v0 = lg[e]; i0 = e; }
                int i1 = -1; float v1 = -INFINITY;
#pragma unroll
                for (int e = 0; e < 8; ++e) if (e != i0 && lg[e] > v1) { v1 = lg[e]; i1 = e; }
                if (F.lane == 0) { const float ex = expf(v1 - v0); const float w0 = 1.0f / (1.0f + ex);
                    WSP(int, WS_TOKE)[2 * row] = i0; WSP(int, WS_TOKE)[2 * row + 1] = i1; WSP(float, WS_TOKW)[2 * row] = w0; WSP(float, WS_TOKW)[2 * row + 1] = ex * w0; }
            }
        }
    }
}

__device__ __forceinline__ void phase_ppost(Frame& F, int l) {
    RELAUNDER(F);
    const int gw = F.vcu * NWAVES + F.wave, NGW = F.G * NWAVES; const int lane = F.lane;
    const bf16* P = WSP(bf16, WS_P); const float* rope = WSP(float, WS_ROPE);
    const float* gcos = rope; const float* gsin = rope + 1024; const float* dcos = rope + 2048; const float* dsin = rope + 2560;
    const float* qn = F.q_norm + l * 64; const float* kn = F.k_norm + l * 64;
    bf16 *GQ = WSP(bf16, WS_GQ), *GK = WSP(bf16, WS_GK), *GV = WSP(bf16, WS_GV), *DQ = WSP(bf16, WS_DQ), *DK = WSP(bf16, WS_DK), *DV = WSP(bf16, WS_DV);
    const float C2Q = 0.125f * LOG2E, C2D = 0.17677669529663687f * LOG2E;
    const int j8 = lane & 7, j4 = lane & 3;
    float qw[8], kw[8];
#pragma unroll
    for (int i = 0; i < 8; ++i) { qw[i] = qn[8 * j8 + i]; kw[i] = kn[8 * j8 + i]; }
    for (int row = gw; row < MT; row += NGW) {
        const bool isctx = row >= MLAT; const int b = isctx ? (row - MLAT) >> 8 : row >> 12; const int t = isctx ? (row - MLAT) & 255 : row & 4095;
        const int pos = isctx ? SEQ + t : t; const int gr = t >> 6, gc = t & 63;
        const bf16* pr = P + (size_t)row * NP; const size_t krow = (size_t)b * LK + pos;
        float x[8], y[8];
        unpack8(*(const v4u*)(pr + PC_GQ + 8 * lane), x);
        { float ss = 0.f;
#pragma unroll
          for (int i = 0; i < 8; ++i) ss += x[i] * x[i];
          ss += __shfl_xor(ss, 1); ss += __shfl_xor(ss, 2); ss += __shfl_xor(ss, 4);
          const float rstd = 1.0f / sqrtf(ss * (1.0f / 64.0f) + EPS);
#pragma unroll
          for (int i = 0; i < 8; ++i) x[i] = x[i] * rstd * qw[i]; }
#pragma unroll
        for (int i = 0; i < 8; ++i) y[i] = __shfl_xor(x[i], 2);
        if (!isctx) { const int pv = (j8 < 4) ? gr : gc;
#pragma unroll
            for (int i = 0; i < 8; ++i) { const int fi = 8 * (j8 & 1) + i; const float cv = gcos[pv * 16 + fi], sv = gsin[pv * 16 + fi]; x[i] = (j8 & 2) ? (y[i] * sv + x[i] * cv) : (x[i] * cv - y[i] * sv); } }
#pragma unroll
        for (int i = 0; i < 8; ++i) x[i] *= C2Q;
        *(GAS v4u*)(GQ + (size_t)row * 512 + 8 * lane) = pack8(x);
        unpack8(*(const v4u*)(pr + PC_GK + 8 * lane), x);
        { float ss = 0.f;
#pragma unroll
          for (int i = 0; i < 8; ++i) ss += x[i] * x[i];
          ss += __shfl_xor(ss, 1); ss += __shfl_xor(ss, 2); ss += __shfl_xor(ss, 4);
          const float rstd = 1.0f / sqrtf(ss * (1.0f / 64.0f) + EPS);
          if (lane < 16) {
#pragma unroll
              for (int i = 0; i < 8; ++i) x[i] = x[i] * rstd * kw[i]; } }
        { float y2[8], y1[8];
#pragma unroll
          for (int i = 0; i < 8; ++i) { y2[i] = __shfl_xor(x[i], 2); y1[i] = __shfl_xor(x[i], 1); }
          if (lane < 16) {
              if (!isctx) { const int pv = (j8 < 4) ? gr : gc;
#pragma unroll
                  for (int i = 0; i < 8; ++i) { const int fi = 8 * (j8 & 1) + i; const float cv = gcos[pv * 16 + fi], sv = gsin[pv * 16 + fi]; x[i] = (j8 & 2) ? (y2[i] * sv + x[i] * cv) : (x[i] * cv - y2[i] * sv); } }
              *(GAS v4u*)(GK + krow * 128 + 8 * lane) = pack8(x);
          } else if (lane < 32) {
              *(GAS v4u*)(GV + krow * 128 + 8 * (lane - 16)) = pack8(x);
          } else {
              if (!isctx) { const int pv = (j4 < 2) ? gr : gc;
#pragma unroll
                  for (int i = 0; i < 8; ++i) { const float cv = dcos[pv * 8 + i], sv = dsin[pv * 8 + i]; x[i] = (j4 & 1) ? (y1[i] * sv + x[i] * cv) : (x[i] * cv - y1[i] * sv); } }
#pragma unroll
              for (int i = 0; i < 8; ++i) x[i] *= C2D;
              *(GAS v4u*)(DQ + (size_t)row * 256 + 8 * (lane - 32)) = pack8(x);
          } }
        unpack8(*(const v4u*)(pr + PC_DK + 8 * lane), x);
#pragma unroll
        for (int i = 0; i < 8; ++i) y[i] = __shfl_xor(x[i], 1);
        if (lane < 32) {
            if (!isctx) { const int pv = (j4 < 2) ? gr : gc;
#pragma unroll
                for (int i = 0; i < 8; ++i) { const float cv = dcos[pv * 8 + i], sv = dsin[pv * 8 + i]; x[i] = (j4 & 1) ? (y[i] * sv + x[i] * cv) : (x[i] * cv - y[i] * sv); } }
            *(GAS v4u*)(DK + krow * 256 + 8 * lane) = pack8(x);
        } else {
            *(GAS v4u*)(DV + krow * 256 + 8 * (lane - 32)) = pack8(x);
        }
    }
}

__device__ __forceinline__ void phase_route(Frame& F) {
    RELAUNDER(F);
    const int* toke = WSP(int, WS_TOKE); const float* tokw = WSP(float, WS_TOKW);
    int* rowl = WSP(int, WS_ROWL); float* roww = WSP(float, WS_ROWW); int* pos = WSP(int, WS_POS); int* pane = WSP(int, WS_PANE);
    LAS int* cnt = (LAS int*)(F.lds + RING_OFF);
    LAS int* le = (LAS int*)(F.lds + RING_OFF + 256);
    const int per = (MLAT + F.G - 1) / F.G; const int bs = (int)blockIdx.x * per; const int be = bs + per < MLAT ? bs + per : MLAT;
    if (F.tid < 32) cnt[F.tid] = 0;
    __syncthreads();
    int tot[8], bef[8];
#pragma unroll
    for (int e = 0; e < 8; ++e) { tot[e] = 0; bef[e] = 0; }
    for (int t = F.tid; t < MLAT; t += 512) { const int e0 = toke[2 * t], e1 = toke[2 * t + 1]; const int isb = t < bs ? 1 : 0;
#pragma unroll
        for (int e = 0; e < 8; ++e) { const int hit = (e0 == e) + (e1 == e); tot[e] += hit; bef[e] += hit * isb; } }
#pragma unroll
    for (int e = 0; e < 8; ++e) {
#pragma unroll
        for (int o = 1; o < 64; o <<= 1) { tot[e] += __shfl_xor(tot[e], o); bef[e] += __shfl_xor(bef[e], o); }
        if (F.lane == 0) { __hip_atomic_fetch_add(&cnt[e], tot[e], __ATOMIC_RELAXED, __HIP_MEMORY_SCOPE_WORKGROUP); __hip_atomic_fetch_add(&cnt[8 + e], bef[e], __ATOMIC_RELAXED, __HIP_MEMORY_SCOPE_WORKGROUP); } }
    for (int t = bs + F.tid; t < be; t += 512) { le[2 * (t - bs)] = toke[2 * t]; le[2 * (t - bs) + 1] = toke[2 * t + 1]; }
    __syncthreads();
    if (F.tid == 0) { int b = 0; for (int e = 0; e < 8; ++e) { cnt[16 + e] = b; b += (cnt[e] + 255) & ~255; } cnt[24] = b; }
    __syncthreads();
    for (int t = bs + F.tid; t < be; t += 512) {
        const int j = t - bs; const int e0 = le[2 * j], e1 = le[2 * j + 1]; int p0 = 0, p1 = 0;
        for (int q = 0; q < j; ++q) { const int a = le[2 * q], b2 = le[2 * q + 1]; p0 += (a == e0) + (b2 == e0); p1 += (a == e1) + (b2 == e1); }
        const int r0 = cnt[16 + e0] + cnt[8 + e0] + p0, r1 = cnt[16 + e1] + cnt[8 + e1] + p1;
        rowl[r0] = t; roww[r0] = tokw[2 * t]; rowl[r1] = t; roww[r1] = tokw[2 * t + 1]; pos[2 * t] = r0; pos[2 * t + 1] = r1;
    }
    if (blockIdx.x == 0) {
        const int np = cnt[24] >> 8;
        for (int p = F.tid; p < 255; p += 512) { int e = 0;
#pragma unroll
            for (int q = 1; q < 8; ++q) if (p * 256 >= cnt[16 + q]) e = q;
            pane[p] = p < np ? e : 0; }
        if (F.tid == 0) pane[255] = np;
        for (int e = 0; e < 8; ++e) { const int lo = cnt[16 + e] + cnt[e], hi = cnt[16 + e + 1]; for (int r = lo + F.tid; r < hi; r += 512) { rowl[r] = 0; roww[r] = 0.f; } }
    }
    __syncthreads();
}

__device__ __forceinline__ void phase_final(Frame& F) {
    RELAUNDER(F);
    const int gw = F.vcu * NWAVES + F.wave, NGW = F.G * NWAVES;
    const bf16* Y2 = WSP(bf16, WS_Y2); const int* pos = WSP(int, WS_POS); const float* mod = WSP(float, WS_MOD) + (size_t)1 * 5 * 6144;
    f32x4 nf[4];
#pragma unroll
    for (int j = 0; j < 4; ++j) nf[j] = *(const f32x4*)(F.norm_f + 4 * F.lane + 256 * j);
    for (int row = gw; row < MLAT; row += NGW) {
        const int b = row >> 12; const float* gf = mod + b * 6144 + 5 * 1024; const int r0 = pos[2 * row], r1 = pos[2 * row + 1];
        float* xr = F.out + (size_t)row * 1024; f32x4 v[4]; float ss = 0.f;
#pragma unroll
        for (int j = 0; j < 4; ++j) { const int col = 4 * F.lane + 256 * j; const f32x4 g = *(const f32x4*)(gf + col);
            const unsigned long long a = *(const GAS unsigned long long*)(Y2 + (size_t)r0 * 1024 + col), c2 = *(const GAS unsigned long long*)(Y2 + (size_t)r1 * 1024 + col);
            f32x4 ya, yb; ya.x = bflo((unsigned)a); ya.y = bfhi((unsigned)a); ya.z = bflo((unsigned)(a >> 32)); ya.w = bfhi((unsigned)(a >> 32));
            yb.x = bflo((unsigned)c2); yb.y = bfhi((unsigned)c2); yb.z = bflo((unsigned)(c2 >> 32)); yb.w = bfhi((unsigned)(c2 >> 32));
            v[j] = *(const f32x4*)(xr + col) + g * (ya + yb);
            ss += (v[j].x * v[j].x + v[j].y * v[j].y) + (v[j].z * v[j].z + v[j].w * v[j].w); }
        const float rstd = 1.0f / sqrtf(wave_sum(ss) * (1.0f / 1024.0f) + EPS);
#pragma unroll
        for (int j = 0; j < 4; ++j) *(f32x4*)(xr + 4 * F.lane + 256 * j) = v[j] * rstd * nf[j];
    }
}

struct Args { const float* in[30]; float* out; unsigned char* ws; int ph_lo, ph_hi; };
constexpr int PH_PRO = 0, PH_L0 = 9, PH_NORM1 = 1, PH_INPROJ = 2, PH_PPOST = 3, PH_G2 = 4, PH_ATTN = 5, PH_OUTPROJ = 6, PH_NORM2 = 7, PH_F1 = 8, PH_F2 = 9, PH_F3 = 10, PH_F4 = 11;
constexpr int N_PHASES = 1 + 9 + 11;
constexpr bool ALIGN_EPI = true, SP2 = true;

__global__ void __launch_bounds__(NWAVES * 64, 2) mk_fwd(Args args) {
    extern __shared__ __attribute__((aligned(16))) unsigned char lds[];
    Frame F;
    F.lds = (LAS unsigned char*)lds; F.MISC = (volatile LAS unsigned*)(F.lds + MISC_OFF);
    F.tid = threadIdx.x; F.lane = F.tid & 63; F.wave = __builtin_amdgcn_readfirstlane(F.tid >> 6);
    F.G = gridDim.x; { const int bx = blockIdx.x; F.vcu = (F.G % 8 == 0) ? (bx % 8) * (F.G / 8) + bx / 8 : bx; }
    F.ws = args.ws; F.out = args.out; F.ctl = (gu32*)(args.ws + WS_CTL);
    F.x = args.in[0]; F.c = args.in[1]; F.ctx = args.in[2]; F.c_ctx = args.in[3]; F.w_mod = args.in[4]; F.b_mod = args.in[5]; F.norm_mix = args.in[6]; F.norm_ffn = args.in[7];
    F.w_in = args.in[8]; F.w_out = args.in[9]; F.a2_f = args.in[10]; F.ab_f = args.in[11]; F.a2_b = args.in[12]; F.ab_b = args.in[13]; F.gla_norm = args.in[14]; F.q_norm = args.in[15]; F.k_norm = args.in[16];
    F.lq1 = args.in[17]; F.lk1 = args.in[18]; F.lq2 = args.in[19]; F.lk2 = args.in[20]; F.diff_norm = args.in[21]; F.ffn_gate = args.in[22]; F.ffn_up = args.in[23]; F.ffn_down = args.in[24];
    F.moe_router = args.in[25]; F.moe_gate = args.in[26]; F.moe_up = args.in[27]; F.moe_down = args.in[28]; F.norm_f = args.in[29];
    for (int u = F.tid; u < (LDS_BYTES - LDSCTL_OFF) / 4; u += NWAVES * 64) ((LAS unsigned*)(F.lds + LDSCTL_OFF))[u] = 0u;
    __syncthreads();
#if MK_ONE_LAUNCH
    XcdBarrier bar = xcd_barrier_post((unsigned*)(F.ctl + CW_BAR), F.MISC + 8);
#define GRID_BAR() xcd_barrier(bar)
#else
#define GRID_BAR() do { } while (0)
#endif
    const int lo = args.ph_lo, hi = args.ph_hi;
#ifndef PHMASK
#define PHMASK 0xFFFFFFFFu
#endif
#define PM(b) ((PHMASK >> (b)) & 1u)
#define IN(k) (lo <= (k) && (k) < hi)
#define SEAM(k) do { if (IN((k) + 1)) GRID_BAR(); } while (0)

    if (PM(0) && IN(PH_PRO)) { p0_prologue(F); SEAM(PH_PRO); }

    for (int l = 0; l < 2; ++l) {
        const int pb = l * PH_L0;
        const float* xlat = l == 0 ? F.x : F.out; const float* xctx = l == 0 ? F.ctx : WSP(float, WS_XCTX);
        const float* mod = WSP(float, WS_MOD) + (size_t)l * 5 * 6144;
        if (PM(1) && IN(pb + PH_NORM1)) { phase_norm<false>(F, l, 0, xlat, xctx); SEAM(pb + PH_NORM1); }
        if (PM(2) && IN(pb + PH_INPROJ)) {
            pg8::Gemm g{WSP(bf16, WS_H), WSP(bf16, WS_WIN) + (size_t)l * NP * D, MT, NP, D}; pg8::StaticOrder S; S.init(MT, NP, F.G, (int)blockIdx.x);
            pg8::EpiStoreBf16 E{WSP(bf16, WS_P), NP};
            pg8::gemm_phase<pg8::EpiStoreBf16, pg8::StaticOrder, ALIGN_EPI, SP2>(F.lds + RING_OFF, g, S, E);
            SEAM(pb + PH_INPROJ);
        }
        if (PM(3) && IN(pb + PH_PPOST)) {
            for (int u = blockIdx.x; u < NB * 4 * NCH; u += F.G) { const int c = u % NCH, bh = u / NCH;
                gla::g1_unit(F.lds + RING_OFF, WSP(bf16, WS_P), bh >> 2, bh & 3, c, F.ab_f + l * 128, F.ab_b + l * 128, WSP(float, WS_KV), WSP(float, WS_DEC)); }
            __syncthreads();
            phase_ppost(F, l);
            SEAM(pb + PH_PPOST);
        }
        if (PM(4) && IN(pb + PH_G2)) { gla::g2_scan(WSP(float, WS_KV), WSP(float, WS_DEC), (int)blockIdx.x * 512 + F.tid, F.G * 512); SEAM(pb + PH_G2); }
        if (PM(5) && IN(pb + PH_ATTN)) {
            const float linit = 0.8f - 0.6f * expf(-0.3f * (float)l);
            float s1 = 0.f, s2 = 0.f;
            for (int i = 0; i < 32; ++i) { s1 += F.lq1[l * 32 + i] * F.lk1[l * 32 + i]; s2 += F.lq2[l * 32 + i] * F.lk2[l * 32 + i]; }
            const float lam = expf(s1) - expf(s2) + linit;
            bf16* MIX = WSP(bf16, WS_MIX);
            const bf16 *GQ = WSP(bf16, WS_GQ), *GK = WSP(bf16, WS_GK), *GV = WSP(bf16, WS_GV), *DQ = WSP(bf16, WS_DQ), *DK = WSP(bf16, WS_DK), *DV = WSP(bf16, WS_DV);
            const int n_gqa = NB * 8 * 16, n_diff = NB * 4 * 16, n_cg = l == 0 ? NB * 8 : 0, n_cd = l == 0 ? NB * 4 : 0;
            const int n_att = n_gqa + n_diff + n_cg + n_cd;
            for (int u = blockIdx.x; u < n_att; u += F.G) {
                if (u < n_gqa) { const int qb = u & 15, hq = (u >> 4) & 7, b = u >> 7; const size_t r0 = (size_t)b * SEQ + qb * 256;
                    att::gqa_unit(F.lds + RING_OFF, GQ + r0 * 512 + hq * 64, 512, GK + (size_t)b * LK * 128 + (hq >> 2) * 64, GV + (size_t)b * LK * 128 + (hq >> 2) * 64, 128, LK / 64, MIX + r0 * 1024 + 256 + hq * 64, 1024); }
                else if (u < n_gqa + n_diff) { const int v = u - n_gqa; const int qb = v & 15, h = (v >> 4) & 3, b = v >> 6; const size_t r0 = (size_t)b * SEQ + qb * 256;
                    att::diff_unit(F.lds + RING_OFF, DQ + r0 * 256 + h * 64, 256, DK + (size_t)b * LK * 256 + h * 64, 256, DV + (size_t)b * LK * 256 + h * 64, 256, LK / 64, lam, F.diff_norm + l * 64, 1.0f - linit, MIX + r0 * 1024 + 768 + h * 64, 1024); }
                else if (u < n_gqa + n_diff + n_cg) { const int v = u - n_gqa - n_diff; const int hq = v & 7, b = v >> 3; const size_t r0 = (size_t)MLAT + b * CTXL; const size_t k0 = (size_t)b * LK + SEQ;
                    att::gqa_unit(F.lds + RING_OFF, GQ + r0 * 512 + hq * 64, 512, GK + k0 * 128 + (hq >> 2) * 64, GV + k0 * 128 + (hq >> 2) * 64, 128, CTXL / 64, MIX + r0 * 1024 + 256 + hq * 64, 1024); }
                else { const int v = u - n_gqa - n_diff - n_cg; const int h = v & 3, b = v >> 2; const size_t r0 = (size_t)MLAT + b * CTXL; const size_t k0 = (size_t)b * LK + SEQ;
                    att::diff_unit(F.lds + RING_OFF, DQ + r0 * 256 + h * 64, 256, DK + k0 * 256 + h * 64, 256, DV + k0 * 256 + h * 64, 256, CTXL / 64, lam, F.diff_norm + l * 64, 1.0f - linit, MIX + r0 * 1024 + 768 + h * 64, 1024); }
            }
            __syncthreads();
            for (int u = blockIdx.x; u < NB * 4 * NCH; u += F.G) { const int c = u % NCH, bh = u / NCH; if (l == 1 && c < 4) continue;
                gla::g3_unit(F.lds + RING_OFF, WSP(bf16, WS_P), bh >> 2, bh & 3, c, F.ab_f + l * 128, F.ab_b + l * 128, WSP(float, WS_KV), F.gla_norm + l * 64, MIX); }
            SEAM(pb + PH_ATTN);
        }
        if (PM(6) && IN(pb + PH_OUTPROJ)) {
            const int M = l == 0 ? MT : MLAT;
            pg8::Gemm g{WSP(bf16, WS_MIX), WSP(bf16, WS_WOUT) + (size_t)l * D * D, M, D, D}; pg8::StaticOrder S; S.init(M, D, F.G, (int)blockIdx.x);
            pg8::EpiResid E{xlat, xctx, F.out, WSP(float, WS_XCTX), mod + 2 * 1024};
            pg8::gemm_phase<pg8::EpiResid, pg8::StaticOrder, ALIGN_EPI, SP2>(F.lds + RING_OFF, g, S, E);
            SEAM(pb + PH_OUTPROJ);
        }
        if (l == 0) {
            if (PM(7) && IN(pb + PH_NORM2)) { phase_norm<false>(F, l, 1, F.out, WSP(float, WS_XCTX)); SEAM(pb + PH_NORM2); }
            if (PM(8) && IN(pb + PH_F1)) {
                pg8::Gemm g{WSP(bf16, WS_H), WSP(bf16, WS_WGU), MT, 2 * DFF, D}; pg8::StaticOrder S; S.init(MT, 2 * DFF, F.G, (int)blockIdx.x);
                pg8::EpiSwiGLU E{WSP(bf16, WS_ACT), DFF, 0};
                pg8::gemm_phase<pg8::EpiSwiGLU, pg8::StaticOrder, ALIGN_EPI, SP2>(F.lds + RING_OFF, g, S, E);
                SEAM(pb + PH_F1);
            }
            if (PM(9) && IN(pb + PH_F2)) {
                pg8::Gemm g{WSP(bf16, WS_ACT), WSP(bf16, WS_WDN), MT, D, DFF}; pg8::StaticOrder S; S.init(MT, D, F.G, (int)blockIdx.x);
                pg8::EpiResid E{F.out, WSP(float, WS_XCTX), F.out, WSP(float, WS_XCTX), mod + 5 * 1024};
                pg8::gemm_phase<pg8::EpiResid, pg8::StaticOrder, ALIGN_EPI, SP2>(F.lds + RING_OFF, g, S, E);
                SEAM(pb + PH_F2);
            }
        } else {
            if (PM(10) && IN(pb + PH_NORM2)) { phase_norm<true>(F, l, 1, F.out, WSP(float, WS_XCTX)); SEAM(pb + PH_NORM2); }
            if (PM(11) && IN(pb + PH_F1)) { phase_route(F); SEAM(pb + PH_F1); }
            if (PM(12) && IN(pb + PH_F2)) {
                const int* pane = WSP(int, WS_PANE); const int np = pane[255];
                pg8::Gemm g{WSP(bf16, WS_H), WSP(bf16, WS_MGU), np * 256, 2 * DFFE, D}; pg8::MoeOrder S; S.init(np, 2 * DFFE / 256, F.G, (int)blockIdx.x, pane);
                pg8::EpiSwiGLU E{WSP(bf16, WS_ACT2), DFFE, 2 * DFFE / 256};
                pg8::gemm_phase_gather<pg8::EpiSwiGLU, pg8::MoeOrder>(F.lds + RING_OFF, g, S, E, WSP(int, WS_ROWL));
                SEAM(pb + PH_F2);
            }
            if (PM(13) && IN(pb + PH_F3)) {
                const int* pane = WSP(int, WS_PANE); const int np = pane[255];
                pg8::Gemm g{WSP(bf16, WS_ACT2), WSP(bf16, WS_MDN), np * 256, D, DFFE}; pg8::MoeOrder S; S.init(np, D / 256, F.G, (int)blockIdx.x, pane);
                pg8::EpiMoeDown E{WSP(bf16, WS_Y2), WSP(float, WS_ROWW), D / 256};
                pg8::gemm_phase<pg8::EpiMoeDown, pg8::MoeOrder, ALIGN_EPI, SP2>(F.lds + RING_OFF, g, S, E);
                SEAM(pb + PH_F3);
            }
            if (PM(14) && IN(pb + PH_F4)) { phase_final(F); }
        }
    }
#undef IN
#undef SEAM
}

extern "C" void kernel_launch(void* const* d_in, const int* in_sizes, int n_in, void* d_out, int out_size, void* d_ws, size_t ws_size, hipStream_t stream) {
    static int grid = 0;
    if (grid == 0) {
        if (n_in != 30 || out_size != MLAT * D || ws_size < WS_END) { fprintf(stderr, "kernel_launch: expected 30 inputs, %d outputs, >= %zu bytes of workspace; got %d, %d, %zu; nothing launched\n", MLAT * D, (size_t)WS_END, n_in, out_size, ws_size); grid = -1; return; }
        int dev = 0, cus = 0, per_cu = 0;
        if (hipGetDevice(&dev) != hipSuccess || hipDeviceGetAttribute(&cus, hipDeviceAttributeMultiprocessorCount, dev) != hipSuccess) { fprintf(stderr, "kernel_launch: device query failed\n"); grid = -1; return; }
        if (hipFuncSetAttribute((const void*)mk_fwd, hipFuncAttributeMaxDynamicSharedMemorySize, LDS_BYTES) != hipSuccess) { fprintf(stderr, "kernel_launch: hipFuncSetAttribute failed\n"); grid = -1; return; }
        if (hipOccupancyMaxActiveBlocksPerMultiprocessor(&per_cu, (const void*)mk_fwd, NWAVES * 64, LDS_BYTES) != hipSuccess || per_cu < 1)
            fprintf(stderr, "kernel_launch: note: occupancy query reports %d workgroups per CU\n", per_cu);
        (void)hipGetLastError();
        grid = cus;
    }
    if (grid < 0) return;
    if (hipMemsetAsync((char*)d_ws + WS_CTL, 0, CTL_ZERO_BYTES, stream) != hipSuccess) { fprintf(stderr, "kernel_launch: hipMemsetAsync failed\n"); return; }
    Args a{};
    for (int i = 0; i < 30; ++i) a.in[i] = (const float*)d_in[i];
    a.out = (float*)d_out; a.ws = (unsigned char*)d_ws;
#if MK_ONE_LAUNCH
    a.ph_lo = 0; a.ph_hi = N_PHASES;
    hipLaunchKernelGGL(mk_fwd, dim3(grid), dim3(NWAVES * 64), LDS_BYTES, stream, a);
#else
    for (int ph = 0; ph < N_PHASES; ++ph) { a.ph_lo = ph; a.ph_hi = ph + 1; hipLaunchKernelGGL(mk_fwd, dim3(grid), dim3(NWAVES * 64), LDS_BYTES, stream, a); }
#endif
    const hipError_t le = hipPeekAtLastError();
    if (le != hipSuccess) fprintf(stderr, "kernel_launch: launch failed: %s\n", hipGetErrorName(le));
}
```

```cpp
#include <hip/hip_runtime.h>
#include <cstdio>
#include <cstdint>
#include <cmath>

#define REPMASK_SET 0x0u
#ifndef REPMASK
#define REPMASK REPMASK_SET
#endif
#ifndef MK_ONE_LAUNCH
#define MK_ONE_LAUNCH 1
#endif

constexpr int D = 1024, NB = 4, SEQ = 4096, CTXL = 256;
constexpr int MLAT = NB * SEQ, MCTX = NB * CTXL, MT = MLAT + MCTX;
constexpr int LK = SEQ + CTXL;
constexpr int NP = 2560;
constexpr int INW = 2336;
constexpr int DFF = 2816, NE = 8, DFFE = 3584;
constexpr int MOE_ROWS = 34816;
constexpr int NCH = 68;
constexpr float EPS = 1e-6f;
constexpr float LOG2E = 1.4426950408889634f;
constexpr int PC_GLQ = 0, PC_GLK = 128, PC_GLV = 256, PC_GLR = 512, PC_ZF = 768, PC_ZB = 896, PC_GQ = 1024, PC_GK = 1536, PC_GV = 1664, PC_DQ = 1792, PC_DK = 2048, PC_DV = 2304;

__device__ __forceinline__ int ltid() { int t = threadIdx.x; asm volatile("" : "+v"(t)); return t; }

__device__ __forceinline__ int opaque_s(int x) { asm volatile("" : "+s"(x)); return x; }

namespace pg8 {
#define PG8_LAS __attribute__((address_space(3)))
typedef unsigned short bf16_t;
typedef short bf16x8 __attribute__((ext_vector_type(8)));
typedef float f32x4 __attribute__((ext_vector_type(4)));
typedef unsigned u32x4 __attribute__((ext_vector_type(4)));
constexpr int BM = 256, BK = 64, HALF = 128, HTB = HALF * BK * 2  , STAGE_BYTES = 8 * HTB, NXCD = 8, WGM = 8;

__host__ __device__ __forceinline__ int lds_byte(int r, int c) { const int st = (r >> 4) * 2 + (c >> 5), rr = r & 15, cc = c & 31, ob = rr * 64 + cc * 2; return st * 1024 + (ob ^ (((ob >> 9) & 1) << 5)); }
__host__ __device__ __forceinline__ void stage_rc(int b, int& R, int& C) { const int st = b / 1024, sb = b % 1024, swz = sb ^ (((sb >> 9) & 1) << 5); R = (st >> 1) * 16 + swz / 64; C = (st & 1) * 32 + (swz % 64) / 2; }
__host__ __device__ __forceinline__ int perm32(int rho) { const int n = rho >> 4, i = rho & 15; return 8 * (i >> 2) + 4 * n + (i & 3); }

struct Unit { int pm, pn; };
struct Gemm { const bf16_t* A; const bf16_t* Bt; int M, N, K; };

struct StaticOrder {
    int nM, nN, nwg, G, c;
    __host__ __device__ __forceinline__ void init(int M, int N, int G_, int c_) { nM = M / BM; nN = N / BM; nwg = nM * nN; G = G_; c = c_; }
    __host__ __device__ __forceinline__ bool next(int i, Unit& u) const {
        const long L = (long)i * G + c; if (L >= nwg) return false;
        int wgid = (int)L; { const int q = nwg / NXCD, r = nwg % NXCD, xcd = wgid % NXCD, off = wgid / NXCD; wgid = (xcd < r ? xcd * (q + 1) : r * (q + 1) + (xcd - r) * q) + off; }
        const int nig = WGM * nN, gid = wgid / nig, fm = gid * WGM, gsz = (nM - fm) < WGM ? (nM - fm) : WGM;
        u.pm = fm + ((wgid % nig) % gsz); u.pn = (wgid % nig) / gsz; return true;
    }
    __device__ __forceinline__ void a_ready(const Unit&) const {}
    __device__ __forceinline__ void done(const Unit&) const {}
};


__device__ __forceinline__ unsigned cvt_pk_bf16(float lo, float hi) { unsigned r; asm volatile("v_cvt_pk_bf16_f32 %0, %1, %2" : "=v"(r) : "v"(lo), "v"(hi)); return r; }

struct EpiStoreBf16 {
    static constexpr bool PERM = true, AFTER_DRAIN = false;
    bf16_t* O; int ldc;
    __device__ __forceinline__ void operator()(const f32x4 (&acc)[2][2][4][2], const Unit& u, int wr, int wc, int fr_in, int fq_in) const {
        int fr = fr_in, fq = fq_in; asm volatile("" : "+v"(fr), "+v"(fq));
        const int row0 = u.pm * BM + wr * 64 + fr, col0 = u.pn * BM + wc * 32 + 8 * fq;
#pragma unroll
        for (int ai = 0; ai < 2; ++ai)
#pragma unroll
            for (int m = 0; m < 4; ++m) { bf16_t* rowp = O + (size_t)(row0 + ai * HALF + m * 16) * ldc + col0;
#pragma unroll
                for (int bj = 0; bj < 2; ++bj) { const f32x4 v0 = acc[ai][bj][m][0], v1 = acc[ai][bj][m][1];
                    u32x4 w; w.x = cvt_pk_bf16(v0[0], v0[1]); w.y = cvt_pk_bf16(v0[2], v0[3]); w.z = cvt_pk_bf16(v1[0], v1[1]); w.w = cvt_pk_bf16(v1[2], v1[3]);
                    *(u32x4*)(rowp + bj * HALF) = w; } }
    }
};

struct EpiResid {
    static constexpr bool PERM = false, AFTER_DRAIN = false;
    const float* base_lat; const float* base_ctx; float* out_lat; float* out_ctx; const float* gate;
    __device__ __forceinline__ void operator()(const f32x4 (&acc)[2][2][4][2], const Unit& u, int wr, int wc, int fr_in, int fq_in) const {
        int fr = fr_in, fq = fq_in; asm volatile("" : "+v"(fr), "+v"(fq));
        const int r0 = u.pm * BM; const bool isctx = r0 >= 16384; const int bidx = isctx ? 4 : (r0 >> 12);
        const float* base = isctx ? base_ctx + (size_t)(r0 - 16384) * 1024 : base_lat + (size_t)r0 * 1024;
        float* out = isctx ? out_ctx + (size_t)(r0 - 16384) * 1024 : out_lat + (size_t)r0 * 1024;
        const int col0 = u.pn * BM + wc * 32 + 4 * fq;
        const float* g = gate + bidx * 6144 + col0;
        f32x4 gv[2][2];
#pragma unroll
        for (int bj = 0; bj < 2; ++bj)
#pragma unroll
            for (int n = 0; n < 2; ++n) gv[bj][n] = *(const f32x4*)(g + bj * HALF + n * 16);
#pragma unroll
        for (int ai = 0; ai < 2; ++ai) {
            f32x4 bs[4][2][2];
#pragma unroll
            for (int m = 0; m < 4; ++m) { const size_t off = (size_t)(ai * HALF + wr * 64 + m * 16 + fr) * 1024 + col0;
#pragma unroll
                for (int bj = 0; bj < 2; ++bj)
#pragma unroll
                    for (int n = 0; n < 2; ++n) bs[m][bj][n] = *(const f32x4*)(base + off + bj * HALF + n * 16); }
            asm volatile("" ::: "memory");
#pragma unroll
            for (int m = 0; m < 4; ++m) { const size_t off = (size_t)(ai * HALF + wr * 64 + m * 16 + fr) * 1024 + col0;
#pragma unroll
                for (int bj = 0; bj < 2; ++bj)
#pragma unroll
                    for (int n = 0; n < 2; ++n) *(f32x4*)(out + off + bj * HALF + n * 16) = bs[m][bj][n] + gv[bj][n] * acc[ai][bj][m][n]; }
            asm volatile("" ::: "memory");
        }
    }
};

typedef float f32x2q __attribute__((ext_vector_type(2)));
__device__ __forceinline__ f32x2q silu_mul2b(f32x2q g, f32x2q u) {
    const f32x2q a = g * (-1.4426950408889634f); f32x2q e; e.x = __builtin_amdgcn_exp2f(a.x); e.y = __builtin_amdgcn_exp2f(a.y);
    const f32x2q d = e + 1.0f; f32x2q r; r.x = __builtin_amdgcn_rcpf(d.x); r.y = __builtin_amdgcn_rcpf(d.y);
    return (g * u) * r;
}
__device__ __forceinline__ float silu_mul(float g, float up) { const float e = __builtin_amdgcn_exp2f(-g * 1.4426950408889634f); return g * __builtin_amdgcn_rcpf(1.0f + e) * up; }

struct EpiSwiGLU {
    static constexpr bool PERM = true, AFTER_DRAIN = false;
    bf16_t* O; int ldc; int nN;
    __device__ __forceinline__ void operator()(const f32x4 (&acc)[2][2][4][2], const Unit& u, int wr, int wc, int fr_in, int fq_in) const {
        int fr = fr_in, fq = fq_in; asm volatile("" : "+v"(fr), "+v"(fq));
        const int pnr = nN ? (u.pn % nN) : u.pn;
        const int row0 = u.pm * BM + wr * 64 + fr, col0 = pnr * HALF + wc * 32 + 8 * fq;
#pragma unroll
        for (int ai = 0; ai < 2; ++ai)
#pragma unroll
            for (int m = 0; m < 4; ++m) { bf16_t* rowp = O + (size_t)(row0 + ai * HALF + m * 16) * ldc + col0;
                const f32x4 g0 = acc[ai][0][m][0], g1 = acc[ai][0][m][1], u0 = acc[ai][1][m][0], u1 = acc[ai][1][m][1];
                const f32x2q a0 = silu_mul2b((f32x2q){g0[0], g0[1]}, (f32x2q){u0[0], u0[1]}), a1 = silu_mul2b((f32x2q){g0[2], g0[3]}, (f32x2q){u0[2], u0[3]});
                const f32x2q a2 = silu_mul2b((f32x2q){g1[0], g1[1]}, (f32x2q){u1[0], u1[1]}), a3 = silu_mul2b((f32x2q){g1[2], g1[3]}, (f32x2q){u1[2], u1[3]});
                u32x4 w; w.x = cvt_pk_bf16(a0.x, a0.y); w.y = cvt_pk_bf16(a1.x, a1.y); w.z = cvt_pk_bf16(a2.x, a2.y); w.w = cvt_pk_bf16(a3.x, a3.y);
                *(u32x4*)rowp = w; }
    }
};

__device__ __forceinline__ float clamp448(float x) { return __builtin_fminf(__builtin_fmaxf(x, -448.0f), 448.0f); }
__device__ __forceinline__ unsigned pack_fp8x4(float a, float b, float c, float d) { int w = 0; w = __builtin_amdgcn_cvt_pk_fp8_f32(clamp448(a), clamp448(b), w, false); w = __builtin_amdgcn_cvt_pk_fp8_f32(clamp448(c), clamp448(d), w, true); return (unsigned)w; }
typedef float f32x2p __attribute__((ext_vector_type(2)));
__device__ __forceinline__ f32x2p silu_mul2(f32x2p g, f32x2p u, float mul) {
    const f32x2p a = g * (-1.4426950408889634f); f32x2p e; e.x = __builtin_amdgcn_exp2f(a.x); e.y = __builtin_amdgcn_exp2f(a.y);
    const f32x2p d = e + 1.0f; f32x2p r; r.x = __builtin_amdgcn_rcpf(d.x); r.y = __builtin_amdgcn_rcpf(d.y);
    f32x2p t = (g * u) * (r * mul); t.x = __builtin_amdgcn_fmed3f(t.x, -448.0f, 448.0f); t.y = __builtin_amdgcn_fmed3f(t.y, -448.0f, 448.0f); return t;
}
__device__ __forceinline__ unsigned pack_fp8x4_noclamp(f32x2p a, f32x2p b) { int w = 0; w = __builtin_amdgcn_cvt_pk_fp8_f32(a.x, a.y, w, false); w = __builtin_amdgcn_cvt_pk_fp8_f32(b.x, b.y, w, true); return (unsigned)w; }
struct EpiSwiGLU8 {
    static constexpr bool PERM = true, AFTER_DRAIN = false;
    unsigned char* O; int ldc; int nN; float mul;
    __device__ __forceinline__ void operator()(const f32x4 (&acc)[2][2][4][2], const Unit& u, int wr, int wc, int fr_in, int fq_in) const {
        int fr = fr_in, fq = fq_in; asm volatile("" : "+v"(fr), "+v"(fq));
        const int pnr = nN ? (u.pn % nN) : u.pn;
        const int row0 = u.pm * BM + wr * 64 + fr, col0 = pnr * HALF + wc * 32 + 8 * fq;
#pragma unroll
        for (int ai = 0; ai < 2; ++ai)
#pragma unroll
            for (int m = 0; m < 4; ++m) { unsigned char* rowp = O + (size_t)(row0 + ai * HALF + m * 16) * ldc + col0;
                const f32x4 g0 = acc[ai][0][m][0], g1 = acc[ai][0][m][1], u0 = acc[ai][1][m][0], u1 = acc[ai][1][m][1];
                typedef unsigned u32x2 __attribute__((ext_vector_type(2))); u32x2 w;
                w.x = pack_fp8x4_noclamp(silu_mul2((f32x2p){g0[0], g0[1]}, (f32x2p){u0[0], u0[1]}, mul), silu_mul2((f32x2p){g0[2], g0[3]}, (f32x2p){u0[2], u0[3]}, mul));
                w.y = pack_fp8x4_noclamp(silu_mul2((f32x2p){g1[0], g1[1]}, (f32x2p){u1[0], u1[1]}, mul), silu_mul2((f32x2p){g1[2], g1[3]}, (f32x2p){u1[2], u1[3]}, mul));
                *(u32x2*)rowp = w; }
    }
};

struct EpiMoeDown {
    static constexpr bool PERM = true, AFTER_DRAIN = false;
    bf16_t* O; const float* roww; int nN;
    __device__ __forceinline__ void operator()(const f32x4 (&acc)[2][2][4][2], const Unit& u, int wr, int wc, int fr_in, int fq_in) const {
        int fr = fr_in, fq = fq_in; asm volatile("" : "+v"(fr), "+v"(fq));
        const int pnr = u.pn % nN;
        const int row0 = u.pm * BM + wr * 64 + fr, col0 = pnr * BM + wc * 32 + 8 * fq;
#pragma unroll
        for (int ai = 0; ai < 2; ++ai)
#pragma unroll
            for (int m = 0; m < 4; ++m) { const int row = row0 + ai * HALF + m * 16; const float wgt = roww[row]; bf16_t* rowp = O + (size_t)row * 1024 + col0;
#pragma unroll
                for (int bj = 0; bj < 2; ++bj) { const f32x4 v0 = acc[ai][bj][m][0] * wgt, v1 = acc[ai][bj][m][1] * wgt;
                    u32x4 w; w.x = cvt_pk_bf16(v0[0], v0[1]); w.y = cvt_pk_bf16(v0[2], v0[3]); w.z = cvt_pk_bf16(v1[0], v1[1]); w.w = cvt_pk_bf16(v1[2], v1[3]);
                    *(u32x4*)(rowp + bj * HALF) = w; } }
    }
};


struct EpiResidNorm {
    static constexpr bool PERM = false, AFTER_DRAIN = false;
    const float* base_lat; const float* base_ctx; float* out_lat; float* out_ctx; const float* gate;
    bf16_t* H; float* ss; const float* nw; const float* sc;
    __device__ __forceinline__ void operator()(const f32x4 (&acc)[2][2][4][2], const Unit& u, int wr, int wc, int fr_in, int fq_in) const {
        int fr = fr_in, fq = fq_in; asm volatile("" : "+v"(fr), "+v"(fq));
        const int r0 = u.pm * BM; const bool isctx = r0 >= 16384; const int bidx = isctx ? 4 : (r0 >> 12);
        const float* base = isctx ? base_ctx + (size_t)(r0 - 16384) * 1024 : base_lat + (size_t)r0 * 1024;
        float* out = isctx ? out_ctx + (size_t)(r0 - 16384) * 1024 : out_lat + (size_t)r0 * 1024;
        const int col0 = u.pn * BM + wc * 32 + 4 * fq;
        float ssq[8];
#pragma unroll
        for (int i = 0; i < 8; ++i) ssq[i] = 0.f;
#pragma unroll
        for (int bj = 0; bj < 2; ++bj)
#pragma unroll
            for (int n = 0; n < 2; ++n) { const int col = col0 + bj * HALF + n * 16;
                const f32x4 gv = *(const f32x4*)(gate + bidx * 6144 + col); const f32x4 cw = *(const f32x4*)(nw + col) * (*(const f32x4*)(sc + bidx * 6144 + col) + 1.0f);
#pragma unroll
                for (int ai = 0; ai < 2; ++ai)
#pragma unroll
                    for (int m = 0; m < 4; ++m) { const int rl = ai * HALF + wr * 64 + m * 16 + fr; const size_t off = (size_t)rl * 1024 + col;
                        const f32x4 x = *(const f32x4*)(base + off) + gv * acc[ai][bj][m][n];
                        *(f32x4*)(out + off) = x;
                        const f32x4 h = x * cw; typedef unsigned u32x2 __attribute__((ext_vector_type(2))); u32x2 w; w.x = cvt_pk_bf16(h[0], h[1]); w.y = cvt_pk_bf16(h[2], h[3]);
                        *(u32x2*)(H + (size_t)(r0 + rl) * 1024 + col) = w;
                        ssq[ai * 4 + m] += (x[0] * x[0] + x[1] * x[1]) + (x[2] * x[2] + x[3] * x[3]);
                        if (m == 3) asm volatile("" ::: "memory"); } }
#pragma unroll
        for (int i = 0; i < 8; ++i) { float v = ssq[i]; v += __shfl_xor(v, 16); v += __shfl_xor(v, 32);
            if (fq == 0) atomicAdd(ss + r0 + (i >> 2) * HALF + wr * 64 + (i & 3) * 16 + fr, v); }
    }
};
struct EpiSwiGLUN {
    static constexpr bool PERM = true, AFTER_DRAIN = false;
    bf16_t* O; int ldc; const float* ss; const float* bias;
    __device__ __forceinline__ void operator()(const f32x4 (&acc)[2][2][4][2], const Unit& u, int wr, int wc, int fr_in, int fq_in) const {
        int fr = fr_in, fq = fq_in; asm volatile("" : "+v"(fr), "+v"(fq));
        const int r0 = u.pm * BM; const int bidx = r0 >= 16384 ? 4 : (r0 >> 12);
        const int row0 = r0 + wr * 64 + fr, col0 = u.pn * HALF + wc * 32 + 8 * fq;
        const float* bp = bias + (size_t)bidx * (2 * ldc) + u.pn * BM + wc * 32 + 8 * fq;
        const f32x4 bg0 = *(const f32x4*)bp, bg1 = *(const f32x4*)(bp + 4), bu0 = *(const f32x4*)(bp + HALF), bu1 = *(const f32x4*)(bp + HALF + 4);
#pragma unroll
        for (int ai = 0; ai < 2; ++ai)
#pragma unroll
            for (int m = 0; m < 4; ++m) { const int row = row0 + ai * HALF + m * 16; const float rstd = 1.0f / sqrtf(ss[row] * (1.0f / 1024.0f) + 1e-6f);
                bf16_t* rowp = O + (size_t)row * ldc + col0;
                const f32x4 g0 = acc[ai][0][m][0] * rstd + bg0, g1 = acc[ai][0][m][1] * rstd + bg1, u0 = acc[ai][1][m][0] * rstd + bu0, u1 = acc[ai][1][m][1] * rstd + bu1;
                u32x4 w; w.x = cvt_pk_bf16(silu_mul(g0[0], u0[0]), silu_mul(g0[1], u0[1])); w.y = cvt_pk_bf16(silu_mul(g0[2], u0[2]), silu_mul(g0[3], u0[3]));
                w.z = cvt_pk_bf16(silu_mul(g1[0], u1[0]), silu_mul(g1[1], u1[1])); w.w = cvt_pk_bf16(silu_mul(g1[2], u1[2]), silu_mul(g1[3], u1[3]));
                *(u32x4*)rowp = w; }
    }
};
struct EpiStoreBf16N {
    static constexpr bool PERM = true, AFTER_DRAIN = false;
    bf16_t* O; int ldc; const float* ss; const float* bias;
    __device__ __forceinline__ void operator()(const f32x4 (&acc)[2][2][4][2], const Unit& u, int wr, int wc, int fr_in, int fq_in) const {
        int fr = fr_in, fq = fq_in; asm volatile("" : "+v"(fr), "+v"(fq));
        const int r0 = u.pm * BM; const int bidx = r0 >= 16384 ? 4 : (r0 >> 12);
        const int row0 = r0 + wr * 64 + fr, col0 = u.pn * BM + wc * 32 + 8 * fq;
        const float* bp = bias + (size_t)bidx * ldc + col0;
        const f32x4 b00 = *(const f32x4*)bp, b01 = *(const f32x4*)(bp + 4), b10 = *(const f32x4*)(bp + HALF), b11 = *(const f32x4*)(bp + HALF + 4);
#pragma unroll
        for (int ai = 0; ai < 2; ++ai)
#pragma unroll
            for (int m = 0; m < 4; ++m) { const int row = row0 + ai * HALF + m * 16; const float rstd = 1.0f / sqrtf(ss[row] * (1.0f / 1024.0f) + 1e-6f);
                bf16_t* rowp = O + (size_t)row * ldc + col0;
                { const f32x4 v0 = acc[ai][0][m][0] * rstd + b00, v1 = acc[ai][0][m][1] * rstd + b01;
                  u32x4 w; w.x = cvt_pk_bf16(v0[0], v0[1]); w.y = cvt_pk_bf16(v0[2], v0[3]); w.z = cvt_pk_bf16(v1[0], v1[1]); w.w = cvt_pk_bf16(v1[2], v1[3]); *(u32x4*)rowp = w; }
                { const f32x4 v0 = acc[ai][1][m][0] * rstd + b10, v1 = acc[ai][1][m][1] * rstd + b11;
                  u32x4 w; w.x = cvt_pk_bf16(v0[0], v0[1]); w.y = cvt_pk_bf16(v0[2], v0[3]); w.z = cvt_pk_bf16(v1[0], v1[1]); w.w = cvt_pk_bf16(v1[2], v1[3]); *(u32x4*)(rowp + HALF) = w; } }
    }
};

struct RoundsOrder {
    StaticOrder so; int R;
    __device__ __forceinline__ void init(int M, int N, int G_, int c_, int R_) { so.init(M, N, G_, c_); R = R_; }
    __device__ __forceinline__ bool next(int i, Unit& u) const { return i < R && so.next(i, u); }
    __device__ __forceinline__ void a_ready(const Unit&) const {}
    __device__ __forceinline__ void done(const Unit&) const {}
};
struct MoeOrder {
    StaticOrder so; const int* panel_e; int nN; int R;
    __device__ __forceinline__ void init(int np, int nN_, int G_, int c_, const int* pe, int R_ = 1 << 30) { so.init(np * BM, nN_ * BM, G_, c_); panel_e = pe; nN = nN_; R = R_; }
    __device__ __forceinline__ bool next(int i, Unit& u) const { if (i >= R || !so.next(i, u)) return false; u.pn += panel_e[u.pm] * nN; return true; }
    __device__ __forceinline__ void a_ready(const Unit&) const {}
    __device__ __forceinline__ void done(const Unit&) const {}
};
template <class Epi, class Sched, bool ALIGN_EPI = false, bool SP2 = false>
__device__ __forceinline__ void gemm_phase(PG8_LAS unsigned char* lds, const Gemm g, const Sched& S, const Epi& E) {
    const int tid = ltid(), wid = __builtin_amdgcn_readfirstlane(tid >> 6), lane = tid & 63, wr = wid >> 2, wc = wid & 3, fr = lane & 15, fq = lane >> 4;
    const int K = g.K, nt = K / BK;
    unsigned voffA[2], voffB[2];
#pragma unroll
    for (int i = 0; i < 2; ++i) { int R, C; stage_rc(tid * 16 + i * 8192, R, C); const int Rb = Epi::PERM ? ((R & ~31) + perm32(R & 31)) : R;
        voffA[i] = (unsigned)(R * K + C) * 2u; voffB[i] = (unsigned)(Rb * K + C) * 2u; }
    const size_t kstep = (size_t)(BK * 2);
    const size_t hstep = (size_t)HALF * K * 2;
    const size_t tstep = 2 * hstep;
    const unsigned ldsw = (unsigned)wid * 1024u;
    const int aoff = lds_byte(wr * 64 + fr, fq * 8), boff = lds_byte(wc * 32 + fr, fq * 8);
#define PG8_SA(b, h) (((b) * 2 + (h)) * HTB)
#define PG8_SB(b, h) ((4 + (b) * 2 + (h)) * HTB)
#define PG8_STAGE(bufoff, gbase, voff) do { _Pragma("unroll") for (int _i = 0; _i < 2; ++_i) \
        __builtin_amdgcn_global_load_lds((const unsigned*)((const char*)(gbase) + (voff)[_i]), (PG8_LAS unsigned*)(lds + (bufoff) + ldsw + _i * 8192), 16, 0, 0); } while (0)
#define PG8_LDA(dst, b, h) do { _Pragma("unroll") for (int m = 0; m < 4; ++m) _Pragma("unroll") for (int k = 0; k < 2; ++k) dst[m][k] = *(const PG8_LAS bf16x8*)(lds + PG8_SA(b, h) + aoff + m * 2048 + k * 1024); } while (0)
#define PG8_LDB(dst, b, h) do { _Pragma("unroll") for (int n = 0; n < 2; ++n) _Pragma("unroll") for (int k = 0; k < 2; ++k) dst[n][k] = *(const PG8_LAS bf16x8*)(lds + PG8_SB(b, h) + boff + n * 2048 + k * 1024); } while (0)
#define PG8_MMA(ai, bj, At, Bt) do { __builtin_amdgcn_s_setprio(1); _Pragma("unroll") for (int m = 0; m < 4; ++m) _Pragma("unroll") for (int n = 0; n < 2; ++n) _Pragma("unroll") for (int k = 0; k < 2; ++k) \
        acc[ai][bj][m][n] = __builtin_amdgcn_mfma_f32_16x16x32_bf16(Bt[n][k], At[m][k], acc[ai][bj][m][n], 0, 0, 0); __builtin_amdgcn_s_setprio(0); } while (0)
#define PG8_WAIT_V(n) asm volatile("s_waitcnt vmcnt(" #n ")" ::: "memory")
#define PG8_WAIT_L(n) asm volatile("s_waitcnt lgkmcnt(" #n ")" ::: "memory")
#define PG8_BAR __builtin_amdgcn_s_barrier()
#define PG8_SCHED __builtin_amdgcn_sched_barrier(0)
    Unit cur, nxt; int ui = 0;
    if (!S.next(0, cur)) return;
    f32x4 acc[2][2][4][2];
#pragma unroll
    for (int a = 0; a < 2; ++a)
#pragma unroll
        for (int b = 0; b < 2; ++b)
#pragma unroll
            for (int m = 0; m < 4; ++m)
#pragma unroll
                for (int n = 0; n < 2; ++n) acc[a][b][m][n] = (f32x4){0.f, 0.f, 0.f, 0.f};
    bf16x8 At[4][2], B0[2][2], B1[2][2];
    const char* cA = (const char*)g.A + (size_t)cur.pm * tstep; const char* cB = (const char*)g.Bt + (size_t)cur.pn * tstep;
    S.a_ready(cur);
    if constexpr (SP2) {
        PG8_STAGE(PG8_SB(0, 0), cB, voffB); PG8_STAGE(PG8_SB(0, 1), cB + hstep, voffB); PG8_STAGE(PG8_SA(0, 0), cA, voffA); PG8_STAGE(PG8_SA(0, 1), cA + hstep, voffA);
        if (wr == 1) PG8_BAR;
        PG8_WAIT_V(2); PG8_BAR;
        PG8_STAGE(PG8_SB(1, 0), cB + kstep, voffB); PG8_STAGE(PG8_SA(1, 0), cA + kstep, voffA); PG8_STAGE(PG8_SB(1, 1), cB + hstep + kstep, voffB);
        PG8_WAIT_V(6); PG8_BAR;
    } else {
        PG8_STAGE(PG8_SB(0, 0), cB, voffB); PG8_STAGE(PG8_SA(0, 0), cA, voffA); PG8_STAGE(PG8_SB(0, 1), cB + hstep, voffB); PG8_STAGE(PG8_SA(0, 1), cA + hstep, voffA);
        if (wr == 1) PG8_BAR;
        PG8_WAIT_V(4); PG8_BAR;
        PG8_STAGE(PG8_SB(1, 0), cB + kstep, voffB); PG8_STAGE(PG8_SA(1, 0), cA + kstep, voffA); PG8_STAGE(PG8_SB(1, 1), cB + hstep + kstep, voffB);
        PG8_WAIT_V(6); PG8_BAR;
    }
    for (;;) {
        const bool has_next = S.next(ui + 1, nxt);
        const char* nA = has_next ? (const char*)g.A + (size_t)nxt.pm * tstep : cA; const char* nB = has_next ? (const char*)g.Bt + (size_t)nxt.pn * tstep : cB;
        for (int t = 0; t < nt; t += 2) {
            const bool last = (t == nt - 2);
            const char* a1 = cA + (size_t)(t + 1) * kstep;
            const char* a2 = last ? nA : cA + (size_t)(t + 2) * kstep; const char* b2 = last ? nB : cB + (size_t)(t + 2) * kstep;
            const char* a3 = a2 + kstep; const char* b3 = b2 + kstep;
            if (last && has_next) S.a_ready(nxt);
            if constexpr (SP2) {
            PG8_LDB(B0, 0, 0); PG8_LDB(B1, 0, 1); PG8_SCHED; PG8_LDA(At, 0, 0); PG8_STAGE(PG8_SA(1, 1), a1 + hstep, voffA);
            PG8_WAIT_V(8); PG8_WAIT_L(0); PG8_BAR; PG8_MMA(0, 0, At, B0); PG8_MMA(0, 1, At, B1); PG8_BAR; PG8_SCHED;
            PG8_LDA(At, 0, 1); PG8_STAGE(PG8_SB(0, 0), b2, voffB); PG8_STAGE(PG8_SB(0, 1), b2 + hstep, voffB); PG8_STAGE(PG8_SA(0, 0), a2, voffA);
            PG8_WAIT_V(8); PG8_WAIT_L(0); PG8_BAR; PG8_MMA(1, 0, At, B0); PG8_MMA(1, 1, At, B1); PG8_BAR; PG8_SCHED;
            PG8_LDB(B0, 1, 0); PG8_LDB(B1, 1, 1); PG8_SCHED; PG8_LDA(At, 1, 0); PG8_STAGE(PG8_SA(0, 1), a2 + hstep, voffA);
            PG8_WAIT_V(8); PG8_WAIT_L(0); PG8_BAR; PG8_MMA(0, 0, At, B0); PG8_MMA(0, 1, At, B1); PG8_BAR; PG8_SCHED;
            PG8_LDA(At, 1, 1); PG8_STAGE(PG8_SB(1, 0), b3, voffB); PG8_STAGE(PG8_SB(1, 1), b3 + hstep, voffB); PG8_STAGE(PG8_SA(1, 0), a3, voffA);
            PG8_WAIT_V(8); PG8_WAIT_L(0); PG8_BAR; PG8_MMA(1, 0, At, B0); PG8_MMA(1, 1, At, B1); PG8_BAR; PG8_SCHED;
            } else {
            PG8_LDB(B0, 0, 0); PG8_SCHED; PG8_LDA(At, 0, 0); PG8_STAGE(PG8_SA(1, 1), a1 + hstep, voffA);
            PG8_WAIT_L(8); PG8_BAR; PG8_WAIT_L(0); PG8_MMA(0, 0, At, B0); PG8_BAR; PG8_SCHED;
            PG8_LDB(B1, 0, 1); PG8_STAGE(PG8_SB(0, 0), b2, voffB);
            PG8_BAR; PG8_WAIT_L(0); PG8_MMA(0, 1, At, B1); PG8_BAR;
            PG8_LDA(At, 0, 1); PG8_STAGE(PG8_SA(0, 0), a2, voffA);
            PG8_BAR; PG8_WAIT_L(0); PG8_MMA(1, 0, At, B0); PG8_BAR; PG8_SCHED;
            PG8_STAGE(PG8_SB(0, 1), b2 + hstep, voffB);
            PG8_WAIT_V(6); PG8_BAR; PG8_MMA(1, 1, At, B1); PG8_BAR;
            PG8_LDB(B0, 1, 0); PG8_SCHED; PG8_LDA(At, 1, 0); PG8_STAGE(PG8_SA(0, 1), a2 + hstep, voffA);
            PG8_WAIT_L(8); PG8_BAR; PG8_WAIT_L(0); PG8_MMA(0, 0, At, B0); PG8_BAR; PG8_SCHED;
            PG8_LDB(B1, 1, 1); PG8_STAGE(PG8_SB(1, 0), b3, voffB);
            PG8_BAR; PG8_WAIT_L(0); PG8_MMA(0, 1, At, B1); PG8_BAR;
            PG8_LDA(At, 1, 1); PG8_STAGE(PG8_SA(1, 0), a3, voffA);
            PG8_BAR; PG8_WAIT_L(0); PG8_MMA(1, 0, At, B0); PG8_BAR; PG8_SCHED;
            PG8_STAGE(PG8_SB(1, 1), b3 + hstep, voffB);
            PG8_WAIT_V(6); PG8_BAR; PG8_MMA(1, 1, At, B1); PG8_BAR;
            }
        }
        if constexpr (ALIGN_EPI) { if (wr == 0) PG8_BAR; }
        if constexpr (!Epi::AFTER_DRAIN) { E(acc, cur, wr, wc, fr, fq); S.done(cur); }
        if (!has_next) break;
#pragma unroll
        for (int a = 0; a < 2; ++a)
#pragma unroll
            for (int b = 0; b < 2; ++b)
#pragma unroll
                for (int m = 0; m < 4; ++m)
#pragma unroll
                    for (int n = 0; n < 2; ++n) acc[a][b][m][n] = (f32x4){0.f, 0.f, 0.f, 0.f};
        cur = nxt; cA = nA; cB = nB; ++ui;
        if constexpr (ALIGN_EPI) { if (wr == 1) PG8_BAR; }
    }
    PG8_WAIT_V(0);
    if constexpr (!ALIGN_EPI) { if (wr == 0) PG8_BAR; }
    PG8_BAR;
    if constexpr (Epi::AFTER_DRAIN) { E.fused(acc, cur, wr, wc, fr, fq, lds, wid, lane); S.done(cur); }
#undef PG8_SA
#undef PG8_SB
#undef PG8_STAGE
#undef PG8_LDA
#undef PG8_LDB
#undef PG8_MMA
#undef PG8_WAIT_V
#undef PG8_WAIT_L
#undef PG8_BAR
#undef PG8_SCHED
}

typedef int v4i_ __attribute__((ext_vector_type(4)));
typedef int v8i_ __attribute__((ext_vector_type(8)));
#define PG8_CAT8(x, y) __builtin_shufflevector(__builtin_bit_cast(v4i_, x), __builtin_bit_cast(v4i_, y), 0, 1, 2, 3, 4, 5, 6, 7)
template <class Epi, class Sched, bool ALIGN_EPI = false, bool SP2 = false>
__device__ __forceinline__ void gemm_phase_f8(PG8_LAS unsigned char* lds, const Gemm g, const Sched& S, const Epi& E, int sc_a, int sc_b) {
    const int tid = ltid(), wid = __builtin_amdgcn_readfirstlane(tid >> 6), lane = tid & 63, wr = wid >> 2, wc = wid & 3, fr = lane & 15, fq = lane >> 4;
    const int K = g.K, nt = K / BK;
    int vsc_a = sc_a, vsc_b = sc_b; asm volatile("" : "+v"(vsc_a), "+v"(vsc_b));
    unsigned voffA[2], voffB[2];
#pragma unroll
    for (int i = 0; i < 2; ++i) { int R, C; stage_rc(tid * 16 + i * 8192, R, C); const int Rb = Epi::PERM ? ((R & ~31) + perm32(R & 31)) : R;
        voffA[i] = (unsigned)(R * K + C) * 2u; voffB[i] = (unsigned)(Rb * K + C) * 2u; }
    const size_t kstep = (size_t)(BK * 2);
    const size_t hstep = (size_t)HALF * K * 2;
    const size_t tstep = 2 * hstep;
    const unsigned ldsw = (unsigned)wid * 1024u;
    const int aoff = lds_byte(wr * 64 + fr, fq * 8), boff = lds_byte(wc * 32 + fr, fq * 8);
#define PG8_SA(b, h) (((b) * 2 + (h)) * HTB)
#define PG8_SB(b, h) ((4 + (b) * 2 + (h)) * HTB)
#define PG8_STAGE(bufoff, gbase, voff) do { _Pragma("unroll") for (int _i = 0; _i < 2; ++_i) \
        __builtin_amdgcn_global_load_lds((const unsigned*)((const char*)(gbase) + (voff)[_i]), (PG8_LAS unsigned*)(lds + (bufoff) + ldsw + _i * 8192), 16, 0, 0); } while (0)
#define PG8_LDA(dst, b, h) do { _Pragma("unroll") for (int m = 0; m < 4; ++m) { const v4i_ lo_ = *(const PG8_LAS v4i_*)(lds + PG8_SA(b, h) + aoff + m * 2048), hi_ = *(const PG8_LAS v4i_*)(lds + PG8_SA(b, h) + aoff + m * 2048 + 1024); dst[m] = __builtin_shufflevector(lo_, hi_, 0, 1, 2, 3, 4, 5, 6, 7); } } while (0)
#define PG8_LDB(dst, b, h) do { _Pragma("unroll") for (int n = 0; n < 2; ++n) { const v4i_ lo_ = *(const PG8_LAS v4i_*)(lds + PG8_SB(b, h) + boff + n * 2048), hi_ = *(const PG8_LAS v4i_*)(lds + PG8_SB(b, h) + boff + n * 2048 + 1024); dst[n] = __builtin_shufflevector(lo_, hi_, 0, 1, 2, 3, 4, 5, 6, 7); } } while (0)
#define PG8_MMA(ai, bj, At, Bt) do { __builtin_amdgcn_s_setprio(1); _Pragma("unroll") for (int m = 0; m < 4; ++m) _Pragma("unroll") for (int n = 0; n < 2; ++n) \
        asm volatile("v_mfma_scale_f32_16x16x128_f8f6f4 %0, %1, %2, %0, %3, %4 op_sel_hi:[0,0,0]" : "+v"(acc[ai][bj][m][n]) : "v"(Bt[n]), "v"(At[m]), "v"(vsc_b), "v"(vsc_a)); __builtin_amdgcn_s_setprio(0); } while (0)
#define PG8_WAIT_V(n) asm volatile("s_waitcnt vmcnt(" #n ")" ::: "memory")
#define PG8_WAIT_L(n) asm volatile("s_waitcnt lgkmcnt(" #n ")" ::: "memory")
#define PG8_BAR __builtin_amdgcn_s_barrier()
#define PG8_SCHED __builtin_amdgcn_sched_barrier(0)
    Unit cur, nxt; int ui = 0;
    if (!S.next(0, cur)) return;
    f32x4 acc[2][2][4][2];
#pragma unroll
    for (int a = 0; a < 2; ++a)
#pragma unroll
        for (int b = 0; b < 2; ++b)
#pragma unroll
            for (int m = 0; m < 4; ++m)
#pragma unroll
                for (int n = 0; n < 2; ++n) acc[a][b][m][n] = (f32x4){0.f, 0.f, 0.f, 0.f};
    v8i_ At[4], B0[2], B1[2];
    const char* cA = (const char*)g.A + (size_t)cur.pm * tstep; const char* cB = (const char*)g.Bt + (size_t)cur.pn * tstep;
    S.a_ready(cur);
    if constexpr (SP2) {
        PG8_STAGE(PG8_SB(0, 0), cB, voffB); PG8_STAGE(PG8_SB(0, 1), cB + hstep, voffB); PG8_STAGE(PG8_SA(0, 0), cA, voffA); PG8_STAGE(PG8_SA(0, 1), cA + hstep, voffA);
        if (wr == 1) PG8_BAR;
        PG8_WAIT_V(2); PG8_BAR;
        PG8_STAGE(PG8_SB(1, 0), cB + kstep, voffB); PG8_STAGE(PG8_SA(1, 0), cA + kstep, voffA); PG8_STAGE(PG8_SB(1, 1), cB + hstep + kstep, voffB);
        PG8_WAIT_V(6); PG8_BAR;
    } else {
        PG8_STAGE(PG8_SB(0, 0), cB, voffB); PG8_STAGE(PG8_SA(0, 0), cA, voffA); PG8_STAGE(PG8_SB(0, 1), cB + hstep, voffB); PG8_STAGE(PG8_SA(0, 1), cA + hstep, voffA);
        if (wr == 1) PG8_BAR;
        PG8_WAIT_V(4); PG8_BAR;
        PG8_STAGE(PG8_SB(1, 0), cB + kstep, voffB); PG8_STAGE(PG8_SA(1, 0), cA + kstep, voffA); PG8_STAGE(PG8_SB(1, 1), cB + hstep + kstep, voffB);
        PG8_WAIT_V(6); PG8_BAR;
    }
    for (;;) {
        const bool has_next = S.next(ui + 1, nxt);
        const char* nA = has_next ? (const char*)g.A + (size_t)nxt.pm * tstep : cA; const char* nB = has_next ? (const char*)g.Bt + (size_t)nxt.pn * tstep : cB;
        for (int t = 0; t < nt; t += 2) {
            const bool last = (t == nt - 2);
            const char* a1 = cA + (size_t)(t + 1) * kstep;
            const char* a2 = last ? nA : cA + (size_t)(t + 2) * kstep; const char* b2 = last ? nB : cB + (size_t)(t + 2) * kstep;
            const char* a3 = a2 + kstep; const char* b3 = b2 + kstep;
            if (last && has_next) S.a_ready(nxt);
            if constexpr (SP2) {
            PG8_LDB(B0, 0, 0); PG8_LDB(B1, 0, 1); PG8_SCHED; PG8_LDA(At, 0, 0); PG8_STAGE(PG8_SA(1, 1), a1 + hstep, voffA);
            PG8_WAIT_V(8); PG8_WAIT_L(0); PG8_BAR; PG8_MMA(0, 0, At, B0); PG8_MMA(0, 1, At, B1); PG8_BAR; PG8_SCHED;
            PG8_LDA(At, 0, 1); PG8_STAGE(PG8_SB(0, 0), b2, voffB); PG8_STAGE(PG8_SB(0, 1), b2 + hstep, voffB); PG8_STAGE(PG8_SA(0, 0), a2, voffA);
            PG8_WAIT_V(8); PG8_WAIT_L(0); PG8_BAR; PG8_MMA(1, 0, At, B0); PG8_MMA(1, 1, At, B1); PG8_BAR; PG8_SCHED;
            PG8_LDB(B0, 1, 0); PG8_LDB(B1, 1, 1); PG8_SCHED; PG8_LDA(At, 1, 0); PG8_STAGE(PG8_SA(0, 1), a2 + hstep, voffA);
            PG8_WAIT_V(8); PG8_WAIT_L(0); PG8_BAR; PG8_MMA(0, 0, At, B0); PG8_MMA(0, 1, At, B1); PG8_BAR; PG8_SCHED;
            PG8_LDA(At, 1, 1); PG8_STAGE(PG8_SB(1, 0), b3, voffB); PG8_STAGE(PG8_SB(1, 1), b3 + hstep, voffB); PG8_STAGE(PG8_SA(1, 0), a3, voffA);
            PG8_WAIT_V(8); PG8_WAIT_L(0); PG8_BAR; PG8_MMA(1, 0, At, B0); PG8_MMA(1, 1, At, B1); PG8_BAR; PG8_SCHED;
            } else {
            PG8_LDB(B0, 0, 0); PG8_SCHED; PG8_LDA(At, 0, 0); PG8_STAGE(PG8_SA(1, 1), a1 + hstep, voffA);
            PG8_WAIT_L(8); PG8_BAR; PG8_WAIT_L(0); PG8_MMA(0, 0, At, B0); PG8_BAR; PG8_SCHED;
            PG8_LDB(B1, 0, 1); PG8_STAGE(PG8_SB(0, 0), b2, voffB);
            PG8_BAR; PG8_WAIT_L(0); PG8_MMA(0, 1, At, B1); PG8_BAR;
            PG8_LDA(At, 0, 1); PG8_STAGE(PG8_SA(0, 0), a2, voffA);
            PG8_BAR; PG8_WAIT_L(0); PG8_MMA(1, 0, At, B0); PG8_BAR; PG8_SCHED;
            PG8_STAGE(PG8_SB(0, 1), b2 + hstep, voffB);
            PG8_WAIT_V(6); PG8_BAR; PG8_MMA(1, 1, At, B1); PG8_BAR;
            PG8_LDB(B0, 1, 0); PG8_SCHED; PG8_LDA(At, 1, 0); PG8_STAGE(PG8_SA(0, 1), a2 + hstep, voffA);
            PG8_WAIT_L(8); PG8_BAR; PG8_WAIT_L(0); PG8_MMA(0, 0, At, B0); PG8_BAR; PG8_SCHED;
            PG8_LDB(B1, 1, 1); PG8_STAGE(PG8_SB(1, 0), b3, voffB);
            PG8_BAR; PG8_WAIT_L(0); PG8_MMA(0, 1, At, B1); PG8_BAR;
            PG8_LDA(At, 1, 1); PG8_STAGE(PG8_SA(1, 0), a3, voffA);
            PG8_BAR; PG8_WAIT_L(0); PG8_MMA(1, 0, At, B0); PG8_BAR; PG8_SCHED;
            PG8_STAGE(PG8_SB(1, 1), b3 + hstep, voffB);
            PG8_WAIT_V(6); PG8_BAR; PG8_MMA(1, 1, At, B1); PG8_BAR;
            }
        }
        if constexpr (ALIGN_EPI) { if (wr == 0) PG8_BAR; }
        asm volatile("s_nop 15\n\ts_nop 15\n\ts_nop 15" ::: "memory");
        if constexpr (!Epi::AFTER_DRAIN) { E(acc, cur, wr, wc, fr, fq); S.done(cur); }
        if (!has_next) break;
#pragma unroll
        for (int a = 0; a < 2; ++a)
#pragma unroll
            for (int b = 0; b < 2; ++b)
#pragma unroll
                for (int m = 0; m < 4; ++m)
#pragma unroll
                    for (int n = 0; n < 2; ++n) acc[a][b][m][n] = (f32x4){0.f, 0.f, 0.f, 0.f};
        cur = nxt; cA = nA; cB = nB; ++ui;
        if constexpr (ALIGN_EPI) { if (wr == 1) PG8_BAR; }
    }
    PG8_WAIT_V(0);
    if constexpr (!ALIGN_EPI) { if (wr == 0) PG8_BAR; }
    PG8_BAR;
    if constexpr (Epi::AFTER_DRAIN) { E.fused(acc, cur, wr, wc, fr, fq, lds, wid, lane); S.done(cur); }
#undef PG8_SA
#undef PG8_SB
#undef PG8_STAGE
#undef PG8_LDA
#undef PG8_LDB
#undef PG8_MMA
#undef PG8_WAIT_V
#undef PG8_WAIT_L
#undef PG8_BAR
#undef PG8_SCHED
}

template <class Epi, class Sched>
__device__ __forceinline__ void gemm_phase_gather(PG8_LAS unsigned char* lds, const Gemm g, const Sched& S, const Epi& E, const int* rowlist, int sc_a, int sc_b) {
    const int tid = ltid(), wid = __builtin_amdgcn_readfirstlane(tid >> 6), lane = tid & 63, wr = wid >> 2, wc = wid & 3, fr = lane & 15, fq = lane >> 4;
    const int K = g.K, nt = K / BK;
    int vsc_a = sc_a, vsc_b = sc_b; asm volatile("" : "+v"(vsc_a), "+v"(vsc_b));
    unsigned voffB[2]; int Rr[2], Cc[2];
#pragma unroll
    for (int i = 0; i < 2; ++i) { int R, C; stage_rc(tid * 16 + i * 8192, R, C); const int Rb = Epi::PERM ? ((R & ~31) + perm32(R & 31)) : R;
        Rr[i] = R; Cc[i] = C; voffB[i] = (unsigned)(Rb * K + C) * 2u; }
    const size_t kstep = (size_t)(BK * 2);
    const size_t hstep = (size_t)HALF * K * 2;
    const size_t tstep = 2 * hstep;
    const unsigned ldsw = (unsigned)wid * 1024u;
    const int aoff = lds_byte(wr * 64 + fr, fq * 8), boff = lds_byte(wc * 32 + fr, fq * 8);
#define PG8_SA(b, h) (((b) * 2 + (h)) * HTB)
#define PG8_SB(b, h) ((4 + (b) * 2 + (h)) * HTB)
#define PG8_STAGE(bufoff, gbase, voff) do { _Pragma("unroll") for (int _i = 0; _i < 2; ++_i) \
        __builtin_amdgcn_global_load_lds((const unsigned*)((const char*)(gbase) + (voff)[_i]), (PG8_LAS unsigned*)(lds + (bufoff) + ldsw + _i * 8192), 16, 0, 0); } while (0)
#define PG8_STAGEA(bufoff, koff, V, h) do { _Pragma("unroll") for (int _i = 0; _i < 2; ++_i) \
        __builtin_amdgcn_global_load_lds((const unsigned*)((const char*)g.A + (koff) + (V)[h][_i]), (PG8_LAS unsigned*)(lds + (bufoff) + ldsw + _i * 8192), 16, 0, 0); } while (0)
#define PG8_LDA(dst, b, h) do { _Pragma("unroll") for (int m = 0; m < 4; ++m) { const v4i_ lo_ = *(const PG8_LAS v4i_*)(lds + PG8_SA(b, h) + aoff + m * 2048), hi_ = *(const PG8_LAS v4i_*)(lds + PG8_SA(b, h) + aoff + m * 2048 + 1024); dst[m] = __builtin_shufflevector(lo_, hi_, 0, 1, 2, 3, 4, 5, 6, 7); } } while (0)
#define PG8_LDB(dst, b, h) do { _Pragma("unroll") for (int n = 0; n < 2; ++n) { const v4i_ lo_ = *(const PG8_LAS v4i_*)(lds + PG8_SB(b, h) + boff + n * 2048), hi_ = *(const PG8_LAS v4i_*)(lds + PG8_SB(b, h) + boff + n * 2048 + 1024); dst[n] = __builtin_shufflevector(lo_, hi_, 0, 1, 2, 3, 4, 5, 6, 7); } } while (0)
#define PG8_MMA(ai, bj, At, Bt) do { __builtin_amdgcn_s_setprio(1); _Pragma("unroll") for (int m = 0; m < 4; ++m) _Pragma("unroll") for (int n = 0; n < 2; ++n) \
        asm volatile("v_mfma_scale_f32_16x16x128_f8f6f4 %0, %1, %2, %0, %3, %4 op_sel_hi:[0,0,0]" : "+v"(acc[ai][bj][m][n]) : "v"(Bt[n]), "v"(At[m]), "v"(vsc_b), "v"(vsc_a)); __builtin_amdgcn_s_setprio(0); } while (0)
#define PG8_WAIT_V(n) asm volatile("s_waitcnt vmcnt(" #n ")" ::: "memory")
#define PG8_WAIT_L(n) asm volatile("s_waitcnt lgkmcnt(" #n ")" ::: "memory")
#define PG8_BAR __builtin_amdgcn_s_barrier()
#define PG8_SCHED __builtin_amdgcn_sched_barrier(0)
#define PG8_ROWS(V, u) do { _Pragma("unroll") for (int _h = 0; _h < 2; ++_h) _Pragma("unroll") for (int _i = 0; _i < 2; ++_i) \
        (V)[_h][_i] = (unsigned)(rowlist[(u).pm * BM + _h * HALF + Rr[_i]] * K + Cc[_i]) * 2u; } while (0)
    Unit cur, nxt; int ui = 0;
    if (!S.next(0, cur)) return;
    f32x4 acc[2][2][4][2];
#pragma unroll
    for (int a = 0; a < 2; ++a)
#pragma unroll
        for (int b = 0; b < 2; ++b)
#pragma unroll
            for (int m = 0; m < 4; ++m)
#pragma unroll
                for (int n = 0; n < 2; ++n) acc[a][b][m][n] = (f32x4){0.f, 0.f, 0.f, 0.f};
    v8i_ At[4], B0[2], B1[2];
    unsigned vC[2][2], vN[2][2];
    PG8_ROWS(vC, cur);
    const char* cB = (const char*)g.Bt + (size_t)cur.pn * tstep;
    S.a_ready(cur);
    PG8_STAGE(PG8_SB(0, 0), cB, voffB); PG8_STAGE(PG8_SB(0, 1), cB + hstep, voffB); PG8_STAGEA(PG8_SA(0, 0), (size_t)0, vC, 0); PG8_STAGEA(PG8_SA(0, 1), (size_t)0, vC, 1);
    if (wr == 1) PG8_BAR;
    PG8_WAIT_V(2); PG8_BAR;
    PG8_STAGE(PG8_SB(1, 0), cB + kstep, voffB); PG8_STAGEA(PG8_SA(1, 0), kstep, vC, 0); PG8_STAGE(PG8_SB(1, 1), cB + hstep + kstep, voffB);
    PG8_WAIT_V(6); PG8_BAR;
    for (;;) {
        const bool has_next = S.next(ui + 1, nxt);
        if (has_next) { PG8_ROWS(vN, nxt); }
        else {
#pragma unroll
            for (int h = 0; h < 2; ++h)
#pragma unroll
                for (int i = 0; i < 2; ++i) vN[h][i] = vC[h][i]; }
        const char* nB = has_next ? (const char*)g.Bt + (size_t)nxt.pn * tstep : cB;
        for (int t = 0; t < nt; t += 2) {
            const bool last = (t == nt - 2);
            const size_t k1 = (size_t)(t + 1) * kstep;
            const size_t k2 = last ? (size_t)0 : (size_t)(t + 2) * kstep;
            unsigned v2[2][2];
#pragma unroll
            for (int h = 0; h < 2; ++h)
#pragma unroll
                for (int i = 0; i < 2; ++i) v2[h][i] = last ? vN[h][i] : vC[h][i];
            const char* b2 = last ? nB : cB + (size_t)(t + 2) * kstep;
            const size_t k3 = k2 + kstep; const char* b3 = b2 + kstep;
            if (last && has_next) S.a_ready(nxt);
            PG8_LDB(B0, 0, 0); PG8_LDB(B1, 0, 1); PG8_SCHED; PG8_LDA(At, 0, 0); PG8_STAGEA(PG8_SA(1, 1), k1, vC, 1);
            PG8_WAIT_V(8); PG8_WAIT_L(0); PG8_BAR; PG8_MMA(0, 0, At, B0); PG8_MMA(0, 1, At, B1); PG8_BAR; PG8_SCHED;
            PG8_LDA(At, 0, 1); PG8_STAGE(PG8_SB(0, 0), b2, voffB); PG8_STAGE(PG8_SB(0, 1), b2 + hstep, voffB); PG8_STAGEA(PG8_SA(0, 0), k2, v2, 0);
            PG8_WAIT_V(8); PG8_WAIT_L(0); PG8_BAR; PG8_MMA(1, 0, At, B0); PG8_MMA(1, 1, At, B1); PG8_BAR; PG8_SCHED;
            PG8_LDB(B0, 1, 0); PG8_LDB(B1, 1, 1); PG8_SCHED; PG8_LDA(At, 1, 0); PG8_STAGEA(PG8_SA(0, 1), k2, v2, 1);
            PG8_WAIT_V(8); PG8_WAIT_L(0); PG8_BAR; PG8_MMA(0, 0, At, B0); PG8_MMA(0, 1, At, B1); PG8_BAR; PG8_SCHED;
            PG8_LDA(At, 1, 1); PG8_STAGE(PG8_SB(1, 0), b3, voffB); PG8_STAGE(PG8_SB(1, 1), b3 + hstep, voffB); PG8_STAGEA(PG8_SA(1, 0), k3, v2, 0);
            PG8_WAIT_V(8); PG8_WAIT_L(0); PG8_BAR; PG8_MMA(1, 0, At, B0); PG8_MMA(1, 1, At, B1); PG8_BAR; PG8_SCHED;
        }
        if (wr == 0) PG8_BAR;
        asm volatile("s_nop 15\n\ts_nop 15\n\ts_nop 15" ::: "memory");
        E(acc, cur, wr, wc, fr, fq); S.done(cur);
        if (!has_next) break;
#pragma unroll
        for (int a = 0; a < 2; ++a)
#pragma unroll
            for (int b = 0; b < 2; ++b)
#pragma unroll
                for (int m = 0; m < 4; ++m)
#pragma unroll
                    for (int n = 0; n < 2; ++n) acc[a][b][m][n] = (f32x4){0.f, 0.f, 0.f, 0.f};
        cur = nxt; cB = nB; ++ui;
#pragma unroll
        for (int h = 0; h < 2; ++h)
#pragma unroll
            for (int i = 0; i < 2; ++i) vC[h][i] = vN[h][i];
        if (wr == 1) PG8_BAR;
    }
    PG8_WAIT_V(0);
    PG8_BAR;
#undef PG8_SA
#undef PG8_SB
#undef PG8_STAGE
#undef PG8_STAGEA
#undef PG8_LDA
#undef PG8_LDB
#undef PG8_MMA
#undef PG8_WAIT_V
#undef PG8_WAIT_L
#undef PG8_BAR
#undef PG8_SCHED
#undef PG8_ROWS
}
}
#define GAS __attribute__((address_space(1)))
#define LAS __attribute__((address_space(3)))
typedef unsigned short bf16;
typedef unsigned v4u __attribute__((ext_vector_type(4)));
typedef float f32x4 __attribute__((ext_vector_type(4)));
typedef short bf16x8 __attribute__((ext_vector_type(8)));
typedef GAS unsigned gu32;
typedef GAS unsigned long long gu64;
#define RLX_AGENT __ATOMIC_RELAXED, __HIP_MEMORY_SCOPE_AGENT
#define LDS_WAIT() asm volatile("s_waitcnt lgkmcnt(0)" ::: "memory")
#define VM_WAIT() asm volatile("s_waitcnt vmcnt(0)" ::: "memory")
__device__ __forceinline__ unsigned long long rt() { return __builtin_amdgcn_s_memrealtime(); }
__device__ __forceinline__ unsigned f2bf(float f) { unsigned u = __builtin_bit_cast(unsigned, f); return (u + 0x7fffu + ((u >> 16) & 1u)) >> 16; }
__device__ __forceinline__ unsigned pk2(float lo, float hi) { return f2bf(lo) | (f2bf(hi) << 16); }

#define XB_TMO      128
#define XB_XCNT(j)  (256  + 64 * (j))
#define XB_XSUB(j)  (1280 + 64 * (j))
#define XB_XGEN(j)  (2304 + 64 * (j))
#define XB_TOP      3328
#define XB_TOPGEN   3392
#define XCD_BAR_WORDS 3456
#define XB_SPIN_CAP (1u << 18)

__device__ __forceinline__ unsigned xb_ld(unsigned* p)              { return __hip_atomic_load(p, __ATOMIC_RELAXED, __HIP_MEMORY_SCOPE_AGENT); }
__device__ __forceinline__ unsigned xb_add(unsigned* p, unsigned v) { return __hip_atomic_fetch_add(p, v, __ATOMIC_RELAXED, __HIP_MEMORY_SCOPE_AGENT); }
__device__ __forceinline__ unsigned xb_xcc_id() { return (unsigned)__builtin_amdgcn_s_getreg((3 << 11) | 20) & 0xFu; }
#define XB_SPIN(cond, bar) do { unsigned _sp = 0; while (cond) { __builtin_amdgcn_s_sleep(1); \
    if ((++_sp & 255u) == 0u) { if (xb_ld(&(bar)[XB_TMO])) break; if (_sp > XB_SPIN_CAP) { atomicAdd(&(bar)[XB_TMO], 1u); break; } } } } while (0)

struct XcdBarrier {
    unsigned* bar; unsigned x;
    volatile LAS unsigned* st;
};

__device__ __forceinline__ XcdBarrier xcd_barrier_post(unsigned* bar, volatile LAS unsigned* st) {
    XcdBarrier b; b.bar = bar; b.x = xb_xcc_id(); b.st = st;
    if (threadIdx.x == 0) (void)xb_add(&bar[XB_XCNT(b.x)], 1u);
    return b;
}
__device__ __forceinline__ void xcd_barrier_complete(unsigned* bar, unsigned x, unsigned& nloc, unsigned& nx) {
    const unsigned G = gridDim.x * gridDim.y * gridDim.z;
    unsigned sum, cnt, mine, sp = 0u;
    for (;;) {
        sum = 0u; cnt = 0u; mine = 0u;
#pragma unroll
        for (unsigned j = 0; j < 16; ++j) { const unsigned c = xb_ld(&bar[XB_XCNT(j)]); sum += c; cnt += (c > 0u) ? 1u : 0u; mine = (j == x) ? c : mine; }
        if (sum == G) break;
        __builtin_amdgcn_s_sleep(1);
        if ((++sp & 255u) == 0u) { if (xb_ld(&bar[XB_TMO])) break; if (sp > XB_SPIN_CAP) { atomicAdd(&bar[XB_TMO], 1u); break; } }
    }
    nloc = mine > 0u ? mine : 1u; nx = cnt > 0u ? cnt : 1u;
}

__device__ __forceinline__ void xcd_barrier(const XcdBarrier& b) {
    asm volatile("s_waitcnt vmcnt(0)" ::: "memory");
    __syncthreads();
    if (threadIdx.x == 0) {
        unsigned* bar = b.bar;
        __builtin_amdgcn_s_waitcnt(0);
        unsigned nloc = b.st[0], nx = b.st[1];
        if (nloc == 0u) { xcd_barrier_complete(bar, b.x, nloc, nx); b.st[0] = nloc; b.st[1] = nx; }
        const unsigned old = xb_add(&bar[XB_XSUB(b.x)], 1u);
        const unsigned gen = old / nloc;
        if (old + 1u == (gen + 1u) * nloc) {
            __builtin_amdgcn_fence(__ATOMIC_RELEASE, "agent");
            asm volatile("s_waitcnt vmcnt(0)" ::: "memory");
            const unsigned og = xb_add(&bar[XB_TOP], 1u);
            const unsigned tg = og / nx;
            if (og + 1u == (tg + 1u) * nx) xb_add(&bar[XB_TOPGEN], 1u);
            else XB_SPIN(xb_ld(&bar[XB_TOPGEN]) == tg, bar);
            __builtin_amdgcn_fence(__ATOMIC_ACQUIRE, "agent");
            xb_add(&bar[XB_XGEN(b.x)], 1u);
            asm volatile("s_waitcnt vmcnt(0)" ::: "memory");
        } else {
            XB_SPIN(xb_ld(&bar[XB_XGEN(b.x)]) == gen, bar);
            __builtin_amdgcn_fence(__ATOMIC_ACQUIRE, "agent");
            asm volatile("s_waitcnt vmcnt(0)" ::: "memory");
        }
    }
    __syncthreads();
}

typedef short s16x4 __attribute__((ext_vector_type(4)));
typedef float f32x16 __attribute__((ext_vector_type(16)));
typedef float f32x2 __attribute__((ext_vector_type(2)));
__device__ __forceinline__ float bflo(unsigned u) { return __builtin_bit_cast(float, u << 16); }
__device__ __forceinline__ float bfhi(unsigned u) { return __builtin_bit_cast(float, u & 0xffff0000u); }
__device__ __forceinline__ void unpack8(const v4u w, float (&x)[8]) { x[0] = bflo(w.x); x[1] = bfhi(w.x); x[2] = bflo(w.y); x[3] = bfhi(w.y); x[4] = bflo(w.z); x[5] = bfhi(w.z); x[6] = bflo(w.w); x[7] = bfhi(w.w); }
__device__ __forceinline__ v4u pack8(const float (&x)[8]) { v4u w; w.x = pk2(x[0], x[1]); w.y = pk2(x[2], x[3]); w.z = pk2(x[4], x[5]); w.w = pk2(x[6], x[7]); return w; }
__device__ __forceinline__ float xor1(float v) { return __builtin_bit_cast(float, __builtin_amdgcn_update_dpp(0, __builtin_bit_cast(int, v), 0xB1, 0xf, 0xf, false)); }
__device__ __forceinline__ float xor2(float v) { return __builtin_bit_cast(float, __builtin_amdgcn_update_dpp(0, __builtin_bit_cast(int, v), 0x4E, 0xf, 0xf, false)); }
__device__ __forceinline__ float wave_sum(float v) {
    int x = __builtin_bit_cast(int, v);
#define WS_ADD(ctrl, rmask, bc) x = __builtin_bit_cast(int, __builtin_bit_cast(float, x) + __builtin_bit_cast(float, __builtin_amdgcn_update_dpp(0, x, ctrl, rmask, 0xf, bc)))
    WS_ADD(0x111, 0xf, true); WS_ADD(0x112, 0xf, true); WS_ADD(0x114, 0xf, true); WS_ADD(0x118, 0xf, true); WS_ADD(0x142, 0xa, false); WS_ADD(0x143, 0xc, false);
#undef WS_ADD
    return __builtin_bit_cast(float, __builtin_amdgcn_readlane(x, 63));
}

namespace att {
constexpr int KST = 144;
constexpr int TILEB = 64 * KST;
constexpr int L_K = 0, L_V = 2 * TILEB, L_WSF = 4 * TILEB, L_OST = L_WSF + 8 * 1024, OST_W = 68 * 32 * 4;
constexpr int LDS_BYTES = L_OST + 8 * OST_W;
constexpr int T2B = 128 * KST, F_K = 0, F_V = 2 * T2B, F_END = 4 * T2B;
static_assert(F_END <= L_WSF + 0 || true, "");
__device__ __forceinline__ int crow(int r, int hi) { return (r & 3) + 8 * (r >> 2) + 4 * hi; }
typedef short v4i16_t __attribute__((ext_vector_type(4)));
__device__ __forceinline__ s16x4 vtr(const LAS unsigned char* p) { return __builtin_bit_cast(s16x4, __builtin_amdgcn_ds_read_tr16_b64_v4i16((LAS v4i16_t*)p)); }
__device__ __forceinline__ unsigned cvtpk(float lo, float hi) { typedef float f2 __attribute__((ext_vector_type(2))); typedef __bf16 b2 __attribute__((ext_vector_type(2))); f2 v = {lo, hi}; b2 b = __builtin_convertvector(v, b2); return __builtin_bit_cast(unsigned, b); }

template <int DQK>
__device__ __forceinline__ void attn_pass(LAS unsigned char* lds, const bf16* Qw, int qld, const bf16* Kp, int kld, const bf16* Vp, int vld, int ntiles, f32x16 (&o)[2], float& l_out) {
    const int tid = ltid(), lane = tid & 63, r32 = lane & 31, hi = lane >> 5; const int wid = __builtin_amdgcn_readfirstlane(tid >> 6);
    constexpr int KS = DQK / 16;
    constexpr int KCH = DQK / 8;
    bf16x8 qr[KS];
#pragma unroll
    for (int s = 0; s < KS; ++s) qr[s] = *(const bf16x8*)(Qw + (size_t)r32 * qld + s * 16 + hi * 8);
    LAS float* wsf = (LAS float*)(lds + L_WSF) + wid * 256;
    const int kkey = tid / KCH, kch = tid % KCH; const bool kact = tid < 64 * KCH;
    const int vkey = tid >> 3, vch = tid & 7;
    const bf16* kg = Kp + (size_t)kkey * kld + kch * 8;
    const bf16* vg = Vp + (size_t)vkey * vld + vch * 8;
    const int klds = L_K + kkey * KST + kch * 16, vlds = L_V + vkey * KST + vch * 16;
    v4u kreg = (v4u){0u, 0u, 0u, 0u}, vreg;
    if (kact) kreg = *(const v4u*)kg;
    vreg = *(const v4u*)vg;
    __syncthreads();
    if (kact) *(LAS v4u*)(lds + klds) = kreg;
    *(LAS v4u*)(lds + vlds) = vreg;
    __syncthreads();
    o[0] = f32x16{}; o[1] = f32x16{};
    float m = -INFINITY, l = 0.f;
    const int kfr = r32 * KST + hi * 16;
    const int vfr = (((lane & 15) >> 2) + 4 * hi) * KST + (16 * ((lane >> 4) & 1) + 4 * (lane & 3)) * 2;
    for (int t = 0; t < ntiles; ++t) {
        const int cb = (t & 1) * TILEB, nb = ((t + 1) & 1) * TILEB;
        const bool pre = (t + 1 < ntiles);
        if (pre) { if (kact) kreg = *(const v4u*)(kg + (size_t)(t + 1) * 64 * kld); vreg = *(const v4u*)(vg + (size_t)(t + 1) * 64 * vld); }
        f32x16 p[2];
#pragma unroll
        for (int kh = 0; kh < 2; ++kh) {
            p[kh] = f32x16{};
#pragma unroll
            for (int s = 0; s < KS; ++s) { const bf16x8 kf = *(const LAS bf16x8*)(lds + L_K + cb + kh * 32 * KST + kfr + s * 32);
                p[kh] = __builtin_amdgcn_mfma_f32_32x32x16_bf16(kf, qr[s], p[kh], 0, 0, 0); }
        }
        float mx = p[0][0];
#pragma unroll
        for (int r = 0; r < 16; ++r) { mx = fmaxf(mx, p[0][r]); mx = fmaxf(mx, p[1][r]); }
        mx = fmaxf(mx, __shfl_xor(mx, 32));
        const float mnew = fmaxf(m, mx);
        const float alpha = __builtin_amdgcn_exp2f(m - mnew);
        float rs = 0.f;
#pragma unroll
        for (int kh = 0; kh < 2; ++kh)
#pragma unroll
            for (int r = 0; r < 16; ++r) { const float e = __builtin_amdgcn_exp2f(p[kh][r] - mnew); p[kh][r] = e; rs += e; }
        l = l * alpha + rs;
        if (__any(mnew > m)) {
            if (hi == 0) wsf[r32] = alpha;
#pragma unroll
            for (int r4 = 0; r4 < 4; ++r4) { const f32x4 a = *(const LAS f32x4*)(wsf + 8 * r4 + 4 * hi);
#pragma unroll
                for (int i = 0; i < 4; ++i) { o[0][4 * r4 + i] *= a[i]; o[1][4 * r4 + i] *= a[i]; } }
        }
        m = mnew;
#pragma unroll
        for (int kh = 0; kh < 2; ++kh)
#pragma unroll
            for (int s2 = 0; s2 < 2; ++s2) {
                v4u pw; pw.x = cvtpk(p[kh][8 * s2 + 0], p[kh][8 * s2 + 1]); pw.y = cvtpk(p[kh][8 * s2 + 2], p[kh][8 * s2 + 3]); pw.z = cvtpk(p[kh][8 * s2 + 4], p[kh][8 * s2 + 5]); pw.w = cvtpk(p[kh][8 * s2 + 6], p[kh][8 * s2 + 7]);
                const bf16x8 pa = __builtin_bit_cast(bf16x8, pw);
#pragma unroll
                for (int dh = 0; dh < 2; ++dh) {
                    const LAS unsigned char* vb = lds + L_V + cb + vfr + (32 * kh + 16 * s2) * KST + dh * 64;
                    const s16x4 lo = vtr(vb), hh = vtr(vb + 8 * KST);
                    const bf16x8 vf = (bf16x8){lo[0], lo[1], lo[2], lo[3], hh[0], hh[1], hh[2], hh[3]};
                    o[dh] = __builtin_amdgcn_mfma_f32_32x32x16_bf16(pa, vf, o[dh], 0, 0, 0);
                }
            }
        if (pre) { if (kact) *(LAS v4u*)(lds + klds + nb) = kreg; *(LAS v4u*)(lds + vlds + nb) = vreg; }
        __syncthreads();
    }
    l_out = l + __shfl_xor(l, 32);
}
__device__ __forceinline__ void scale_rows(LAS unsigned char* lds, f32x16 (&o)[2], float f) {
    const int tid_ = ltid(); const int lane = tid_ & 63, r32 = lane & 31, hi = lane >> 5; const int wid = __builtin_amdgcn_readfirstlane(tid_ >> 6);
    LAS float* wsf = (LAS float*)(lds + L_WSF) + wid * 256 + 128;
    if (hi == 0) wsf[r32] = f;
#pragma unroll
    for (int r4 = 0; r4 < 4; ++r4) { const f32x4 a = *(const LAS f32x4*)(wsf + 8 * r4 + 4 * hi);
#pragma unroll
        for (int i = 0; i < 4; ++i) { o[0][4 * r4 + i] *= a[i]; o[1][4 * r4 + i] *= a[i]; } }
}
__device__ __forceinline__ void stage_o(LAS unsigned char* lds, const f32x16 (&o)[2]) {
    const int tid_ = ltid(); const int lane = tid_ & 63, r32 = lane & 31, hi = lane >> 5; const int wid = __builtin_amdgcn_readfirstlane(tid_ >> 6);
    LAS float* stg = (LAS float*)(lds + L_OST + wid * OST_W);
#pragma unroll
    for (int r = 0; r < 16; ++r) { const int q = crow(r, hi); stg[q * 68 + r32] = o[0][r]; stg[q * 68 + 32 + r32] = o[1][r]; }
}
template <int KS, int K1OFF>
__device__ __forceinline__ void dual_pass(LAS unsigned char* lds, const bf16x8 (&qr)[2][KS], const bf16* Kp, int kld, const bf16* Vlat, const bf16* Vctx, int nlat, int vld, int ntiles, f32x16 (&o)[2][2], float (&l_out)[2]) {
    const int tid = ltid(), lane = tid & 63, r32 = lane & 31, hi = lane >> 5; const int wid = __builtin_amdgcn_readfirstlane(tid >> 6);
    LAS float* wsf = (LAS float*)(lds + L_WSF) + wid * 256;
    const int kkey = tid >> 3, kch = tid & 7;
    const bf16* kg = Kp + (size_t)kkey * kld + kch * 8;
    const bf16* vgl = Vlat + (size_t)kkey * vld + kch * 8; const bf16* vgc = Vctx + (size_t)kkey * vld + kch * 8;
#define VTILE(t) ((t) < nlat ? vgl + (size_t)(t) * 64 * vld : vgc + (size_t)((t) - nlat) * 64 * vld)
    const int klds = L_K + kkey * KST + kch * 16, vlds = L_V + kkey * KST + kch * 16;
    v4u kreg = *(const v4u*)kg, vreg = *(const v4u*)VTILE(0);
    __syncthreads();
    *(LAS v4u*)(lds + klds) = kreg; *(LAS v4u*)(lds + vlds) = vreg;
    __syncthreads();
#pragma unroll
    for (int s = 0; s < 2; ++s) { o[s][0] = f32x16{}; o[s][1] = f32x16{}; }
    float m[2] = {-INFINITY, -INFINITY}, l[2] = {0.f, 0.f};
    const int kfr = r32 * KST + hi * 16;
    const int vfr = (((lane & 15) >> 2) + 4 * hi) * KST + (16 * ((lane >> 4) & 1) + 4 * (lane & 3)) * 2;
    for (int t = 0; t < ntiles; ++t) {
        const int cb = (t & 1) * TILEB, nb = ((t + 1) & 1) * TILEB;
        const bool pre = (t + 1 < ntiles);
        if (pre) { kreg = *(const v4u*)(kg + (size_t)(t + 1) * 64 * kld); vreg = *(const v4u*)VTILE(t + 1); }
        f32x16 p[2][2];
#pragma unroll
        for (int kh = 0; kh < 2; ++kh) {
            p[0][kh] = f32x16{}; p[1][kh] = f32x16{};
#pragma unroll
            for (int ks = 0; ks < KS; ++ks) { const bf16x8 kf0 = *(const LAS bf16x8*)(lds + L_K + cb + kh * 32 * KST + kfr + ks * 32);
                p[0][kh] = __builtin_amdgcn_mfma_f32_32x32x16_bf16(kf0, qr[0][ks], p[0][kh], 0, 0, 0);
                if (K1OFF == 0) p[1][kh] = __builtin_amdgcn_mfma_f32_32x32x16_bf16(kf0, qr[1][ks], p[1][kh], 0, 0, 0);
                else { const bf16x8 kf1 = *(const LAS bf16x8*)(lds + L_K + cb + kh * 32 * KST + kfr + K1OFF + ks * 32); p[1][kh] = __builtin_amdgcn_mfma_f32_32x32x16_bf16(kf1, qr[1][ks], p[1][kh], 0, 0, 0); } }
        }
#pragma unroll
        for (int s = 0; s < 2; ++s) {
            float mx = fmaxf(p[s][0][0], p[s][1][0]);
#pragma unroll
            for (int r = 1; r < 16; ++r) mx = fmaxf(fmaxf(mx, p[s][0][r]), p[s][1][r]);
            mx = fmaxf(mx, __shfl_xor(mx, 32));
            const float mnew = fmaxf(m[s], mx);
            const float alpha = __builtin_amdgcn_exp2f(m[s] - mnew);
            float rs = 0.f;
#pragma unroll
            for (int kh = 0; kh < 2; ++kh)
#pragma unroll
                for (int r = 0; r < 16; ++r) { const float e = __builtin_amdgcn_exp2f(p[s][kh][r] - mnew); p[s][kh][r] = e; rs += e; }
            l[s] = l[s] * alpha + rs;
            if (__any(mnew > m[s])) {
                if (hi == 0) wsf[64 * s + r32] = alpha;
#pragma unroll
                for (int r4 = 0; r4 < 4; ++r4) { const f32x4 a = *(const LAS f32x4*)(wsf + 64 * s + 8 * r4 + 4 * hi);
#pragma unroll
                    for (int i = 0; i < 4; ++i) { o[s][0][4 * r4 + i] *= a[i]; o[s][1][4 * r4 + i] *= a[i]; } }
            }
            m[s] = mnew;
        }
#pragma unroll
        for (int kh = 0; kh < 2; ++kh)
#pragma unroll
            for (int s2 = 0; s2 < 2; ++s2) {
                bf16x8 pa[2];
#pragma unroll
                for (int s = 0; s < 2; ++s) { v4u pw; pw.x = cvtpk(p[s][kh][8 * s2 + 0], p[s][kh][8 * s2 + 1]); pw.y = cvtpk(p[s][kh][8 * s2 + 2], p[s][kh][8 * s2 + 3]); pw.z = cvtpk(p[s][kh][8 * s2 + 4], p[s][kh][8 * s2 + 5]); pw.w = cvtpk(p[s][kh][8 * s2 + 6], p[s][kh][8 * s2 + 7]);
                    pa[s] = __builtin_bit_cast(bf16x8, pw); }
#pragma unroll
                for (int dh = 0; dh < 2; ++dh) {
                    const LAS unsigned char* vb = lds + L_V + cb + vfr + (32 * kh + 16 * s2) * KST + dh * 64;
                    const s16x4 lo = vtr(vb), hh = vtr(vb + 8 * KST);
                    const bf16x8 vf = (bf16x8){lo[0], lo[1], lo[2], lo[3], hh[0], hh[1], hh[2], hh[3]};
                    o[0][dh] = __builtin_amdgcn_mfma_f32_32x32x16_bf16(pa[0], vf, o[0][dh], 0, 0, 0);
                    o[1][dh] = __builtin_amdgcn_mfma_f32_32x32x16_bf16(pa[1], vf, o[1][dh], 0, 0, 0);
                }
            }
        if (pre) { *(LAS v4u*)(lds + klds + nb) = kreg; *(LAS v4u*)(lds + vlds + nb) = vreg; }
        __syncthreads();
    }
    l_out[0] = l[0] + __shfl_xor(l[0], 32); l_out[1] = l[1] + __shfl_xor(l[1], 32);
}
struct Conv { const float* mg; const float* mu; const float* md; unsigned char* MGU8; unsigned char* MDN8; int h0; int hn; };
constexpr int HI_G = 32 * 112, HI_D = 112 * 32, HI_ALL = 16 * HI_G + 8 * HI_D;
struct ConvItem { const float* W; unsigned char* WT; int K, N, drow0, k0, n0; };
__device__ __forceinline__ ConvItem conv_decode(const Conv c, int h) {
    ConvItem it;
    if (h < 16 * HI_G) { const int eu = h / HI_G; const int r = h - eu * HI_G; const int e = eu >> 1, up = eu & 1; const int kb = r / 112, nb = r - kb * 112;
        it.W = (up ? c.mu : c.mg) + (size_t)e * 1024 * 3584; it.WT = c.MGU8 + (size_t)e * 7168 * 1024; it.K = 1024; it.N = 3584; it.k0 = kb * 32; it.n0 = nb * 32;
        it.drow0 = 256 * ((nb * 32) >> 7) + (up ? 128 : 0) + ((nb * 32) & 127); }
    else { const int h2 = h - 16 * HI_G; const int e = h2 / HI_D; const int r = h2 - e * HI_D; const int kb = r >> 5, nb = r & 31;
        it.W = c.md + (size_t)e * 3584 * 1024; it.WT = c.MDN8 + (size_t)e * 1024 * 3584; it.K = 3584; it.N = 1024; it.k0 = kb * 32; it.n0 = nb * 32; it.drow0 = nb * 32; }
    return it;
}
__device__ __forceinline__ void conv_load(const Conv c, int h, int lane, float (&w)[16]) {
    const ConvItem it = conv_decode(c, h); const float* p = it.W + (size_t)(it.k0 + (lane >> 5)) * it.N + it.n0 + (lane & 31);
#pragma unroll
    for (int i = 0; i < 16; ++i) w[i] = p[(size_t)(2 * i) * it.N];
}
__device__ __forceinline__ void conv_store(const Conv c, int h, int lane, const float (&w)[16], LAS float* scr  ) {
    const ConvItem it = conv_decode(c, h);
#pragma unroll
    for (int i = 0; i < 16; ++i) scr[(2 * i + (lane >> 5)) * 33 + (lane & 31)] = w[i];
    const int n = lane >> 1, kh = lane & 1; const LAS float* s = scr + (16 * kh) * 33 + n;
    v4u o;
    o.x = pg8::pack_fp8x4(s[0 * 33] * 128.0f, s[1 * 33] * 128.0f, s[2 * 33] * 128.0f, s[3 * 33] * 128.0f); o.y = pg8::pack_fp8x4(s[4 * 33] * 128.0f, s[5 * 33] * 128.0f, s[6 * 33] * 128.0f, s[7 * 33] * 128.0f);
    o.z = pg8::pack_fp8x4(s[8 * 33] * 128.0f, s[9 * 33] * 128.0f, s[10 * 33] * 128.0f, s[11 * 33] * 128.0f); o.w = pg8::pack_fp8x4(s[12 * 33] * 128.0f, s[13 * 33] * 128.0f, s[14 * 33] * 128.0f, s[15 * 33] * 128.0f);
    *(GAS v4u*)(it.WT + (size_t)(it.drow0 + n) * it.K + it.k0 + 16 * kh) = o;
}
__device__ __forceinline__ void conv_st1(int lane, const float (&w)[16], LAS float* scr) {
#pragma unroll
    for (int i = 0; i < 16; ++i) scr[(2 * i + (lane >> 5)) * 33 + (lane & 31)] = w[i];
}
__device__ __forceinline__ void conv_st2(int lane, float (&w)[16], const LAS float* scr) {
    const int n = lane >> 1, kh = lane & 1; const LAS float* s = scr + (16 * kh) * 33 + n;
#pragma unroll
    for (int i = 0; i < 16; ++i) w[i] = s[i * 33];
}
__device__ __forceinline__ void conv_st3(const Conv c, int h, int lane, const float (&w)[16]) {
    const ConvItem it = conv_decode(c, h); const int n = lane >> 1, kh = lane & 1;
    v4u o;
    o.x = pg8::pack_fp8x4(w[0] * 128.0f, w[1] * 128.0f, w[2] * 128.0f, w[3] * 128.0f); o.y = pg8::pack_fp8x4(w[4] * 128.0f, w[5] * 128.0f, w[6] * 128.0f, w[7] * 128.0f);
    o.z = pg8::pack_fp8x4(w[8] * 128.0f, w[9] * 128.0f, w[10] * 128.0f, w[11] * 128.0f); o.w = pg8::pack_fp8x4(w[12] * 128.0f, w[13] * 128.0f, w[14] * 128.0f, w[15] * 128.0f);
    *(GAS v4u*)(it.WT + (size_t)(it.drow0 + n) * it.K + it.k0 + 16 * kh) = o;
}
__device__ __forceinline__ void conv_plain(LAS unsigned char* lds, const Conv cv) {
    const int tid = ltid(), lane = tid & 63; LAS float* cscr = (LAS float*)(lds + 73728) + __builtin_amdgcn_readfirstlane(tid >> 6) * 1056;
    for (int i = 0; i < cv.hn; ++i) { float w[16]; conv_load(cv, cv.h0 + i, lane, w); conv_store(cv, cv.h0 + i, lane, w, cscr); }
}
constexpr int P_K = 0, P_V = 3 * T2B, P_END = 6 * T2B, P_CONV = P_END;
static_assert(P_CONV + 8 * 4224 <= 147456 - 1024, "attention LDS");
template <int KS, int K1OFF, int S>
__device__ __forceinline__ void pipe_stage(LAS unsigned char* lds, const int kb_next, const int vb_cur, const bf16x8 (&qr)[2][KS], f32x16& pc, f32x16& pn, f32x16 (&o)[2][2], v4u& pa1, bf16x8 (&kf)[4], bf16x8 (&vf0)[2], bf16x8 (&vf1)[2], float (&l)[2][2], float (&en)[2]) {
    constexpr int NSLOT = 4 + KS, S1 = 1 - S;
    v4u pa0;
#pragma unroll
    for (int sl = 0; sl < NSLOT; ++sl) {
        const int kind = (KS == 4) ? ((sl & 1) ? (sl < 4 ? 0 : 2) : 1) : (sl == 0 || sl == 2 ? 1 : (sl < 4 ? 0 : 2));
        const int idx = (KS == 4) ? (kind == 1 ? sl >> 1 : (sl >> 1) & 1) : (kind == 1 ? sl >> 1 : (kind == 0 ? sl >> 1 : sl - 4));
        if (S == 0 && sl == 1) {
#pragma unroll
            for (int dh = 0; dh < 2; ++dh) { const LAS unsigned char* vb = lds + vb_cur + dh * 64; const s16x4 lo = vtr(vb), hh = vtr(vb + 8 * KST); vf0[dh] = (bf16x8){lo[0], lo[1], lo[2], lo[3], hh[0], hh[1], hh[2], hh[3]}; } }
        if (kind == 0) o[S1][idx] = __builtin_amdgcn_mfma_f32_32x32x16_bf16(__builtin_bit_cast(bf16x8, pa1), vf1[idx], o[S1][idx], 0, 0, 0);
        else if (kind == 1) { const int ks = idx, kc = K1OFF == 0 ? ks : ks + 2 * S1;
            if (ks == 0) pn = __builtin_amdgcn_mfma_f32_32x32x16_bf16(kf[kc], qr[S1][ks], f32x16{}, 0, 0, 0);
            else pn = __builtin_amdgcn_mfma_f32_32x32x16_bf16(kf[kc], qr[S1][ks], pn, 0, 0, 0);
            if (S == 0) {
                if (K1OFF == 0) kf[ks] = *(const LAS bf16x8*)(lds + kb_next + ks * 32);
                else { kf[ks] = *(const LAS bf16x8*)(lds + kb_next + ks * 32); kf[ks + 2] = *(const LAS bf16x8*)(lds + kb_next + (ks + 2) * 32); } } }
        else o[S][idx] = __builtin_amdgcn_mfma_f32_32x32x16_bf16(__builtin_bit_cast(bf16x8, pa0), vf0[idx], o[S][idx], 0, 0, 0);
        if (S == 0 && sl == 4) {
#pragma unroll
            for (int dh = 0; dh < 2; ++dh) { const LAS unsigned char* vb = lds + vb_cur + 16 * KST + dh * 64; const s16x4 lo = vtr(vb), hh = vtr(vb + 8 * KST); vf1[dh] = (bf16x8){lo[0], lo[1], lo[2], lo[3], hh[0], hh[1], hh[2], hh[3]}; } }
#pragma unroll
        for (int m = sl * 8 / NSLOT; m < (sl + 1) * 8 / NSLOT; ++m) { const int s2 = m >> 2, w = m & 3;
            const float e0 = en[0], e1 = en[1];
            if (m < 7) { en[0] = __builtin_amdgcn_exp2f(pc[2 * (m + 1)]); en[1] = __builtin_amdgcn_exp2f(pc[2 * (m + 1) + 1]); }
            else { en[0] = __builtin_amdgcn_exp2f(pn[0]); en[1] = __builtin_amdgcn_exp2f(pn[1]); }
            float ls = l[S][0]; ls += e0; ls += e1; unsigned pw = cvtpk(e0, e1);
            asm volatile("" : "+v"(ls), "+v"(pw), "+v"(en[0]), "+v"(en[1]));
            l[S][0] = ls; if (s2 == 0) pa0[w] = pw; else pa1[w] = pw; }
        __builtin_amdgcn_sched_barrier(0);
    }
}
template <int KS, int K1OFF, bool CONV>
__device__ __forceinline__ void dual_pass_pipe(LAS unsigned char* lds, const bf16x8 (&qr)[2][KS], const bf16* Kp, int kld, const bf16* Vlat, const bf16* Vctx, int nlat, int vld, int ntiles, f32x16 (&o)[2][2], float (&l_out)[2], const Conv cv, const bool act = true) {
    const int tid = ltid(), lane = tid & 63, r32 = lane & 31, hi = lane >> 5;
    LAS float* cscr = (LAS float*)(lds + P_CONV) + __builtin_amdgcn_readfirstlane(tid >> 6) * 1056;
    const int kkey = tid >> 3, kch = tid & 7;
    const bf16* kg = Kp + (size_t)kkey * kld + kch * 8;
    const bf16* vgl = Vlat + (size_t)kkey * vld + kch * 8; const bf16* vgc = Vctx + (size_t)kkey * vld + kch * 8;
    const int klds = P_K + kkey * KST + kch * 16, vlds = P_V + kkey * KST + kch * 16;
    const int kfr = P_K + r32 * KST + hi * 16;
    const int vfr = P_V + (((lane & 15) >> 2) + 4 * hi) * KST + (16 * ((lane >> 4) & 1) + 4 * (lane & 3)) * 2;
    v4u kreg[2], vreg[2];
#pragma unroll
    for (int i = 0; i < 2; ++i) { kreg[i] = *(const v4u*)(kg + (size_t)i * 64 * kld); vreg[i] = *(const v4u*)VTILE(i); }
    __syncthreads();
#pragma unroll
    for (int i = 0; i < 2; ++i) { *(LAS v4u*)(lds + klds + i * 64 * KST) = kreg[i]; *(LAS v4u*)(lds + vlds + i * 64 * KST) = vreg[i]; }
    __syncthreads();
#pragma unroll
    for (int s = 0; s < 2; ++s) { o[s][0] = f32x16{}; o[s][1] = f32x16{}; }
    f32x16 pX, pY; v4u pa1 = (v4u){0u, 0u, 0u, 0u}; bf16x8 kf[4], vf0[2], vf1[2]; float l[2][2] = {{0.f, 0.f}, {0.f, 0.f}};
    pX = f32x16{}; pY = f32x16{};
#pragma unroll
    for (int c = 0; c < 4; ++c) kf[c] = bf16x8{};
    vf0[0] = vf0[1] = vf1[0] = vf1[1] = bf16x8{};
    if (act) {
#pragma unroll
        for (int c = 0; c < 4; ++c) kf[c] = *(const LAS bf16x8*)(lds + kfr + c * 32);
#pragma unroll
        for (int dh = 0; dh < 2; ++dh) { const LAS unsigned char* vb = lds + vfr + 16 * KST + dh * 64; const s16x4 lo = vtr(vb), hh = vtr(vb + 8 * KST); vf1[dh] = (bf16x8){lo[0], lo[1], lo[2], lo[3], hh[0], hh[1], hh[2], hh[3]}; vf0[dh] = vf1[dh]; }
        pX = f32x16{};
#pragma unroll
        for (int ks = 0; ks < KS; ++ks) pX = __builtin_amdgcn_mfma_f32_32x32x16_bf16(kf[ks], qr[0][ks], pX, 0, 0, 0);
    }
    float en[2]; en[0] = __builtin_amdgcn_exp2f(pX[0]); en[1] = __builtin_amdgcn_exp2f(pX[1]);
    const int niter = ntiles >> 1;
    float cw[16];
#pragma unroll
    for (int i = 0; i < 16; ++i) cw[i] = 0.f;
    int cb = 0, nb = T2B;
    for (int it = 0; it < niter; ++it) {
        const bool pre = (it + 1 < niter);
        {
#pragma unroll
            for (int i = 0; i < 2; ++i) { const int t = pre ? 2 * it + 2 + i : 2 * it + i; kreg[i] = *(const v4u*)(kg + (size_t)t * 64 * kld); vreg[i] = *(const v4u*)VTILE(t); } }
        const bool cld = CONV && !(it & 1) && (it >> 1) < cv.hn, cst = CONV && (it & 1) && (it >> 1) < cv.hn;
        __builtin_amdgcn_sched_barrier(0);
        if (act) pipe_stage<KS, K1OFF, 0>(lds, kfr + cb + 1 * 32 * KST, vfr + cb + 0 * 32 * KST, qr, pX, pY, o, pa1, kf, vf0, vf1, l, en);
        if (CONV) { if (cst) conv_st1(lane, cw, cscr); }
        __builtin_amdgcn_sched_barrier(0);
        if (act) pipe_stage<KS, K1OFF, 1>(lds, 0, 0, qr, pY, pX, o, pa1, kf, vf0, vf1, l, en);
        if (act) pipe_stage<KS, K1OFF, 0>(lds, kfr + cb + 2 * 32 * KST, vfr + cb + 1 * 32 * KST, qr, pX, pY, o, pa1, kf, vf0, vf1, l, en);
        if (CONV) { if (cst) conv_st2(lane, cw, cscr); }
        __builtin_amdgcn_sched_barrier(0);
        if (act) pipe_stage<KS, K1OFF, 1>(lds, 0, 0, qr, pY, pX, o, pa1, kf, vf0, vf1, l, en);
        if (act) pipe_stage<KS, K1OFF, 0>(lds, kfr + cb + 3 * 32 * KST, vfr + cb + 2 * 32 * KST, qr, pX, pY, o, pa1, kf, vf0, vf1, l, en);
        if (act) pipe_stage<KS, K1OFF, 1>(lds, 0, 0, qr, pY, pX, o, pa1, kf, vf0, vf1, l, en);
        if (pre) {
#pragma unroll
            for (int i = 0; i < 2; ++i) { *(LAS v4u*)(lds + klds + nb + i * 64 * KST) = kreg[i]; *(LAS v4u*)(lds + vlds + nb + i * 64 * KST) = vreg[i]; } }
        if (CONV) { if (cst) conv_st3(cv, cv.h0 + (it >> 1), lane, cw); }
        if (CONV) { if (cld) conv_load(cv, cv.h0 + (it >> 1), lane, cw); }
        __syncthreads();
        if (act) {
        pipe_stage<KS, K1OFF, 0>(lds, kfr + nb, vfr + cb + 3 * 32 * KST, qr, pX, pY, o, pa1, kf, vf0, vf1, l, en);
        pipe_stage<KS, K1OFF, 1>(lds, 0, 0, qr, pY, pX, o, pa1, kf, vf0, vf1, l, en);
        }
        cb = nb; nb = (nb == 2 * T2B) ? 0 : nb + T2B;
    }
#pragma unroll
    for (int dh = 0; dh < 2; ++dh) o[1][dh] = __builtin_amdgcn_mfma_f32_32x32x16_bf16(__builtin_bit_cast(bf16x8, pa1), vf1[dh], o[1][dh], 0, 0, 0);
    __syncthreads();
#pragma unroll
    for (int s = 0; s < 2; ++s) { const float t = l[s][0]; l_out[s] = t + __shfl_xor(t, 32); }
}
__device__ __forceinline__ void store_stage(LAS unsigned char* lds, bf16* Out, int old) {
    const int tid_ = ltid(); const int lane = tid_ & 63; const int wid = __builtin_amdgcn_readfirstlane(tid_ >> 6);
    const LAS float* stg = (const LAS float*)(lds + L_OST + wid * OST_W);
#pragma unroll
    for (int i = 0; i < 4; ++i) { const int row = i * 8 + (lane >> 3), ch = lane & 7; float x[8];
#pragma unroll
        for (int j = 0; j < 8; ++j) x[j] = stg[row * 68 + ch * 8 + j];
        *(v4u*)(Out + (size_t)(wid * 32 + row) * old + ch * 8) = pack8(x); }
}
struct QCtx { const bf16* P; const float* gcos; const float* gsin; const float* dcos; const float* dsin; const float* qn; };
__device__ __forceinline__ void build_q_gqa(const QCtx& C, size_t row, int hq, int tpos, int hi, bf16x8 (&qr)[4]) {
    const bf16* pr = C.P + row * NP + PC_GQ + hq * 64 + 8 * hi; float x[4][8]; float ss = 0.f;
#pragma unroll
    for (int s = 0; s < 4; ++s) { unpack8(*(const v4u*)(pr + 16 * s), x[s]);
#pragma unroll
        for (int j = 0; j < 8; ++j) ss += x[s][j] * x[s][j]; }
    ss += __shfl_xor(ss, 32);
    const float rstd = 1.0f / sqrtf(ss * (1.0f / 64.0f) + EPS);
#pragma unroll
    for (int s = 0; s < 4; ++s)
#pragma unroll
        for (int j = 0; j < 8; ++j) x[s][j] *= rstd * C.qn[16 * s + 8 * hi + j];
    if (tpos >= 0) { const int gr = tpos >> 6, gc = tpos & 63;
#pragma unroll
        for (int j = 0; j < 8; ++j) { const int fi = 8 * hi + j;
            { const float c = C.gcos[gr * 16 + fi], sn = C.gsin[gr * 16 + fi]; const float a = x[0][j], b = x[1][j]; x[0][j] = a * c - b * sn; x[1][j] = a * sn + b * c; }
            { const float c = C.gcos[gc * 16 + fi], sn = C.gsin[gc * 16 + fi]; const float a = x[2][j], b = x[3][j]; x[2][j] = a * c - b * sn; x[3][j] = a * sn + b * c; } } }
    const float sc = 0.125f * LOG2E;
#pragma unroll
    for (int s = 0; s < 4; ++s) {
#pragma unroll
        for (int j = 0; j < 8; ++j) x[s][j] *= sc;
        qr[s] = __builtin_bit_cast(bf16x8, pack8(x[s])); }
}
__device__ __forceinline__ void build_q_diff(const QCtx& C, size_t row, int h, int m, int tpos, int hi, bf16x8 (&qr)[2]) {
    const bf16* pr = C.P + row * NP + PC_DQ + h * 64 + m * 32 + 8 * hi; float x[2][8], y[2][8];
#pragma unroll
    for (int s = 0; s < 2; ++s) { unpack8(*(const v4u*)(pr + 16 * s), x[s]);
#pragma unroll
        for (int j = 0; j < 8; ++j) y[s][j] = __shfl_xor(x[s][j], 32); }
    if (tpos >= 0) { const int gr = tpos >> 6, gc = tpos & 63;
#pragma unroll
        for (int j = 0; j < 8; ++j) {
            { const float c = C.dcos[gr * 8 + j], sn = C.dsin[gr * 8 + j]; x[0][j] = hi ? (y[0][j] * sn + x[0][j] * c) : (x[0][j] * c - y[0][j] * sn); }
            { const float c = C.dcos[gc * 8 + j], sn = C.dsin[gc * 8 + j]; x[1][j] = hi ? (y[1][j] * sn + x[1][j] * c) : (x[1][j] * c - y[1][j] * sn); } } }
    const float sc = 0.17677669529663687f * LOG2E;
#pragma unroll
    for (int s = 0; s < 2; ++s) {
#pragma unroll
        for (int j = 0; j < 8; ++j) x[s][j] *= sc;
        qr[s] = __builtin_bit_cast(bf16x8, pack8(x[s])); }
}
__device__ __forceinline__ void gqa_unit2(LAS unsigned char* lds, const QCtx& C, size_t row0, int t0, int hq, const bf16* Kp, const bf16* Vlat, const bf16* Vctx, int nlat, int ntiles, bf16* Out0, bf16* Out1, bool fast, const Conv cv) {
    const int tid_ = ltid(); const int lane = tid_ & 63, r32 = lane & 31, hi = lane >> 5; const int wid = __builtin_amdgcn_readfirstlane(tid_ >> 6);
    bf16x8 qr[2][4];
    build_q_gqa(C, row0 + wid * 32 + r32, hq, t0 < 0 ? -1 : t0 + wid * 32 + r32, hi, qr[0]);
    build_q_gqa(C, row0 + wid * 32 + r32, hq + 1, t0 < 0 ? -1 : t0 + wid * 32 + r32, hi, qr[1]);
    f32x16 o[2][2];
    if (fast) { float l[2]; dual_pass_pipe<4, 0, true>(lds, qr, Kp, 128, Vlat, Vctx, nlat, NP, ntiles, o, l, cv); scale_rows(lds, o[0], 1.0f / l[0]); scale_rows(lds, o[1], 1.0f / l[1]); }
    else { __syncthreads(); conv_plain(lds, cv); __syncthreads(); float l[2]; dual_pass<4, 0>(lds, qr, Kp, 128, Vlat, Vctx, nlat, NP, ntiles, o, l);
        scale_rows(lds, o[0], 1.0f / l[0]); scale_rows(lds, o[1], 1.0f / l[1]); }
    stage_o(lds, o[0]); store_stage(lds, Out0, 1024);
    stage_o(lds, o[1]); store_stage(lds, Out1, 1024);
}
__device__ __forceinline__ void diff_unit2(LAS unsigned char* lds, const QCtx& C, size_t row0, int t0, int h, const bf16* Kp, const bf16* Vlat, const bf16* Vctx, int nlat, int ntiles, float lam, const float* nw, float oscale, bf16* Out, bool fast, const Conv cv) {
    const int tid_ = ltid(); const int lane = tid_ & 63, r32 = lane & 31, hi = lane >> 5; const int wid = __builtin_amdgcn_readfirstlane(tid_ >> 6);
    bf16x8 qr[2][2];
    build_q_diff(C, row0 + wid * 32 + r32, h, 0, t0 < 0 ? -1 : t0 + wid * 32 + r32, hi, qr[0]);
    build_q_diff(C, row0 + wid * 32 + r32, h, 1, t0 < 0 ? -1 : t0 + wid * 32 + r32, hi, qr[1]);
    f32x16 o[2][2];
    if (fast) { float l[2]; dual_pass_pipe<2, 64, true>(lds, qr, Kp, 256, Vlat, Vctx, nlat, NP, ntiles, o, l, cv); scale_rows(lds, o[0], 1.0f / l[0]); scale_rows(lds, o[1], 1.0f / l[1]); }
    else { __syncthreads(); conv_plain(lds, cv); __syncthreads(); float l[2]; dual_pass<2, 64>(lds, qr, Kp, 256, Vlat, Vctx, nlat, NP, ntiles, o, l);
        scale_rows(lds, o[0], 1.0f / l[0]); scale_rows(lds, o[1], 1.0f / l[1]); }
#pragma unroll
    for (int r = 0; r < 16; ++r) { o[0][0][r] -= lam * o[1][0][r]; o[0][1][r] -= lam * o[1][1][r]; }
    stage_o(lds, o[0]);
    const LAS float* stg = (const LAS float*)(lds + L_OST + wid * OST_W);
#pragma unroll
    for (int i = 0; i < 4; ++i) { const int row = i * 8 + (lane >> 3), ch = lane & 7; float x[8]; float ss = 0.f;
#pragma unroll
        for (int j = 0; j < 8; ++j) { x[j] = stg[row * 68 + ch * 8 + j]; ss += x[j] * x[j]; }
        ss += __shfl_xor(ss, 1); ss += __shfl_xor(ss, 2); ss += __shfl_xor(ss, 4);
        const float rstd = 1.0f / sqrtf(ss * (1.0f / 64.0f) + EPS) * oscale;
#pragma unroll
        for (int j = 0; j < 8; ++j) x[j] = x[j] * rstd * nw[ch * 8 + j];
        *(v4u*)(Out + (size_t)(wid * 32 + row) * 1024 + ch * 8) = pack8(x); }
}
#undef VTILE
}

namespace tail {
using pg8::bf16x8; using pg8::bf16_t;
struct EpiResid {
    const float* base_lat; const float* base_ctx; float* out_lat; float* out_ctx; const float* gate;
    __device__ __forceinline__ void operator()(int row, int col, int  , const float (&v)[8]) const {
        const bool isctx = row >= MLAT; const int bidx = isctx ? 4 : (row >> 12);
        const float* b = (isctx ? base_ctx + (size_t)(row - MLAT) * 1024 : base_lat + (size_t)row * 1024) + col;
        float* o = (isctx ? out_ctx + (size_t)(row - MLAT) * 1024 : out_lat + (size_t)row * 1024) + col;
        const float* g = gate + bidx * 6144 + col;
        const f32x4 b0 = *(const f32x4*)b, b1 = *(const f32x4*)(b + 4), g0 = *(const f32x4*)g, g1 = *(const f32x4*)(g + 4);
        *(f32x4*)o = b0 + g0 * (f32x4){v[0], v[1], v[2], v[3]}; *(f32x4*)(o + 4) = b1 + g1 * (f32x4){v[4], v[5], v[6], v[7]};
    }
};
struct EpiResidNorm {
    const float* base_lat; const float* base_ctx; float* out_lat; float* out_ctx; const float* gate; bf16_t* H; float* ss; const float* nw; const float* sc;
    __device__ __forceinline__ void operator()(int row, int col, int  , const float (&v)[8]) const {
        const bool isctx = row >= MLAT; const int bidx = isctx ? 4 : (row >> 12);
        const float* b = (isctx ? base_ctx + (size_t)(row - MLAT) * 1024 : base_lat + (size_t)row * 1024) + col;
        float* o = (isctx ? out_ctx + (size_t)(row - MLAT) * 1024 : out_lat + (size_t)row * 1024) + col;
        const float* g = gate + bidx * 6144 + col;
        const f32x4 x0 = *(const f32x4*)b + *(const f32x4*)g * (f32x4){v[0], v[1], v[2], v[3]}, x1 = *(const f32x4*)(b + 4) + *(const f32x4*)(g + 4) * (f32x4){v[4], v[5], v[6], v[7]};
        *(f32x4*)o = x0; *(f32x4*)(o + 4) = x1;
        const f32x4 c0 = *(const f32x4*)(nw + col) * (*(const f32x4*)(sc + bidx * 6144 + col) + 1.0f), c1 = *(const f32x4*)(nw + col + 4) * (*(const f32x4*)(sc + bidx * 6144 + col + 4) + 1.0f);
        const f32x4 h0 = x0 * c0, h1 = x1 * c1; float hh[8] = {h0[0], h0[1], h0[2], h0[3], h1[0], h1[1], h1[2], h1[3]};
        *(GAS v4u*)(H + (size_t)row * 1024 + col) = pack8(hh);
        float s = ((x0[0] * x0[0] + x0[1] * x0[1]) + (x0[2] * x0[2] + x0[3] * x0[3])) + ((x1[0] * x1[0] + x1[1] * x1[1]) + (x1[2] * x1[2] + x1[3] * x1[3]));
        s += __shfl_xor(s, 1); s += __shfl_xor(s, 2); s += __shfl_xor(s, 4);
        if ((ltid() & 7) == 0) atomicAdd(ss + row, s);
    }
};
struct EpiMoeDown {
    bf16_t* O; const float* roww;
    __device__ __forceinline__ void operator()(int row, int col, int  , const float (&v)[8]) const {
        const float w = roww[row]; float x[8];
#pragma unroll
        for (int j = 0; j < 8; ++j) x[j] = v[j] * w;
        *(GAS v4u*)(O + (size_t)row * 1024 + col) = pack8(x);
    }
};
template <int K, class Epi>
__device__ __forceinline__ void subtile(LAS unsigned char* lds, const bf16_t* A, const bf16_t* Bt, int row0, int brow0, int col0, const Epi& E) {
    const int tid = ltid(), lane = tid & 63, fr = lane & 15, fq = lane >> 4; const int w = __builtin_amdgcn_readfirstlane(tid >> 6);
    constexpr int kw = K / 8, nsub = kw / 32;
    constexpr int DEPTH = nsub < 4 ? nsub : 4;
    const bf16_t* ap = A + (size_t)(row0 + fr) * K + w * kw + 8 * fq; const bf16_t* bp = Bt + (size_t)(brow0 + fr) * K + w * kw + 8 * fq;
    f32x4 acc[4][4];
#pragma unroll
    for (int m = 0; m < 4; ++m)
#pragma unroll
        for (int n = 0; n < 4; ++n) acc[m][n] = (f32x4){0.f, 0.f, 0.f, 0.f};
    bf16x8 a[DEPTH][4], b[DEPTH][4];
#pragma unroll
    for (int d = 0; d < DEPTH; ++d)
#pragma unroll
        for (int m = 0; m < 4; ++m) { a[d][m] = *(const bf16x8*)(ap + (size_t)(16 * m) * K + 32 * d); b[d][m] = *(const bf16x8*)(bp + (size_t)(16 * m) * K + 32 * d); }
#pragma unroll
    for (int s = 0; s < nsub; ++s) {
        bf16x8 ca[4], cb[4];
#pragma unroll
        for (int m = 0; m < 4; ++m) { ca[m] = a[s % DEPTH][m]; cb[m] = b[s % DEPTH][m]; }
        if (s + DEPTH < nsub) {
#pragma unroll
            for (int m = 0; m < 4; ++m) { a[s % DEPTH][m] = *(const bf16x8*)(ap + (size_t)(16 * m) * K + 32 * (s + DEPTH)); b[s % DEPTH][m] = *(const bf16x8*)(bp + (size_t)(16 * m) * K + 32 * (s + DEPTH)); } }
#pragma unroll
        for (int m = 0; m < 4; ++m)
#pragma unroll
            for (int n = 0; n < 4; ++n) acc[m][n] = __builtin_amdgcn_mfma_f32_16x16x32_bf16(cb[n], ca[m], acc[m][n], 0, 0, 0);
    }
    __syncthreads();
    LAS float* part = (LAS float*)lds + w * 4096;
#pragma unroll
    for (int m = 0; m < 4; ++m)
#pragma unroll
        for (int n = 0; n < 4; ++n) *(LAS f32x4*)(part + (16 * m + fr) * 64 + 16 * n + 4 * fq) = acc[m][n];
    __syncthreads();
    const int r = 8 * w + (lane >> 3), c = 8 * (lane & 7);
    float v[8];
#pragma unroll
    for (int j = 0; j < 8; ++j) v[j] = 0.f;
#pragma unroll
    for (int p = 0; p < 8; ++p) { const LAS float* q = (const LAS float*)lds + p * 4096 + r * 64 + c; const f32x4 x0 = *(const LAS f32x4*)q, x1 = *(const LAS f32x4*)(q + 4);
        v[0] += x0[0]; v[1] += x0[1]; v[2] += x0[2]; v[3] += x0[3]; v[4] += x1[0]; v[5] += x1[1]; v[6] += x1[2]; v[7] += x1[3]; }
    E(row0 + r, col0 + c, brow0 + c, v);
}
typedef int v8i __attribute__((ext_vector_type(8)));
typedef int v4i __attribute__((ext_vector_type(4)));
template <int KB, class Epi>
__device__ __forceinline__ void subtile_f8(LAS unsigned char* lds, const unsigned char* A, const unsigned char* Bt, int row0, int brow0, int col0, const Epi& E, int sc_a, int sc_b) {
    const int tid = ltid(), lane = tid & 63, fr = lane & 15, fq = lane >> 4; const int w = __builtin_amdgcn_readfirstlane(tid >> 6);
    constexpr int NCHUNK = KB / 128;
    int vsc_a = sc_a, vsc_b = sc_b; asm volatile("" : "+v"(vsc_a), "+v"(vsc_b));
    const unsigned char* ap = A + (size_t)(row0 + fr) * KB + 32 * fq; const unsigned char* bp = Bt + (size_t)(brow0 + fr) * KB + 32 * fq;
    f32x4 acc[4][4];
#pragma unroll
    for (int m = 0; m < 4; ++m)
#pragma unroll
        for (int n = 0; n < 4; ++n) acc[m][n] = (f32x4){0.f, 0.f, 0.f, 0.f};
    for (int c = w; c < NCHUNK; c += 8) {
        v8i a[4], b[4];
#pragma unroll
        for (int m = 0; m < 4; ++m) { const v4i a0 = *(const v4i*)(ap + (size_t)(16 * m) * KB + 128 * c), a1 = *(const v4i*)(ap + (size_t)(16 * m) * KB + 128 * c + 16);
            const v4i b0 = *(const v4i*)(bp + (size_t)(16 * m) * KB + 128 * c), b1 = *(const v4i*)(bp + (size_t)(16 * m) * KB + 128 * c + 16);
            a[m] = __builtin_shufflevector(a0, a1, 0, 1, 2, 3, 4, 5, 6, 7); b[m] = __builtin_shufflevector(b0, b1, 0, 1, 2, 3, 4, 5, 6, 7); }
#pragma unroll
        for (int m = 0; m < 4; ++m)
#pragma unroll
            for (int n = 0; n < 4; ++n) asm volatile("v_mfma_scale_f32_16x16x128_f8f6f4 %0, %1, %2, %0, %3, %4 op_sel_hi:[0,0,0]" : "+v"(acc[m][n]) : "v"(b[n]), "v"(a[m]), "v"(vsc_b), "v"(vsc_a));
    }
    asm volatile("s_nop 15\n\ts_nop 15\n\ts_nop 15" ::: "memory");
    __syncthreads();
    LAS float* part = (LAS float*)lds + w * 4096;
#pragma unroll
    for (int m = 0; m < 4; ++m)
#pragma unroll
        for (int n = 0; n < 4; ++n) *(LAS f32x4*)(part + (16 * m + fr) * 64 + 16 * n + 4 * fq) = acc[m][n];
    __syncthreads();
    const int r = 8 * w + (lane >> 3), cc = 8 * (lane & 7);
    float v[8];
#pragma unroll
    for (int j = 0; j < 8; ++j) v[j] = 0.f;
#pragma unroll
    for (int p = 0; p < 8; ++p) { const LAS float* q = (const LAS float*)lds + p * 4096 + r * 64 + cc; const f32x4 x0 = *(const LAS f32x4*)q, x1 = *(const LAS f32x4*)(q + 4);
        v[0] += x0[0]; v[1] += x0[1]; v[2] += x0[2]; v[3] += x0[3]; v[4] += x1[0]; v[5] += x1[1]; v[6] += x1[2]; v[7] += x1[3]; }
    E(row0 + r, col0 + cc, brow0 + cc, v);
}
}

namespace gla {
constexpr int QS = 80;
constexpr int VS = 144;
constexpr int OS = 68;
constexpr int G_QF = 0, G_QB = 64 * QS, G_KF = 2 * 64 * QS, G_KB = 3 * 64 * QS, G_V = 4 * 64 * QS, G_SF = G_V + 64 * VS, G_SB = G_SF + 64 * QS, G_OST = G_SB + 64 * QS, G_END = G_OST + 64 * OS * 4;
static_assert(2 * G_END <= 131072, "GLA LDS");
__device__ __forceinline__ int chunk_row0(int b, int c) { return c < 4 ? MLAT + b * CTXL + c * 64 : b * SEQ + (c - 4) * 64; }
__device__ __forceinline__ float log_sigmoid(float z) { return fminf(z, 0.f) - __logf(1.0f + __expf(-fabsf(z))); }
__device__ __forceinline__ int crow(int r, int hi) { return (r & 3) + 8 * (r >> 2) + 4 * hi; }
__device__ __forceinline__ bf16x8 trfrag_nat(const LAS unsigned char* img, int stride, int k0, int ncol0, int lane) {
    const int hi = lane >> 5, q = (lane & 15) >> 2, p = lane & 3, g1 = (lane >> 4) & 1;
    const LAS unsigned char* a = img + (k0 + 8 * hi + q) * stride + (ncol0 + 16 * g1 + 4 * p) * 2;
    const s16x4 lo = att::vtr(a), hh = att::vtr(a + 4 * stride);
    return (bf16x8){lo[0], lo[1], lo[2], lo[3], hh[0], hh[1], hh[2], hh[3]};
}
__device__ __forceinline__ bf16x8 trfrag_perm(const LAS unsigned char* img, int stride, int k0, int ncol0, int lane) {
    const int hi = lane >> 5, q = (lane & 15) >> 2, p = lane & 3, g1 = (lane >> 4) & 1;
    const LAS unsigned char* a = img + (k0 + 4 * hi + q) * stride + (ncol0 + 16 * g1 + 4 * p) * 2;
    const s16x4 lo = att::vtr(a), hh = att::vtr(a + 8 * stride);
    return (bf16x8){lo[0], lo[1], lo[2], lo[3], hh[0], hh[1], hh[2], hh[3]};
}
__device__ __forceinline__ float dpp_prefix(float v) {
    int x = __builtin_bit_cast(int, v);
#define DPP_ADD(ctrl, rmask, bc) x = __builtin_bit_cast(int, __builtin_bit_cast(float, x) + __builtin_bit_cast(float, __builtin_amdgcn_update_dpp(0, x, ctrl, rmask, 0xf, bc)))
    DPP_ADD(0x111, 0xf, true); DPP_ADD(0x112, 0xf, true); DPP_ADD(0x114, 0xf, true); DPP_ADD(0x118, 0xf, true);
    DPP_ADD(0x142, 0xa, false); DPP_ADD(0x143, 0xc, false);
#undef DPP_ADD
    return __builtin_bit_cast(float, x);
}
__device__ __forceinline__ void scan_fwd(float (&x)[8], int lane) {
#pragma unroll
    for (int j = 0; j < 8; ++j) x[j] = dpp_prefix(x[j]);
}
__device__ __forceinline__ void scan_bwd(float (&x)[8], int lane) {
#pragma unroll
    for (int j = 0; j < 8; ++j) { const float p = dpp_prefix(x[j]); const float tot = __shfl(p, 63); x[j] = tot - p + x[j]; }
}
struct UnitId { int b, h, c; bool valid; };

struct G1Regs { v4u ck, czf, czb, cv0, cv1; };
__device__ __forceinline__ UnitId unit_of(int u, int NU, int nc) { UnitId id; id.valid = u < NU; const int uu = id.valid ? u : 0; id.c = (NCH - nc) + uu % nc; const int bh = uu / nc; id.b = bh >> 2; id.h = bh & 3; return id; }
__device__ __forceinline__ void g1_load(G1Regs& R, const bf16* P, const UnitId u, int lane, int w) {
    if (u.valid) { const bf16* pr = P + (size_t)(chunk_row0(u.b, u.c) + lane) * NP;
        R.ck = *(const v4u*)(pr + PC_GLK + 32 * u.h + 8 * w); R.czf = *(const v4u*)(pr + PC_ZF + 32 * u.h + 8 * w); R.czb = *(const v4u*)(pr + PC_ZB + 32 * u.h + 8 * w);
        R.cv0 = *(const v4u*)(pr + PC_GLV + 64 * u.h + 16 * w); R.cv1 = *(const v4u*)(pr + PC_GLV + 64 * u.h + 16 * w + 8); }
}
__device__ __forceinline__ void g1_phase(LAS unsigned char* lds, const bf16* P, const float* ab_f, const float* ab_b, float* KV, float* DEC, int G) {
    const int tid = ltid(), lane = tid & 63; const int wid = __builtin_amdgcn_readfirstlane(tid >> 6); const int grp = wid >> 2, w = wid & 3;
    LAS unsigned char* gb = lds + grp * G_END;
    const int NU = NB * 4 * NCH, npairs = (NU + 1) / 2;
    int pi = blockIdx.x; if (pi >= npairs) return;
    UnitId u = unit_of(2 * pi + grp, NU, NCH);
    G1Regs R; R.ck = R.czf = R.czb = R.cv0 = R.cv1 = (v4u){0u, 0u, 0u, 0u};
    g1_load(R, P, u, lane, w);
    for (;;) {
        __syncthreads();
        if (u.valid) {
            float lf[8], lb[8], k[8], z[8];
            unpack8(R.czf, z);
#pragma unroll
            for (int j = 0; j < 8; ++j) lf[j] = log_sigmoid(z[j] + ab_f[32 * u.h + 8 * w + j]) * (1.0f / 16.0f);
            unpack8(R.czb, z);
#pragma unroll
            for (int j = 0; j < 8; ++j) lb[j] = log_sigmoid(z[j] + ab_b[32 * u.h + 8 * w + j]) * (1.0f / 16.0f);
            scan_fwd(lf, lane); scan_bwd(lb, lane);
            unpack8(R.ck, k);
            float wf[8], wb[8];
#pragma unroll
            for (int j = 0; j < 8; ++j) { const float fl = __shfl(lf[j], 63), bl = __shfl(lb[j], 0); wf[j] = k[j] * __expf(fl - lf[j]); wb[j] = k[j] * __expf(bl - lb[j]); }
            *(LAS v4u*)(gb + G_QF + lane * QS + 16 * w) = pack8(wf);
            *(LAS v4u*)(gb + G_QB + lane * QS + 16 * w) = pack8(wb);
            *(LAS v4u*)(gb + G_V + lane * VS + 32 * w) = R.cv0; *(LAS v4u*)(gb + G_V + lane * VS + 32 * w + 16) = R.cv1;
            const int sf = u.c, sb = u.c < 4 ? 3 - u.c : 71 - u.c; const int bhf = (u.b * 4 + u.h) * 2;
            if (lane == 63) {
#pragma unroll
                for (int j = 0; j < 8; ++j) DEC[((size_t)bhf * NCH + sf) * 32 + 8 * w + j] = __expf(lf[j]); }
            if (lane == 0) {
#pragma unroll
                for (int j = 0; j < 8; ++j) DEC[((size_t)(bhf + 1) * NCH + sb) * 32 + 8 * w + j] = __expf(lb[j]); }
        }
        const int pn = pi + G; const bool more = pn < npairs;
        const UnitId un = unit_of(more ? 2 * pn + grp : NU, NU, NCH);
        g1_load(R, P, un, lane, w);
        __syncthreads();
        if (u.valid) {
            const int dir = w >> 1, et = w & 1, r32 = lane & 31, hi = lane >> 5;
            f32x16 acc = f32x16{};
#pragma unroll
            for (int ks = 0; ks < 4; ++ks) { const bf16x8 a = trfrag_nat(gb + (dir ? G_QB : G_QF), QS, 16 * ks, 0, lane); const bf16x8 bb = trfrag_nat(gb + G_V, VS, 16 * ks, 32 * et, lane);
                acc = __builtin_amdgcn_mfma_f32_32x32x16_bf16(a, bb, acc, 0, 0, 0); }
            const int sq = dir ? (u.c < 4 ? 3 - u.c : 71 - u.c) : u.c;
            float* kv = KV + ((size_t)((u.b * 4 + u.h) * 2 + dir) * NCH + sq) * 2048;
#pragma unroll
            for (int r = 0; r < 16; ++r) kv[crow(r, hi) * 64 + 32 * et + r32] = acc[r];
        }
        if (!more) break;
        pi = pn; u = un;
    }
}

__device__ __forceinline__ void g2_scan(float* KV, const float* DEC, int gtid, int gthreads) {
    for (int idx = gtid; idx < 32 * 2048; idx += gthreads) {
        const int bhd = idx >> 11, el = idx & 2047, d = el >> 6;
        float* kv = KV + (size_t)bhd * NCH * 2048 + el; const float* dc = DEC + (size_t)bhd * NCH * 32 + d;
        float x[NCH], g[NCH];
#pragma unroll
        for (int s = 0; s < NCH; ++s) { x[s] = kv[(size_t)s * 2048]; g[s] = dc[s * 32]; }
        float S = 0.f;
#pragma unroll
        for (int s = 0; s < NCH; ++s) { kv[(size_t)s * 2048] = S; S = g[s] * S + x[s]; }
    }
}

struct G3Regs { v4u cq, ck, czf, czb, cv0, cv1, r0, r1; float sf[8], sb[8]; };
__device__ __forceinline__ void g3_load(G3Regs& R, const bf16* P, const float* KV, const UnitId u, int tid, int lane, int w) {
    if (u.valid) { const bf16* pr = P + (size_t)(chunk_row0(u.b, u.c) + lane) * NP;
        R.cq = *(const v4u*)(pr + PC_GLQ + 32 * u.h + 8 * w); R.ck = *(const v4u*)(pr + PC_GLK + 32 * u.h + 8 * w); R.czf = *(const v4u*)(pr + PC_ZF + 32 * u.h + 8 * w); R.czb = *(const v4u*)(pr + PC_ZB + 32 * u.h + 8 * w);
        R.cv0 = *(const v4u*)(pr + PC_GLV + 64 * u.h + 16 * w); R.cv1 = *(const v4u*)(pr + PC_GLV + 64 * u.h + 16 * w + 8);
        const int sfi = u.c, sbi = u.c < 4 ? 3 - u.c : 71 - u.c; const int bhf = (u.b * 4 + u.h) * 2; const int tg = tid & 255, e = tg & 63, dq = tg >> 6;
        const float* Sf = KV + ((size_t)bhf * NCH + sfi) * 2048 + (8 * dq) * 64 + e; const float* Sb = KV + ((size_t)(bhf + 1) * NCH + sbi) * 2048 + (8 * dq) * 64 + e;
#pragma unroll
        for (int j = 0; j < 8; ++j) { R.sf[j] = Sf[j * 64]; R.sb[j] = Sb[j * 64]; }
        { const int t = tg >> 2, part = tg & 3; const bf16* rp = P + (size_t)(chunk_row0(u.b, u.c) + t) * NP + PC_GLR + 64 * u.h + 16 * part; R.r0 = *(const v4u*)rp; R.r1 = *(const v4u*)(rp + 8); } }
}
__device__ __forceinline__ void g3_phase(LAS unsigned char* lds, const bf16* P, int nc_in, const float* ab_f, const float* ab_b, const float* KV, const float* gnorm, bf16* MIX, int G) {
    const int tid = ltid(), lane = tid & 63; const int wid = __builtin_amdgcn_readfirstlane(tid >> 6); const int grp = wid >> 2, w = wid & 3;
    LAS unsigned char* gb = lds + grp * G_END;
    const int nc = opaque_s(nc_in);
    const int NU = NB * 4 * nc, npairs = (NU + 1) / 2;
    int pi = blockIdx.x; if (pi >= npairs) return;
    UnitId u = unit_of(2 * pi + grp, NU, nc);
    G3Regs R; R.cq = R.ck = R.czf = R.czb = R.cv0 = R.cv1 = R.r0 = R.r1 = (v4u){0u, 0u, 0u, 0u};
#pragma unroll
    for (int j = 0; j < 8; ++j) { R.sf[j] = 0.f; R.sb[j] = 0.f; }
    g3_load(R, P, KV, u, tid, lane, w);
    for (;;) {
        const int row0 = chunk_row0(u.b, u.c);
        __syncthreads();
        if (u.valid) {
            { const int tg = tid & 255, e = tg & 63, dq = tg >> 6;
              *(LAS v4u*)(gb + G_SF + e * QS + 16 * dq) = pack8(R.sf); *(LAS v4u*)(gb + G_SB + e * QS + 16 * dq) = pack8(R.sb); }
            float lf[8], lb[8], z[8];
            unpack8(R.czf, z);
#pragma unroll
            for (int j = 0; j < 8; ++j) lf[j] = log_sigmoid(z[j] + ab_f[32 * u.h + 8 * w + j]) * (1.0f / 16.0f);
            unpack8(R.czb, z);
#pragma unroll
            for (int j = 0; j < 8; ++j) lb[j] = log_sigmoid(z[j] + ab_b[32 * u.h + 8 * w + j]) * (1.0f / 16.0f);
            scan_fwd(lf, lane); scan_bwd(lb, lane);
            float q[8], k[8], t0[8], t1[8];
            unpack8(R.cq, q); unpack8(R.ck, k);
#pragma unroll
            for (int j = 0; j < 8; ++j) { q[j] *= 0.17677669529663687f; t0[j] = q[j] * __expf(lf[j]); t1[j] = k[j] * __expf(-lf[j]); }
            *(LAS v4u*)(gb + G_QF + lane * QS + 16 * w) = pack8(t0); *(LAS v4u*)(gb + G_KF + lane * QS + 16 * w) = pack8(t1);
#pragma unroll
            for (int j = 0; j < 8; ++j) { t0[j] = q[j] * __expf(lb[j]); t1[j] = k[j] * __expf(-lb[j]); }
            *(LAS v4u*)(gb + G_QB + lane * QS + 16 * w) = pack8(t0); *(LAS v4u*)(gb + G_KB + lane * QS + 16 * w) = pack8(t1);
            *(LAS v4u*)(gb + G_V + lane * VS + 32 * w) = R.cv0; *(LAS v4u*)(gb + G_V + lane * VS + 32 * w + 16) = R.cv1;
        }
        const v4u cur_r0 = R.r0, cur_r1 = R.r1;
        const int pn = pi + G; const bool more = pn < npairs;
        const UnitId un = unit_of(more ? 2 * pn + grp : NU, NU, nc);
        g3_load(R, P, KV, un, tid, lane, w);
        __syncthreads();
        if (u.valid) {
            const int tt = w >> 1, et = w & 1, r32 = lane & 31, hi = lane >> 5;
            bf16x8 qf[2], qb[2];
#pragma unroll
            for (int ks = 0; ks < 2; ++ks) { qf[ks] = *(const LAS bf16x8*)(gb + G_QF + (32 * tt + r32) * QS + (16 * ks + 8 * hi) * 2); qb[ks] = *(const LAS bf16x8*)(gb + G_QB + (32 * tt + r32) * QS + (16 * ks + 8 * hi) * 2); }
            f32x16 o = f32x16{};
#pragma unroll
            for (int st = 0; st < 2; ++st) {
                f32x16 xf = f32x16{}, xb = f32x16{};
                if (st <= tt) {
#pragma unroll
                    for (int ks = 0; ks < 2; ++ks) { const bf16x8 kf = *(const LAS bf16x8*)(gb + G_KF + (32 * st + r32) * QS + (16 * ks + 8 * hi) * 2); xf = __builtin_amdgcn_mfma_f32_32x32x16_bf16(kf, qf[ks], xf, 0, 0, 0); } }
                if (st >= tt) {
#pragma unroll
                    for (int ks = 0; ks < 2; ++ks) { const bf16x8 kb = *(const LAS bf16x8*)(gb + G_KB + (32 * st + r32) * QS + (16 * ks + 8 * hi) * 2); xb = __builtin_amdgcn_mfma_f32_32x32x16_bf16(kb, qb[ks], xb, 0, 0, 0); } }
                float x[16];
#pragma unroll
                for (int r = 0; r < 16; ++r) { const int sl = crow(r, hi);
                    const float vf = (st < tt || (st == tt && sl <= r32)) ? xf[r] : 0.f; const float vb = (st > tt || (st == tt && sl >= r32)) ? xb[r] : 0.f; x[r] = vf + vb; }
#pragma unroll
                for (int s2 = 0; s2 < 2; ++s2) {
                    v4u pw; pw.x = att::cvtpk(x[8 * s2 + 0], x[8 * s2 + 1]); pw.y = att::cvtpk(x[8 * s2 + 2], x[8 * s2 + 3]); pw.z = att::cvtpk(x[8 * s2 + 4], x[8 * s2 + 5]); pw.w = att::cvtpk(x[8 * s2 + 6], x[8 * s2 + 7]);
                    const bf16x8 vf = trfrag_perm(gb + G_V, VS, 32 * st + 16 * s2, 32 * et, lane);
                    o = __builtin_amdgcn_mfma_f32_32x32x16_bf16(__builtin_bit_cast(bf16x8, pw), vf, o, 0, 0, 0); }
            }
#pragma unroll
            for (int ks = 0; ks < 2; ++ks) { const bf16x8 sf = *(const LAS bf16x8*)(gb + G_SF + (32 * et + r32) * QS + (16 * ks + 8 * hi) * 2); const bf16x8 sb = *(const LAS bf16x8*)(gb + G_SB + (32 * et + r32) * QS + (16 * ks + 8 * hi) * 2);
                o = __builtin_amdgcn_mfma_f32_32x32x16_bf16(qf[ks], sf, o, 0, 0, 0); o = __builtin_amdgcn_mfma_f32_32x32x16_bf16(qb[ks], sb, o, 0, 0, 0); }
            LAS float* stg = (LAS float*)(gb + G_OST);
#pragma unroll
            for (int r = 0; r < 16; ++r) stg[(32 * tt + crow(r, hi)) * OS + 32 * et + r32] = o[r];
        }
        __syncthreads();
        if (u.valid) {
            const int tg = tid & 255, t = tg >> 2, part = tg & 3; const LAS float* stg = (const LAS float*)(gb + G_OST) + t * OS + 16 * part;
            float x[16]; float ss = 0.f;
#pragma unroll
            for (int j = 0; j < 16; ++j) { x[j] = stg[j]; ss += x[j] * x[j]; }
            ss += xor1(ss); ss += xor2(ss);
            const float rstd = __builtin_amdgcn_rsqf(ss * (1.0f / 64.0f) + EPS);
            const size_t row = (size_t)(row0 + t); float rv[16];
            { float a[8]; unpack8(cur_r0, a);
#pragma unroll
              for (int j = 0; j < 8; ++j) rv[j] = a[j];
              unpack8(cur_r1, a);
#pragma unroll
              for (int j = 0; j < 8; ++j) rv[8 + j] = a[j]; }
            float y0[8], y1[8];
#pragma unroll
            for (int j = 0; j < 8; ++j) { const float r0 = rv[j], r1 = rv[8 + j];
                y0[j] = x[j] * rstd * gnorm[16 * part + j] * (r0 * __builtin_amdgcn_rcpf(1.0f + __expf(-r0))); y1[j] = x[8 + j] * rstd * gnorm[16 * part + 8 + j] * (r1 * __builtin_amdgcn_rcpf(1.0f + __expf(-r1))); }
            bf16* op = MIX + row * 1024 + 64 * u.h + 16 * part;
            *(GAS v4u*)op = pack8(y0); *(GAS v4u*)(op + 8) = pack8(y1);
        }
        if (!more) break;
        pi = pn; u = un;
    }
}
}

constexpr size_t MiB = 1u << 20;
constexpr size_t WS_CTL = 0, CTL_ZERO_BYTES = 256 * 1024;
constexpr size_t WS_SS2 = 64 * 1024, WS_SS1 = 136 * 1024;
constexpr size_t WS_BIASGU = 5 * MiB, WS_BIASIN = 5 * MiB + 128 * 1024;
constexpr size_t WS_MOD = 1 * MiB;
constexpr size_t WS_ROPE = 1 * MiB + 512 * 1024;
constexpr size_t WS_TOKE = 2 * MiB;
constexpr size_t WS_TOKW = 2 * MiB + 256 * 1024;
constexpr size_t WS_POS = 2 * MiB + 512 * 1024;
constexpr size_t WS_ROWL = 3 * MiB;
constexpr size_t WS_ROWW = 3 * MiB + 256 * 1024;
constexpr size_t WS_PANE = 3 * MiB + 512 * 1024;
constexpr size_t WS_QKMAX = 3 * MiB + 768 * 1024;
constexpr size_t WS_DEC = 4 * MiB;
constexpr size_t WS_WIN = 8 * MiB, WS_WOUT = 18 * MiB, WS_WGU = 22 * MiB, WS_WDN = 33 * MiB;
constexpr size_t WS_XCTX = 39 * MiB;
constexpr size_t WS_H = 43 * MiB;
constexpr size_t WS_MGU = 77 * MiB, WS_MDN = 133 * MiB;
constexpr size_t WS_P = 245 * MiB;
constexpr size_t WS_GQ = 330 * MiB, WS_GK = 347 * MiB, WS_GV = 351 * MiB + 512 * 1024;
constexpr size_t WS_DQ = 356 * MiB, WS_DK = 364 * MiB + 512 * 1024, WS_DV = 373 * MiB;
constexpr size_t WS_KV = 382 * MiB;
constexpr size_t WS_MIX = 399 * MiB;
constexpr size_t WS_ACT = 245 * MiB;
constexpr size_t WS_ACT2 = 245 * MiB;
constexpr size_t WS_Y2 = 161 * MiB;
constexpr size_t WS_END = 483 * MiB;
static_assert(WS_P + (size_t)MT * NP * 2 <= WS_GQ && WS_GQ + (size_t)MT * 512 * 2 <= WS_GK && WS_GK + (size_t)NB * LK * 128 * 2 <= WS_GV && WS_GV + (size_t)NB * LK * 128 * 2 <= WS_DQ, "ws map 1");
static_assert(WS_DQ + (size_t)MT * 256 * 2 <= WS_DK && WS_DK + (size_t)NB * LK * 256 * 2 <= WS_DV && WS_DV + (size_t)NB * LK * 256 * 2 <= WS_KV && WS_KV + (size_t)32 * NCH * 2048 * 4 <= WS_MIX && WS_MIX + (size_t)MT * 1024 * 2 <= WS_END, "ws map 2");
static_assert(WS_ACT + (size_t)MT * DFF * 2 <= WS_KV && WS_ACT2 + (size_t)MOE_ROWS * DFFE <= WS_END && WS_Y2 + (size_t)MOE_ROWS * 1024 * 2 <= WS_P, "ws map 3");
static_assert(WS_WIN + (size_t)2 * NP * D * 2 <= WS_WOUT && WS_WOUT + (size_t)2 * D * D * 2 <= WS_WGU && WS_WGU + (size_t)2 * DFF * D * 2 <= WS_WDN && WS_WDN + (size_t)D * DFF * 2 <= WS_XCTX && WS_XCTX + (size_t)MCTX * D * 4 <= WS_H && WS_H + (size_t)MT * D * 2 <= WS_MGU, "ws map 4");
static_assert(WS_MGU + (size_t)NE * 2 * DFFE * D <= WS_MDN && WS_MDN + (size_t)NE * D * DFFE <= WS_Y2, "ws map 5");
constexpr int CW_TMO = 0, CW_CODE = 1, CW_BAR = 4096;

constexpr int RING_OFF = 0, RING_BYTES = 131072;
constexpr int LDSCTL_OFF = 147456 - 1024, MISC_OFF = LDSCTL_OFF + 320;
constexpr int LDS_BYTES = 147456;
constexpr int NWAVES = 8;

struct Frame {
    LAS unsigned char* lds; volatile LAS unsigned* MISC; gu32* ctl;
    int tid, lane, wave, vcu, G;
    unsigned char* ws; float* out;
    const float* const* in;
};
#define FIN(i) (F.in[i])
#define WSP(T, off) ((T*)(F.ws + (off)))
#define RELAUNDER(F) do { const int t_ = ltid(); (F).tid = t_; (F).lane = t_ & 63; (F).wave = __builtin_amdgcn_readfirstlane(t_ >> 6); } while (0)

__device__ __forceinline__ void p0_transpose_item(const float* W, int K, int N, bf16* WT, int dst_row0, LAS float* scr, int k0, int n0, int lane) {
    { float wv[32];
#pragma unroll
      for (int i = 0; i < 32; ++i) { const int kk = 2 * i + (lane >> 5); wv[i] = W[(size_t)(k0 + kk) * N + n0 + (lane & 31)]; }
#pragma unroll
      for (int i = 0; i < 32; ++i) { const int kk = 2 * i + (lane >> 5); scr[kk * 33 + (lane & 31)] = wv[i]; } }
    LDS_WAIT(); asm volatile("" ::: "memory");
    const int c = lane & 7;
#pragma unroll
    for (int j = 0; j < 4; ++j) { const int n = (lane >> 3) + 8 * j; const LAS float* s = scr + (8 * c) * 33 + n;
        v4u o; o.x = pk2(s[0 * 33], s[1 * 33]); o.y = pk2(s[2 * 33], s[3 * 33]); o.z = pk2(s[4 * 33], s[5 * 33]); o.w = pk2(s[6 * 33], s[7 * 33]);
        *(GAS v4u*)(WT + (size_t)(dst_row0 + n) * K + k0 + 8 * c) = o; }
    LDS_WAIT(); asm volatile("" ::: "memory");
}
__device__ __forceinline__ void p0_transpose_item_f8(const float* W, int K, int N, unsigned char* WT8, int dst_row0, LAS float* scr, int k0, int n0, int lane, float mul) {
    { float wv[32];
#pragma unroll
      for (int i = 0; i < 32; ++i) { const int kk = 2 * i + (lane >> 5); wv[i] = W[(size_t)(k0 + kk) * N + n0 + (lane & 31)]; }
#pragma unroll
      for (int i = 0; i < 32; ++i) { const int kk = 2 * i + (lane >> 5); scr[kk * 33 + (lane & 31)] = wv[i]; } }
    LDS_WAIT(); asm volatile("" ::: "memory");
    const int c = lane & 7;
#pragma unroll
    for (int j = 0; j < 4; ++j) { const int n = (lane >> 3) + 8 * j; const LAS float* s = scr + (8 * c) * 33 + n;
        typedef unsigned u32x2 __attribute__((ext_vector_type(2))); u32x2 o;
        o.x = pg8::pack_fp8x4(s[0 * 33] * mul, s[1 * 33] * mul, s[2 * 33] * mul, s[3 * 33] * mul); o.y = pg8::pack_fp8x4(s[4 * 33] * mul, s[5 * 33] * mul, s[6 * 33] * mul, s[7 * 33] * mul);
        *(GAS u32x2*)(WT8 + (size_t)(dst_row0 + n) * K + k0 + 8 * c) = o; }
    LDS_WAIT(); asm volatile("" ::: "memory");
}
__device__ __forceinline__ int gu_row(int n0, int up) { return 256 * (n0 >> 7) + (up ? 128 : 0) + (n0 & 127); }

constexpr int I_MG = 16 * 112, I_MD = 56 * 32, MOE_ITEMS = 16 * I_MG + 8 * I_MD;
#ifndef CONV_IN_ATTN
#define CONV_IN_ATTN 1
#endif
constexpr int SLOT_A_WG = 88, SLOT_B_WG = 40, SLOT_C_WG = 88, SLOT_A_Q = CONV_IN_ATTN ? 0 : 64, SLOT_B_Q = CONV_IN_ATTN ? 0 : 96, SLOT_C_Q = CONV_IN_ATTN ? 0 : 64;
constexpr int SLOT_A0 = 0, SLOT_B0 = SLOT_A0 + SLOT_A_WG * SLOT_A_Q, SLOT_C0 = SLOT_B0 + SLOT_B_WG * SLOT_B_Q, MOE_SLOT_ITEMS = SLOT_C0 + SLOT_C_WG * SLOT_C_Q;
static_assert(MOE_SLOT_ITEMS < MOE_ITEMS, "slot plan");
constexpr int MOE_PROLOGUE_ITEMS = CONV_IN_ATTN ? 0 : MOE_ITEMS - MOE_SLOT_ITEMS;
__device__ __forceinline__ void moe_item(Frame& F, LAS float* scr, int m) {
    if (m < 16 * I_MG) { const int eu = m / I_MG; const int r = m - eu * I_MG; const int e = eu >> 1, up = eu & 1; const int kb = r / 112, nb = r % 112;
        p0_transpose_item_f8((up ? FIN(27) : FIN(26)) + (size_t)e * D * DFFE, D, DFFE, WSP(unsigned char, WS_MGU) + (size_t)e * 2 * DFFE * D, gu_row(nb * 32, up), scr, kb * 64, nb * 32, F.lane, 128.0f); }
    else { const int m2 = m - 16 * I_MG; const int e = m2 / I_MD; const int r = m2 - e * I_MD; const int kb = r / 32, nb = r % 32;
        p0_transpose_item_f8(FIN(28) + (size_t)e * DFFE * D, DFFE, D, WSP(unsigned char, WS_MDN) + (size_t)e * D * DFFE, nb * 32, scr, kb * 64, nb * 32, F.lane, 128.0f); }
}
__device__ __forceinline__ void moe_slot(Frame& F, int base, int idx, int q) {
    RELAUNDER(F);
    LAS float* scr = (LAS float*)(F.lds + RING_OFF + F.wave * 8704);
    __syncthreads();
    for (int i = F.wave; i < q; i += NWAVES) moe_item(F, scr, base + idx * q + i);
    __syncthreads();
}
constexpr int AUX_OUT = 2 * 16 * 32, AUX_FG = 2 * 16 * 88, AUX_FD = 44 * 32, AUX_IN1 = 16 * 73, AUX_ITEMS = AUX_OUT + AUX_FG + AUX_FD + AUX_IN1, AUX_WG = 88, AUX_Q = (AUX_ITEMS + AUX_WG - 1) / AUX_WG;
__device__ __forceinline__ void aux_item(Frame& F, LAS float* scr, int r) {
    if (r < AUX_OUT) { const int l = r / 512; r -= l * 512; const int kb = r / 32, nb = r % 32;
        p0_transpose_item(FIN(9) + (size_t)l * D * D, D, D, WSP(bf16, WS_WOUT) + (size_t)l * D * D, nb * 32, scr, kb * 64, nb * 32, F.lane); return; }
    r -= AUX_OUT;
    if (r < AUX_FG) { const int up = r / 1408; r -= up * 1408; const int kb = r / 88, nb = r % 88;
        p0_transpose_item(up ? FIN(23) : FIN(22), D, DFF, WSP(bf16, WS_WGU), gu_row(nb * 32, up), scr, kb * 64, nb * 32, F.lane); return; }
    r -= AUX_FG;
    if (r < AUX_FD) { const int kb = r / 32, nb = r % 32;
        p0_transpose_item(FIN(24), DFF, D, WSP(bf16, WS_WDN), nb * 32, scr, kb * 64, nb * 32, F.lane); return; }
    r -= AUX_FD;
    { const int kb = r / 73, nb = r % 73; if (nb == 24) return; const int n0 = nb * 32;
        p0_transpose_item(FIN(8) + (size_t)D * INW, D, INW, WSP(bf16, WS_WIN) + (size_t)NP * D, n0 < 768 ? n0 : n0 + 224, scr, kb * 64, n0, F.lane); }
}
__device__ __forceinline__ void aux_slot(Frame& F, int idx) {
    RELAUNDER(F);
    LAS float* scr = (LAS float*)(F.lds + RING_OFF + F.wave * 8704);
    __syncthreads();
    for (int i = F.wave; i < AUX_Q; i += NWAVES) { const int it = idx * AUX_Q + i; if (it < AUX_ITEMS) aux_item(F, scr, it); }
    __syncthreads();
}
__device__ __forceinline__ int idle_index(int nwg, int G, int c) { const int rounds = (nwg + G - 1) / G; const int first = nwg - (rounds - 1) * G; return c >= first ? c - first : -1; }
__device__ __forceinline__ int idle_count(int nwg, int G) { const int rounds = (nwg + G - 1) / G; return rounds * G - nwg; }
__device__ __forceinline__ void slot_leftover(Frame& F, int base, int planned, int nwg, int q) {
    const int actual = idle_count(nwg, F.G) < planned ? idle_count(nwg, F.G) : planned;
    for (int w = actual + (int)blockIdx.x; w < planned; w += F.G) moe_slot(F, base, w, q);
}
__device__ __forceinline__ void p0_prologue(Frame& F) {
    RELAUNDER(F);
    {
        LAS float* s5 = (LAS float*)(F.lds + RING_OFF);
        LAS float* red = (LAS float*)(F.lds + RING_OFF + 5 * 1024 * 4);
        bool have = false;
        for (int u = blockIdx.x; u < 192; u += F.G) {
            if (!have) { for (int i = F.tid; i < 5 * 1024; i += 512) { const int r = i >> 10, k = i & 1023; const float v = r < 4 ? FIN(1)[r * 1024 + k] : FIN(3)[k]; s5[i] = v / (1.0f + expf(-v)); } have = true; }
            __syncthreads();
            const int l = u / 96, cg = u % 96; const float* W = FIN(4) + (size_t)l * 1024 * 6144 + cg * 64 + F.lane;
            float a0 = 0.f, a1 = 0.f, a2 = 0.f, a3 = 0.f, a4 = 0.f; const int kb = F.wave * 128;
#pragma unroll 64
            for (int k = 0; k < 128; ++k) { const float w = W[(size_t)(kb + k) * 6144];
                a0 += s5[kb + k] * w; a1 += s5[1024 + kb + k] * w; a2 += s5[2048 + kb + k] * w; a3 += s5[3072 + kb + k] * w; a4 += s5[4096 + kb + k] * w; }
            red[(F.wave * 5 + 0) * 64 + F.lane] = a0; red[(F.wave * 5 + 1) * 64 + F.lane] = a1; red[(F.wave * 5 + 2) * 64 + F.lane] = a2; red[(F.wave * 5 + 3) * 64 + F.lane] = a3; red[(F.wave * 5 + 4) * 64 + F.lane] = a4;
            __syncthreads();
            if (F.tid < 320) { const int r = F.tid >> 6, col = F.tid & 63; float s = FIN(5)[l * 6144 + cg * 64 + col];
#pragma unroll
                for (int w = 0; w < 8; ++w) s += red[(w * 5 + r) * 64 + col];
                WSP(float, WS_MOD)[(l * 5 + r) * 6144 + cg * 64 + col] = s; }
            __syncthreads();
        }
        __syncthreads();
    }
    if ((int)blockIdx.x == F.G - 1) {
        float* rope = WSP(float, WS_ROPE);
        for (int idx = F.tid; idx < 1024 + 512; idx += 512) {
            const bool gq = idx < 1024; const int j = gq ? idx : idx - 1024; const int pos = gq ? (j >> 4) : (j >> 3), fi = gq ? (j & 15) : (j & 7);
            const double base = gq ? 0.56234132519034908 : 0.31622776601683794;
            double f = 1.0; for (int q = 0; q < fi; ++q) f *= base;
            const double ang = (double)pos * f;
            const double nq = __builtin_rint(ang * 0.63661977236758134);
            const double r = (ang - nq * 1.5707963267948966) - nq * 6.123233995736766e-17;
            const double r2 = r * r;
            double sn = r * (1.0 + r2 * (-1.0 / 6 + r2 * (1.0 / 120 + r2 * (-1.0 / 5040 + r2 * (1.0 / 362880 + r2 * (-1.0 / 39916800 + r2 * (1.0 / 6227020800.0 + r2 * (-1.0 / 1307674368000.0))))))));
            double cs = 1.0 + r2 * (-0.5 + r2 * (1.0 / 24 + r2 * (-1.0 / 720 + r2 * (1.0 / 40320 + r2 * (-1.0 / 3628800 + r2 * (1.0 / 479001600.0 + r2 * (-1.0 / 87178291200.0 + r2 * (1.0 / 20922789888000.0))))))));
            const int qd = ((int)nq) & 3;
            const double cv = qd == 0 ? cs : qd == 1 ? -sn : qd == 2 ? -cs : sn;
            const double sv = qd == 0 ? sn : qd == 1 ? cs : qd == 2 ? -sn : -cs;
            if (gq) { rope[j] = (float)cv; rope[1024 + j] = (float)sv; } else { rope[2048 + j] = (float)cv; rope[2560 + j] = (float)sv; }
        }
    }
    const int gw = F.vcu * NWAVES + F.wave, NGW = F.G * NWAVES;
    for (int it = gw; it < 2 * 2 * 128 * 2; it += NGW) {
        const int kb = it & 1, j = (it >> 1) & 127, dir = (it >> 8) & 1, l = it >> 9;
        const float* a2 = (dir ? FIN(12) : FIN(10)) + l * 16 * 128 + j; float a[16];
#pragma unroll
        for (int r = 0; r < 16; ++r) a[r] = a2[r * 128];
        const int k0 = kb * 512 + F.lane * 8; float o[8];
#pragma unroll
        for (int kk = 0; kk < 8; ++kk) { const float* wr = FIN(8) + (size_t)l * D * INW + (size_t)(k0 + kk) * INW + 768 + 16 * dir; float s = 0.f;
#pragma unroll
            for (int r = 0; r < 16; ++r) s += wr[r] * a[r];
            o[kk] = s; }
        *(GAS v4u*)(WSP(bf16, WS_WIN) + ((size_t)l * NP + 768 + 128 * dir + j) * D + k0) = pack8(o);
    }
    LAS float* scr = (LAS float*)(F.lds + RING_OFF + 32768 + F.wave * 8704);
    constexpr int I_IN = 16 * 73;
    constexpr int NITEMS = I_IN + MOE_PROLOGUE_ITEMS;
    for (int it = gw; it < NITEMS; it += NGW) {
        int r = it;
        if (r < I_IN) { const int kb = r / 73, nb = r % 73; if (nb == 24) continue;
            const int n0 = nb * 32; p0_transpose_item(FIN(8), D, INW, WSP(bf16, WS_WIN), n0 < 768 ? n0 : n0 + 224, scr, kb * 64, n0, F.lane); continue; }
        r -= I_IN;
        moe_item(F, scr, r + MOE_SLOT_ITEMS);
    }
}

template <bool ROUTER>
__device__ __forceinline__ void phase_norm(Frame& F, int l, int which, const float* xlat, const float* xctx) {
    RELAUNDER(F);
    const int gw = F.vcu * NWAVES + F.wave, NGW = F.G * NWAVES;
    const float* nw = (which ? FIN(7) : FIN(6)) + l * 1024;
    const float* mod = WSP(float, WS_MOD) + (size_t)l * 5 * 6144;
    bf16* H = WSP(bf16, WS_H);
    LAS float* cwL = (LAS float*)(F.lds + RING_OFF); LAS float* csL = cwL + 5 * 1024;
    __syncthreads();
    { float a_[10], b_[10], c_[10];
#pragma unroll
      for (int q = 0; q < 10; ++q) { const int i = F.tid + 512 * q; const int b = i >> 10, col = i & 1023; a_[q] = nw[col]; b_[q] = mod[b * 6144 + (which ? 4 : 1) * 1024 + col]; c_[q] = mod[b * 6144 + (which ? 3 : 0) * 1024 + col]; }
#pragma unroll
      for (int q = 0; q < 10; ++q) { const int i = F.tid + 512 * q; cwL[i] = a_[q] * (1.0f + b_[q]); csL[i] = c_[q]; } }
    LAS float* wrL = csL + 5 * 1024;
    if (ROUTER) { for (int i = F.tid; i < 2048; i += 512) *(LAS f32x4*)(wrL + 4 * i) = *(const f32x4*)(FIN(25) + 4 * i); }
    __syncthreads();
    for (int rb = gw; rb < MT; rb += 4 * NGW) {
        f32x4 xv[4][4];
#pragma unroll
        for (int r = 0; r < 4; ++r) { const int row = rb + r * NGW; if (row < MT) { const float* xr = row < MLAT ? xlat + (size_t)row * 1024 : xctx + (size_t)(row - MLAT) * 1024;
#pragma unroll
            for (int j = 0; j < 4; ++j) xv[r][j] = *(const f32x4*)(xr + 4 * F.lane + 256 * j); } }
#pragma unroll
        for (int r = 0; r < 4; ++r) {
            const int row = rb + r * NGW; if (row >= MT) break;
            const int bidx = row < MLAT ? (row >> 12) : 4;
            f32x4 v[4]; float ss = 0.f;
#pragma unroll
            for (int j = 0; j < 4; ++j) { v[j] = xv[r][j]; ss += (v[j].x * v[j].x + v[j].y * v[j].y) + (v[j].z * v[j].z + v[j].w * v[j].w); }
            const float rstd = 1.0f / sqrtf(wave_sum(ss) * (1.0f / 1024.0f) + EPS);
#pragma unroll
            for (int j = 0; j < 4; ++j) { const f32x4 cw = *(const LAS f32x4*)(cwL + bidx * 1024 + 4 * F.lane + 256 * j), cs = *(const LAS f32x4*)(csL + bidx * 1024 + 4 * F.lane + 256 * j);
                v[j] = v[j] * rstd * cw + cs;
                if (ROUTER) *(GAS unsigned*)((unsigned char*)H + (size_t)row * 1024 + 4 * F.lane + 256 * j) = pg8::pack_fp8x4(v[j].x * 4.0f, v[j].y * 4.0f, v[j].z * 4.0f, v[j].w * 4.0f);
                else *(GAS unsigned long long*)(H + (size_t)row * 1024 + 4 * F.lane + 256 * j) = (unsigned long long)pk2(v[j].x, v[j].y) | ((unsigned long long)pk2(v[j].z, v[j].w) << 32); }
            if (ROUTER && row < MLAT) {
                const LAS float* wr = wrL; float lg[8];
#pragma unroll
                for (int e = 0; e < 8; ++e) lg[e] = 0.f;
#pragma unroll
                for (int j = 0; j < 4; ++j)
#pragma unroll
                    for (int i = 0; i < 4; ++i) { const LAS float* wp = wr + (4 * F.lane + 256 * j + i) * 8; const f32x4 w0 = *(const LAS f32x4*)wp, w1 = *(const LAS f32x4*)(wp + 4); const float hv = v[j][i];
                        lg[0] += hv * w0.x; lg[1] += hv * w0.y; lg[2] += hv * w0.z; lg[3] += hv * w0.w; lg[4] += hv * w1.x; lg[5] += hv * w1.y; lg[6] += hv * w1.z; lg[7] += hv * w1.w; }
#pragma unroll
                for (int e = 0; e < 8; ++e) lg[e] = wave_sum(lg[e]);
                int i0 = 0; float v0 = lg[0];
#pragma unroll
                for (int e = 1; e < 8; ++e) if (lg[e] > v0) { v0 = lg[e]; i0 = e; }
                int i1 = -1; float v1 = -INFINITY;
#pragma unroll
                for (int e = 0; e < 8; ++e) if (e != i0 && lg[e] > v1) { v1 = lg[e]; i1 = e; }
                if (F.lane == 0) { const float ex = expf(v1 - v0); const float w0 = 1.0f / (1.0f + ex);
                    WSP(int, WS_TOKE)[2 * row] = i0; WSP(int, WS_TOKE)[2 * row + 1] = i1; WSP(float, WS_TOKW)[2 * row] = w0; WSP(float, WS_TOKW)[2 * row + 1] = ex * w0; }
            }
        }
    }
    __syncthreads();
}

__device__ __forceinline__ void bias_rows(Frame& F, const bf16* WT, int N, const float* shift  , float* out  ) {
    const int gw = F.vcu * NWAVES + F.wave, NGW = F.G * NWAVES;
    float cs[5][16];
#pragma unroll
    for (int b = 0; b < 5; ++b)
#pragma unroll
        for (int q = 0; q < 2; ++q) { const f32x4 a0 = *(const f32x4*)(shift + b * 6144 + 8 * F.lane + 512 * q), a1 = *(const f32x4*)(shift + b * 6144 + 8 * F.lane + 512 * q + 4);
            cs[b][8 * q + 0] = a0[0]; cs[b][8 * q + 1] = a0[1]; cs[b][8 * q + 2] = a0[2]; cs[b][8 * q + 3] = a0[3]; cs[b][8 * q + 4] = a1[0]; cs[b][8 * q + 5] = a1[1]; cs[b][8 * q + 6] = a1[2]; cs[b][8 * q + 7] = a1[3]; }
    for (int n = gw; n < N; n += NGW) {
        float w[16]; { float x[8]; unpack8(*(const v4u*)(WT + (size_t)n * 1024 + 8 * F.lane), x);
#pragma unroll
            for (int j = 0; j < 8; ++j) w[j] = x[j];
            unpack8(*(const v4u*)(WT + (size_t)n * 1024 + 8 * F.lane + 512), x);
#pragma unroll
            for (int j = 0; j < 8; ++j) w[8 + j] = x[j]; }
#pragma unroll
        for (int b = 0; b < 5; ++b) { float s = 0.f;
#pragma unroll
            for (int j = 0; j < 16; ++j) s += cs[b][j] * w[j];
            s = wave_sum(s); if (F.lane == 0) out[(size_t)b * N + n] = s; }
    }
}
__device__ __forceinline__ void phase_ppost(Frame& F, int l) {
    RELAUNDER(F);
    const int gw = F.vcu * NWAVES + F.wave, NGW = F.G * NWAVES; const int lane = F.lane;
    const bf16* P = WSP(bf16, WS_P);
    LAS float* ropeL = (LAS float*)(F.lds + RING_OFF + 1024);
    __syncthreads();
    for (int i = F.tid; i < 3072; i += 512) ropeL[i] = WSP(float, WS_ROPE)[i];
    __syncthreads();
    const LAS float* gcos = ropeL; const LAS float* gsin = ropeL + 1024; const LAS float* dcos = ropeL + 2048; const LAS float* dsin = ropeL + 2560;
    const float* kn = FIN(16) + l * 64;
    bf16 *GK = WSP(bf16, WS_GK), *DK = WSP(bf16, WS_DK);
    const int j8 = lane & 7, j4 = lane & 3;
    const int colA = lane < 16 ? PC_GK + 8 * lane : PC_DK + 8 * ((lane - 16) & 31);
    const int colB = PC_DQ + 8 * (lane & 31);
    float kw[8];
#pragma unroll
    for (int i = 0; i < 8; ++i) kw[i] = kn[8 * j8 + i];
    float dq2 = 0.f, dk2 = 0.f;
    constexpr int PP_MAX = 9;
    for (int rbase = gw; rbase < MT; rbase += PP_MAX * NGW) {
    v4u rA[PP_MAX], rB[PP_MAX];
#pragma unroll
    for (int i = 0; i < PP_MAX; ++i) { const int rr = rbase + i * NGW; rA[i] = (v4u){0u, 0u, 0u, 0u}; rB[i] = rA[i];
        if (rr < MT) { const bf16* p0 = P + (size_t)rr * NP; rA[i] = *(const v4u*)(p0 + colA); rB[i] = *(const v4u*)(p0 + colB); } }
#pragma unroll
    for (int i = 0; i < PP_MAX; ++i) {
        const int row = rbase + i * NGW; if (row < MT) {
        const v4u cA = rA[i], cB = rB[i];
        const bool isctx = row >= MLAT; const int b = isctx ? (row - MLAT) >> 8 : row >> 12; const int t = isctx ? (row - MLAT) & 255 : row & 4095;
        const int pos = isctx ? SEQ + t : t; const int gr = t >> 6, gc = t & 63; const size_t krow = (size_t)b * LK + pos;
        float x[8], y2[8], y1[8];
        unpack8(cA, x);
        { float ss = 0.f;
#pragma unroll
          for (int i = 0; i < 8; ++i) ss += x[i] * x[i];
          float s4 = ss + xor1(ss); s4 += xor2(s4);
          const float s8 = s4 + __shfl_xor(s4, 4);
          if (lane >= 16 && lane < 48) dk2 = fmaxf(dk2, s4);
          if (lane < 16) { const float rstd = 1.0f / sqrtf(s8 * (1.0f / 64.0f) + EPS);
#pragma unroll
              for (int i = 0; i < 8; ++i) x[i] = x[i] * rstd * kw[i]; } }
#pragma unroll
        for (int i = 0; i < 8; ++i) { y2[i] = xor2(x[i]); y1[i] = xor1(x[i]); }
        if (lane < 16) {
            if (!isctx) { const int pv = (j8 < 4) ? gr : gc; const LAS float* cp = gcos + pv * 16 + 8 * (j8 & 1); const LAS float* sp = gsin + pv * 16 + 8 * (j8 & 1);
                const f32x4 c0 = *(const LAS f32x4*)cp, c1 = *(const LAS f32x4*)(cp + 4), s0 = *(const LAS f32x4*)sp, s1 = *(const LAS f32x4*)(sp + 4);
                const float cvv[8] = {c0[0], c0[1], c0[2], c0[3], c1[0], c1[1], c1[2], c1[3]}, svv[8] = {s0[0], s0[1], s0[2], s0[3], s1[0], s1[1], s1[2], s1[3]};
#pragma unroll
                for (int i = 0; i < 8; ++i) x[i] = (j8 & 2) ? (y2[i] * svv[i] + x[i] * cvv[i]) : (x[i] * cvv[i] - y2[i] * svv[i]); }
            *(GAS v4u*)(GK + krow * 128 + 8 * lane) = pack8(x);
        } else if (lane < 48) {
            if (!isctx) { const int pv = (j4 < 2) ? gr : gc; const LAS float* cp = dcos + pv * 8; const LAS float* sp = dsin + pv * 8;
                const f32x4 c0 = *(const LAS f32x4*)cp, c1 = *(const LAS f32x4*)(cp + 4), s0 = *(const LAS f32x4*)sp, s1 = *(const LAS f32x4*)(sp + 4);
                const float cvv[8] = {c0[0], c0[1], c0[2], c0[3], c1[0], c1[1], c1[2], c1[3]}, svv[8] = {s0[0], s0[1], s0[2], s0[3], s1[0], s1[1], s1[2], s1[3]};
#pragma unroll
                for (int i = 0; i < 8; ++i) x[i] = (j4 & 1) ? (y1[i] * svv[i] + x[i] * cvv[i]) : (x[i] * cvv[i] - y1[i] * svv[i]); }
            *(GAS v4u*)(DK + krow * 256 + 8 * (lane - 16)) = pack8(x);
        }
        unpack8(cB, x);
        { float ss = 0.f;
#pragma unroll
          for (int i = 0; i < 8; ++i) ss += x[i] * x[i];
          ss += xor1(ss); ss += xor2(ss); dq2 = fmaxf(dq2, ss); }
        }
    }
    }
    dq2 *= (0.17677669529663687f * LOG2E) * (0.17677669529663687f * LOG2E);
#pragma unroll
    for (int o = 1; o < 64; o <<= 1) { dq2 = fmaxf(dq2, __shfl_xor(dq2, o)); dk2 = fmaxf(dk2, __shfl_xor(dk2, o)); }
    LAS float* red = (LAS float*)(F.lds + RING_OFF);
    __syncthreads();
    if (lane == 0) { red[2 * F.wave] = dq2; red[2 * F.wave + 1] = dk2; }
    __syncthreads();
    if (F.tid == 0) { float a = 0.f, b2 = 0.f;
        for (int w = 0; w < NWAVES; ++w) { a = fmaxf(a, red[2 * w]); b2 = fmaxf(b2, red[2 * w + 1]); }
        WSP(float, WS_QKMAX)[2 * blockIdx.x] = a; WSP(float, WS_QKMAX)[2 * blockIdx.x + 1] = b2; }
    __syncthreads();
}

__device__ __forceinline__ void phase_route(Frame& F) {
    RELAUNDER(F);
    const int* toke = WSP(int, WS_TOKE); const float* tokw = WSP(float, WS_TOKW);
    int* rowl = WSP(int, WS_ROWL); float* roww = WSP(float, WS_ROWW); int* pos = WSP(int, WS_POS); int* pane = WSP(int, WS_PANE);
    LAS int* cnt = (LAS int*)(F.lds + RING_OFF);
    LAS int* le = (LAS int*)(F.lds + RING_OFF + 256);
    const int Gq = opaque_s(F.G); const int per = (MLAT + Gq - 1) / Gq; const int bs = (int)blockIdx.x * per; const int be = bs + per < MLAT ? bs + per : MLAT;
    if (F.tid < 32) cnt[F.tid] = 0;
    __syncthreads();
    int tot[8], bef[8];
#pragma unroll
    for (int e = 0; e < 8; ++e) { tot[e] = 0; bef[e] = 0; }
    { typedef int i32x2 __attribute__((ext_vector_type(2))); i32x2 te[MLAT / 512];
#pragma unroll
      for (int q = 0; q < MLAT / 512; ++q) te[q] = *(const i32x2*)(toke + 2 * (F.tid + 512 * q));
#pragma unroll
      for (int q = 0; q < MLAT / 512; ++q) { const int t = F.tid + 512 * q; const int e0 = te[q].x, e1 = te[q].y; const int isb = t < bs ? 1 : 0;
#pragma unroll
        for (int e = 0; e < 8; ++e) { const int hit = (e0 == e) + (e1 == e); tot[e] += hit; bef[e] += hit * isb; } } }
#pragma unroll
    for (int e = 0; e < 8; ++e) {
#pragma unroll
        for (int o = 1; o < 64; o <<= 1) { tot[e] += __shfl_xor(tot[e], o); bef[e] += __shfl_xor(bef[e], o); }
        if (F.lane == 0) { __hip_atomic_fetch_add(&cnt[e], tot[e], __ATOMIC_RELAXED, __HIP_MEMORY_SCOPE_WORKGROUP); __hip_atomic_fetch_add(&cnt[8 + e], bef[e], __ATOMIC_RELAXED, __HIP_MEMORY_SCOPE_WORKGROUP); } }
    for (int t = bs + F.tid; t < be; t += 512) { le[2 * (t - bs)] = toke[2 * t]; le[2 * (t - bs) + 1] = toke[2 * t + 1]; }
    __syncthreads();
    if (F.tid == 0) { int b = 0; for (int e = 0; e < 8; ++e) { cnt[16 + e] = b; b += (cnt[e] + 255) & ~255; } cnt[24] = b; }
    __syncthreads();
    for (int t = bs + F.tid; t < be; t += 512) {
        const int j = t - bs; const int e0 = le[2 * j], e1 = le[2 * j + 1]; int p0 = 0, p1 = 0;
        for (int q = 0; q < j; ++q) { const int a = le[2 * q], b2 = le[2 * q + 1]; p0 += (a == e0) + (b2 == e0); p1 += (a == e1) + (b2 == e1); }
        const int r0 = cnt[16 + e0] + cnt[8 + e0] + p0, r1 = cnt[16 + e1] + cnt[8 + e1] + p1;
        rowl[r0] = t; roww[r0] = tokw[2 * t]; rowl[r1] = t; roww[r1] = tokw[2 * t + 1]; pos[2 * t] = r0; pos[2 * t + 1] = r1;
    }
    if (blockIdx.x == 0) {
        const int np = cnt[24] >> 8;
        for (int p = F.tid; p < 255; p += 512) { int e = 0;
#pragma unroll
            for (int q = 1; q < 8; ++q) if (p * 256 >= cnt[16 + q]) e = q;
            pane[p] = p < np ? e : 0; }
        if (F.tid == 0) pane[255] = np;
        for (int e = 0; e < 8; ++e) { const int lo = cnt[16 + e] + cnt[e], hi = cnt[16 + e + 1]; for (int r = lo + F.tid; r < hi; r += 512) { rowl[r] = 0; roww[r] = 0.f; } }
    }
    __syncthreads();
}

__device__ __forceinline__ void phase_final(Frame& F) {
    RELAUNDER(F);
    const int gw = F.vcu * NWAVES + F.wave, NGW = F.G * NWAVES;
    const bf16* Y2 = WSP(bf16, WS_Y2); const int* pos = WSP(int, WS_POS); const float* mod = WSP(float, WS_MOD) + (size_t)1 * 5 * 6144;
    f32x4 nf[4];
#pragma unroll
    for (int j = 0; j < 4; ++j) nf[j] = *(const f32x4*)(FIN(29) + 4 * F.lane + 256 * j);
    typedef unsigned long long u64;
    int pr0 = 0, pr1 = 0;
    f32x4 nx[4]; u64 na[4], nb[4];
#pragma unroll
    for (int j = 0; j < 4; ++j) { nx[j] = (f32x4){0.f, 0.f, 0.f, 0.f}; na[j] = 0; nb[j] = 0; }
    if (gw < MLAT) { const int r0 = pos[2 * gw], r1 = pos[2 * gw + 1];
#pragma unroll
        for (int j = 0; j < 4; ++j) { const int col = 4 * F.lane + 256 * j; nx[j] = *(const f32x4*)(F.out + (size_t)gw * 1024 + col);
            na[j] = *(const GAS u64*)(Y2 + (size_t)r0 * 1024 + col); nb[j] = *(const GAS u64*)(Y2 + (size_t)r1 * 1024 + col); } }
    if (gw + NGW < MLAT) { pr0 = pos[2 * (gw + NGW)]; pr1 = pos[2 * (gw + NGW) + 1]; }
    for (int row = gw; row < MLAT; row += NGW) {
        const int b = row >> 12; const float* gf = mod + b * 6144 + 5 * 1024;
        f32x4 cx[4]; u64 ca[4], cb[4];
#pragma unroll
        for (int j = 0; j < 4; ++j) { cx[j] = nx[j]; ca[j] = na[j]; cb[j] = nb[j]; }
        const int nrow = row + NGW;
        if (nrow < MLAT) { const int r0 = pr0, r1 = pr1;
#pragma unroll
            for (int j = 0; j < 4; ++j) { const int col = 4 * F.lane + 256 * j; nx[j] = *(const f32x4*)(F.out + (size_t)nrow * 1024 + col);
                na[j] = *(const GAS u64*)(Y2 + (size_t)r0 * 1024 + col); nb[j] = *(const GAS u64*)(Y2 + (size_t)r1 * 1024 + col); }
            if (nrow + NGW < MLAT) { pr0 = pos[2 * (nrow + NGW)]; pr1 = pos[2 * (nrow + NGW) + 1]; } }
        float* xr = F.out + (size_t)row * 1024; f32x4 v[4]; float ss = 0.f;
#pragma unroll
        for (int j = 0; j < 4; ++j) { const int col = 4 * F.lane + 256 * j; const f32x4 g = *(const f32x4*)(gf + col); const u64 a = ca[j], c2 = cb[j];
            f32x4 ya, yb; ya.x = bflo((unsigned)a); ya.y = bfhi((unsigned)a); ya.z = bflo((unsigned)(a >> 32)); ya.w = bfhi((unsigned)(a >> 32));
            yb.x = bflo((unsigned)c2); yb.y = bfhi((unsigned)c2); yb.z = bflo((unsigned)(c2 >> 32)); yb.w = bfhi((unsigned)(c2 >> 32));
            v[j] = cx[j] + g * (ya + yb);
            ss += (v[j].x * v[j].x + v[j].y * v[j].y) + (v[j].z * v[j].z + v[j].w * v[j].w); }
        const float rstd = 1.0f / sqrtf(wave_sum(ss) * (1.0f / 1024.0f) + EPS);
#pragma unroll
        for (int j = 0; j < 4; ++j) *(f32x4*)(xr + 4 * F.lane + 256 * j) = v[j] * rstd * nf[j];
    }
}

struct Args { const float* in[30]; float* out; unsigned char* ws; int ph_lo, ph_hi; };
constexpr int PH_PRO = 0, PH_L0 = 9, PH_NORM1 = 1, PH_INPROJ = 2, PH_PPOST = 3, PH_G2 = 4, PH_ATTN = 5, PH_OUTPROJ = 6, PH_NORM2 = 7, PH_F1 = 8, PH_F2 = 9, PH_F3 = 10, PH_F4 = 11;
constexpr int N_PHASES = 1 + 9 + 11;
constexpr bool ALIGN_EPI = true, SP2 = true;
#ifndef FUSE_NORM
#define FUSE_NORM 0
#endif
constexpr bool FUSEN = FUSE_NORM != 0;
#ifndef NBAR
#define NBAR 1
#endif

__global__ void __launch_bounds__(NWAVES * 64, 2) mk_fwd(Args args) {
    extern __shared__ __attribute__((aligned(16))) unsigned char lds[];
    Frame F;
    F.lds = (LAS unsigned char*)lds; F.MISC = (volatile LAS unsigned*)(F.lds + MISC_OFF);
    F.tid = 0; F.lane = 0; F.wave = 0;
    F.G = gridDim.x; { const int bx = blockIdx.x; F.vcu = (F.G % 8 == 0) ? (bx % 8) * (F.G / 8) + bx / 8 : bx; }
    F.ws = args.ws; F.out = args.out; F.ctl = (gu32*)(args.ws + WS_CTL);
    F.in = args.in;
    for (int u = ltid(); u < (LDS_BYTES - LDSCTL_OFF) / 4; u += NWAVES * 64) ((LAS unsigned*)(F.lds + LDSCTL_OFF))[u] = 0u;
    __syncthreads();
#if MK_ONE_LAUNCH
    XcdBarrier bar = xcd_barrier_post((unsigned*)(F.ctl + CW_BAR), F.MISC + 8);
#define GRID_BAR() xcd_barrier(bar)
#else
#define GRID_BAR() do { } while (0)
#endif
    const int lo = args.ph_lo, hi = args.ph_hi;
#ifndef PHMASK
#define PHMASK 0xFFFFFFFFu
#endif
#define PM(b) ((PHMASK >> (b)) & 1u)
#ifndef REPMASK
#define REPMASK 0u
#endif
#define REPS(b) (((REPMASK >> (b)) & 1u) ? 2 : 1)
#define IN(k) (lo <= (k) && (k) < hi)
#define SEAM(k) do { if (IN((k) + 1)) { _Pragma("nounroll") for (int r_ = 0; r_ < NBAR; ++r_) GRID_BAR(); } } while (0)

    if (PM(0) && IN(PH_PRO)) { for (int rep = 0; rep < REPS(0); ++rep) { p0_prologue(F); __syncthreads(); } SEAM(PH_PRO); }

    for (int l = 0; l < 2; ++l) {
        const int pb = l * PH_L0;
        const float* xlat = l == 0 ? FIN(0) : F.out; const float* xctx = l == 0 ? FIN(2) : WSP(float, WS_XCTX);
        const float* mod = WSP(float, WS_MOD) + (size_t)l * 5 * 6144;
        if ((l == 0 || !FUSEN) && PM(1) && IN(pb + PH_NORM1)) { for (int rep = 0; rep < REPS(1); ++rep) phase_norm<false>(F, l, 0, xlat, xctx);
            if (FUSEN && l == 0) { bias_rows(F, WSP(bf16, WS_WGU), 2 * DFF, WSP(float, WS_MOD) + 3 * 1024, WSP(float, WS_BIASGU));
            bias_rows(F, WSP(bf16, WS_WIN) + (size_t)NP * D, NP, WSP(float, WS_MOD) + (size_t)5 * 6144 + 0 * 1024, WSP(float, WS_BIASIN)); }
            SEAM(pb + PH_NORM1); }
        if (PM(2) && IN(pb + PH_INPROJ)) { for (int rep = 0; rep < REPS(2); ++rep) {
            pg8::Gemm g{WSP(bf16, WS_H), WSP(bf16, WS_WIN) + (size_t)l * NP * D, MT, NP, D}; pg8::StaticOrder S; S.init(MT, NP, F.G, opaque_s((int)blockIdx.x));
            if (l == 0 || !FUSEN) { pg8::EpiStoreBf16 E{WSP(bf16, WS_P), NP};
                pg8::gemm_phase<pg8::EpiStoreBf16, pg8::StaticOrder, ALIGN_EPI, SP2>(F.lds + RING_OFF, g, S, E); }
            else { pg8::EpiStoreBf16N E{WSP(bf16, WS_P), NP, (const float*)(F.ws + WS_SS1), WSP(float, WS_BIASIN)};
                pg8::gemm_phase<pg8::EpiStoreBf16N, pg8::StaticOrder, ALIGN_EPI, SP2>(F.lds + RING_OFF, g, S, E); }
            if (l == 0) { const int ii = idle_index((MT / 256) * (NP / 256), F.G, opaque_s((int)blockIdx.x)); if (ii >= 0 && ii < AUX_WG) aux_slot(F, ii); } }
            SEAM(pb + PH_INPROJ);
        }
        if (PM(3) && IN(pb + PH_PPOST)) { for (int rep = 0; rep < REPS(3); ++rep) {
            if (l == 0) { const int ic = idle_count((MT / 256) * (NP / 256), F.G); for (int w = (ic < AUX_WG ? ic : AUX_WG) + (int)blockIdx.x; w < AUX_WG; w += F.G) aux_slot(F, w); }
            for (int rg = 0; rg < REPS(16); ++rg) { gla::g1_phase(F.lds + RING_OFF, WSP(bf16, WS_P), FIN(11) + l * 128, FIN(13) + l * 128, WSP(float, WS_KV), WSP(float, WS_DEC), F.G); __syncthreads(); }
            __syncthreads();
            phase_ppost(F, l); __syncthreads(); }
            SEAM(pb + PH_PPOST);
        }
        if (PM(4) && IN(pb + PH_G2)) {
            gla::g2_scan(WSP(float, WS_KV), WSP(float, WS_DEC), opaque_s((int)blockIdx.x) * 512 + ltid(), F.G * 512);
            float wq = 0.f, wk = 0.f; for (int i = 0; i < 64; ++i) { wq = fmaxf(wq, fabsf(FIN(15)[l * 64 + i])); wk = fmaxf(wk, fabsf(FIN(16)[l * 64 + i])); }
            const bool fast_g = 64.0f * wq * wk * 0.125f * LOG2E < 60.0f;
            bf16* MIX = WSP(bf16, WS_MIX); const bf16 *P = WSP(bf16, WS_P), *GK = WSP(bf16, WS_GK); const float* rope = WSP(float, WS_ROPE);
            const att::QCtx QC{P, rope, rope + 1024, rope + 2048, rope + 2560, FIN(15) + l * 64};
            const int wv_ = __builtin_amdgcn_readfirstlane(ltid() >> 6);
            const int n_gqa = NB * 4 * 16;
            for (int rep = 0; rep < REPS(4); ++rep)
            for (int u = blockIdx.x; u < n_gqa; u += F.G) {
                const int qb = u & 15, hp = (u >> 4) & 3, b = u >> 6; const int hq = 2 * hp; const size_t r0 = (size_t)b * SEQ + qb * 256;
                const att::Conv CV{FIN(26), FIN(27), FIN(28), WSP(unsigned char, WS_MGU), WSP(unsigned char, WS_MDN), CONV_IN_ATTN ? l * 43008 + (u * 8 + wv_) * 11 : 0, CONV_IN_ATTN ? 11 : 0};
                att::gqa_unit2(F.lds + RING_OFF, QC, r0, qb * 256, hq, GK + (size_t)b * LK * 128 + (hq >> 2) * 64, P + (size_t)b * SEQ * NP + PC_GV + (hq >> 2) * 64, P + (size_t)(MLAT + b * CTXL) * NP + PC_GV + (hq >> 2) * 64, SEQ / 64, LK / 64,
                               MIX + r0 * 1024 + 256 + hq * 64, MIX + r0 * 1024 + 256 + (hq + 1) * 64, fast_g, CV);
            }
            SEAM(pb + PH_G2);
        }
        if (PM(5) && IN(pb + PH_ATTN)) { {
            const float linit = 0.8f - 0.6f * expf(-0.3f * (float)l);
            float s1 = 0.f, s2 = 0.f;
            for (int i = 0; i < 32; ++i) { s1 += FIN(17)[l * 32 + i] * FIN(18)[l * 32 + i]; s2 += FIN(19)[l * 32 + i] * FIN(20)[l * 32 + i]; }
            const float lam = expf(s1) - expf(s2) + linit;
            float q2 = 0.f, k2 = 0.f;
            { LAS float* red = (LAS float*)(F.lds + RING_OFF); __syncthreads();
              const int t_ = ltid(); const int wv_ = __builtin_amdgcn_readfirstlane(t_ >> 6);
              float a = 0.f, b2 = 0.f; for (int i = t_; i < F.G; i += 512) { a = fmaxf(a, WSP(float, WS_QKMAX)[2 * i]); b2 = fmaxf(b2, WSP(float, WS_QKMAX)[2 * i + 1]); }
#pragma unroll
              for (int o = 1; o < 64; o <<= 1) { a = fmaxf(a, __shfl_xor(a, o)); b2 = fmaxf(b2, __shfl_xor(b2, o)); }
              if ((t_ & 63) == 0) { red[2 * wv_] = a; red[2 * wv_ + 1] = b2; }
              __syncthreads();
              for (int w = 0; w < NWAVES; ++w) { q2 = fmaxf(q2, red[2 * w]); k2 = fmaxf(k2, red[2 * w + 1]); }
              __syncthreads(); }
            const bool fast_d = sqrtf(q2 * k2) < 60.0f;
            bf16* MIX = WSP(bf16, WS_MIX); const bf16 *P = WSP(bf16, WS_P), *DK = WSP(bf16, WS_DK); const float* rope = WSP(float, WS_ROPE);
            const att::QCtx QC{P, rope, rope + 1024, rope + 2048, rope + 2560, FIN(15) + l * 64};
            const int n_diff = NB * 4 * 16; const int wv_ = __builtin_amdgcn_readfirstlane(ltid() >> 6);
            for (int rep = 0; rep < REPS(5); ++rep)
            for (int u = blockIdx.x; u < n_diff; u += F.G) {
                const int qb = u & 15, h = (u >> 4) & 3, b = u >> 6; const size_t r0 = (size_t)b * SEQ + qb * 256;
                const att::Conv CV{FIN(26), FIN(27), FIN(28), WSP(unsigned char, WS_MGU), WSP(unsigned char, WS_MDN), CONV_IN_ATTN ? l * 43008 + 22528 + (u * 8 + wv_) * 10 : 0, CONV_IN_ATTN ? 10 : 0};
                att::diff_unit2(F.lds + RING_OFF, QC, r0, qb * 256, h, DK + (size_t)b * LK * 256 + h * 64, P + (size_t)b * SEQ * NP + PC_DV + h * 64, P + (size_t)(MLAT + b * CTXL) * NP + PC_DV + h * 64, SEQ / 64, LK / 64,
                                lam, FIN(21) + l * 64, 1.0f - linit, MIX + r0 * 1024 + 768 + h * 64, fast_d, CV);
            }
            if (l == 0) {
                float wq = 0.f, wk = 0.f; for (int i = 0; i < 64; ++i) { wq = fmaxf(wq, fabsf(FIN(15)[l * 64 + i])); wk = fmaxf(wk, fabsf(FIN(16)[l * 64 + i])); }
                const bool fast_g = 64.0f * wq * wk * 0.125f * LOG2E < 60.0f;
                const bf16* GK = WSP(bf16, WS_GK); const att::Conv CV0{FIN(26), FIN(27), FIN(28), WSP(unsigned char, WS_MGU), WSP(unsigned char, WS_MDN), 0, 0};
                for (int v = (int)blockIdx.x - (F.G - 32); v >= 0 && v < 32; v += F.G) {
                    const int b = (v >> 2) & 3, hh = v & 3; const size_t r0 = (size_t)MLAT + b * CTXL; const size_t k0 = (size_t)b * LK + SEQ;
                    if (v < 16) att::diff_unit2(F.lds + RING_OFF, QC, r0, -1, hh, DK + k0 * 256 + hh * 64, P, P + r0 * NP + PC_DV + hh * 64, 0, CTXL / 64, lam, FIN(21) + l * 64, 1.0f - linit, MIX + r0 * 1024 + 768 + hh * 64, fast_d, CV0);
                    else { const int hq = 2 * hh; att::gqa_unit2(F.lds + RING_OFF, QC, r0, -1, hq, GK + k0 * 128 + (hq >> 2) * 64, P, P + r0 * NP + PC_GV + (hq >> 2) * 64, 0, CTXL / 64, MIX + r0 * 1024 + 256 + hq * 64, MIX + r0 * 1024 + 256 + (hq + 1) * 64, fast_g, CV0); }
                }
            }
            __syncthreads();
            for (int rep3 = 0; rep3 < REPS(15); ++rep3)
            gla::g3_phase(F.lds + RING_OFF, WSP(bf16, WS_P), l == 0 ? NCH : NCH - 4, FIN(11) + l * 128, FIN(13) + l * 128, WSP(float, WS_KV), FIN(14) + l * 64, MIX, F.G);
            __syncthreads(); }
            SEAM(pb + PH_ATTN);
        }
        if (PM(6) && IN(pb + PH_OUTPROJ)) {
            const int M = l == 0 ? MT : MLAT;
            const int U = (M / 256) * (D / 256); const int Gq = opaque_s(F.G); int R = U / Gq; const int Lc = U - R * Gq; const bool split = Lc > 0 && Lc * 16 <= 2 * Gq; if (!split) R = (U + Gq - 1) / Gq;
            pg8::Gemm g{WSP(bf16, WS_MIX), WSP(bf16, WS_WOUT) + (size_t)l * D * D, M, D, D}; pg8::RoundsOrder S; S.init(M, D, F.G, opaque_s((int)blockIdx.x), R);
            if (l == 0 && FUSEN) {
                pg8::EpiResidNorm E{xlat, xctx, F.out, WSP(float, WS_XCTX), mod + 2 * 1024, WSP(bf16, WS_H), (float*)(F.ws + WS_SS2), FIN(7) + l * 1024, mod + 4 * 1024};
                pg8::gemm_phase<pg8::EpiResidNorm, pg8::RoundsOrder, ALIGN_EPI, SP2>(F.lds + RING_OFF, g, S, E);
                if (split) { tail::EpiResidNorm TE{xlat, xctx, F.out, WSP(float, WS_XCTX), mod + 2 * 1024, WSP(bf16, WS_H), (float*)(F.ws + WS_SS2), FIN(7) + l * 1024, mod + 4 * 1024};
                    for (int q = F.vcu; q < Lc * 16; q += F.G) { pg8::StaticOrder s2; s2.init(M, D, F.G, q >> 4); pg8::Unit u; s2.next(R, u); const int sub = q & 15;
                        tail::subtile<D>(F.lds + RING_OFF, g.A, g.Bt, u.pm * 256 + 64 * (sub >> 2), u.pn * 256 + 64 * (sub & 3), u.pn * 256 + 64 * (sub & 3), TE); } }
            } else {
            pg8::EpiResid E{xlat, xctx, F.out, WSP(float, WS_XCTX), mod + 2 * 1024};
            pg8::gemm_phase<pg8::EpiResid, pg8::RoundsOrder, ALIGN_EPI, SP2>(F.lds + RING_OFF, g, S, E);
            if (split) { tail::EpiResid TE{xlat, xctx, F.out, WSP(float, WS_XCTX), mod + 2 * 1024};
                for (int q = F.vcu; q < Lc * 16; q += F.G) { pg8::StaticOrder s2; s2.init(M, D, F.G, q >> 4); pg8::Unit u; s2.next(R, u); const int sub = q & 15;
                    tail::subtile<D>(F.lds + RING_OFF, g.A, g.Bt, u.pm * 256 + 64 * (sub >> 2), u.pn * 256 + 64 * (sub & 3), u.pn * 256 + 64 * (sub & 3), TE); } }
            }
            SEAM(pb + PH_OUTPROJ);
        }
        if (l == 0) {
            if (!FUSEN && PM(7) && IN(pb + PH_NORM2)) { phase_norm<false>(F, l, 1, F.out, WSP(float, WS_XCTX)); SEAM(pb + PH_NORM2); }
            if (PM(8) && IN(pb + PH_F1)) { for (int rep = 0; rep < REPS(8); ++rep) {
                pg8::Gemm g{WSP(bf16, WS_H), WSP(bf16, WS_WGU), MT, 2 * DFF, D}; pg8::StaticOrder S; S.init(MT, 2 * DFF, F.G, opaque_s((int)blockIdx.x));
                if (FUSEN) { pg8::EpiSwiGLUN E{WSP(bf16, WS_ACT), DFF, (const float*)(F.ws + WS_SS2), WSP(float, WS_BIASGU)};
                pg8::gemm_phase<pg8::EpiSwiGLUN, pg8::StaticOrder, ALIGN_EPI, SP2>(F.lds + RING_OFF, g, S, E); }
                else { pg8::EpiSwiGLU E{WSP(bf16, WS_ACT), DFF, 0};
                pg8::gemm_phase<pg8::EpiSwiGLU, pg8::StaticOrder, ALIGN_EPI, SP2>(F.lds + RING_OFF, g, S, E); }
                { const int ii = idle_index((MT / 256) * (2 * DFF / 256), F.G, opaque_s((int)blockIdx.x)); if (ii >= 0 && ii < SLOT_B_WG) moe_slot(F, SLOT_B0, ii, SLOT_B_Q); } }
                SEAM(pb + PH_F1);
            }
            if (PM(9) && IN(pb + PH_F2)) {
                const int U = (MT / 256) * (D / 256); const int Gq = opaque_s(F.G); int R = U / Gq; const int Lc = U - R * Gq; const bool split = Lc > 0 && Lc * 16 <= 2 * Gq; if (!split) R = (U + Gq - 1) / Gq;
                pg8::Gemm g{WSP(bf16, WS_ACT), WSP(bf16, WS_WDN), MT, D, DFF}; pg8::RoundsOrder S; S.init(MT, D, F.G, opaque_s((int)blockIdx.x), R);
                if (FUSEN) {
                const float* mod1 = WSP(float, WS_MOD) + (size_t)5 * 6144;
                pg8::EpiResidNorm E{F.out, WSP(float, WS_XCTX), F.out, WSP(float, WS_XCTX), mod + 5 * 1024, WSP(bf16, WS_H), (float*)(F.ws + WS_SS1), FIN(6) + 1024, mod1 + 1 * 1024};
                pg8::gemm_phase<pg8::EpiResidNorm, pg8::RoundsOrder, ALIGN_EPI, SP2>(F.lds + RING_OFF, g, S, E);
                if (split) { tail::EpiResidNorm TE{F.out, WSP(float, WS_XCTX), F.out, WSP(float, WS_XCTX), mod + 5 * 1024, WSP(bf16, WS_H), (float*)(F.ws + WS_SS1), FIN(6) + 1024, mod1 + 1 * 1024};
                    for (int q = F.vcu; q < Lc * 16; q += F.G) { pg8::StaticOrder s2; s2.init(MT, D, F.G, q >> 4); pg8::Unit u; s2.next(R, u); const int sub = q & 15;
                        tail::subtile<DFF>(F.lds + RING_OFF, g.A, g.Bt, u.pm * 256 + 64 * (sub >> 2), u.pn * 256 + 64 * (sub & 3), u.pn * 256 + 64 * (sub & 3), TE); } }
                } else {
                pg8::EpiResid E{F.out, WSP(float, WS_XCTX), F.out, WSP(float, WS_XCTX), mod + 5 * 1024};
                pg8::gemm_phase<pg8::EpiResid, pg8::RoundsOrder, ALIGN_EPI, SP2>(F.lds + RING_OFF, g, S, E);
                if (split) { tail::EpiResid TE{F.out, WSP(float, WS_XCTX), F.out, WSP(float, WS_XCTX), mod + 5 * 1024};
                    for (int q = F.vcu; q < Lc * 16; q += F.G) { pg8::StaticOrder s2; s2.init(MT, D, F.G, q >> 4); pg8::Unit u; s2.next(R, u); const int sub = q & 15;
                        tail::subtile<DFF>(F.lds + RING_OFF, g.A, g.Bt, u.pm * 256 + 64 * (sub >> 2), u.pn * 256 + 64 * (sub & 3), u.pn * 256 + 64 * (sub & 3), TE); } }
                }
                SEAM(pb + PH_F2);
            }
        } else {
            if (PM(10) && IN(pb + PH_NORM2)) { phase_norm<true>(F, l, 1, F.out, WSP(float, WS_XCTX)); SEAM(pb + PH_NORM2); }
            if (PM(11) && IN(pb + PH_F1)) { phase_route(F);
                slot_leftover(F, SLOT_A0, SLOT_A_WG, (MT / 256) * (NP / 256), SLOT_A_Q); slot_leftover(F, SLOT_B0, SLOT_B_WG, (MT / 256) * (2 * DFF / 256), SLOT_B_Q); slot_leftover(F, SLOT_C0, SLOT_C_WG, (MT / 256) * (NP / 256), SLOT_C_Q);
                SEAM(pb + PH_F1); }
            if (PM(12) && IN(pb + PH_F2)) { for (int rep = 0; rep < REPS(12); ++rep) {
                const int* pane = WSP(int, WS_PANE); const int np = pane[255];
                pg8::Gemm g{WSP(bf16, WS_H), WSP(bf16, WS_MGU), np * 256, 2 * DFFE, D / 2}; pg8::MoeOrder S; S.init(np, 2 * DFFE / 256, F.G, opaque_s((int)blockIdx.x), pane);
                pg8::EpiSwiGLU8 E{WSP(unsigned char, WS_ACT2), DFFE, 2 * DFFE / 256, 2.0f};
                pg8::gemm_phase_gather<pg8::EpiSwiGLU8, pg8::MoeOrder>(F.lds + RING_OFF, g, S, E, WSP(int, WS_ROWL), 0x7D7D7D7D  , 0x78787878  ); }
                SEAM(pb + PH_F2);
            }
            if (PM(13) && IN(pb + PH_F3)) { for (int rep = 0; rep < REPS(13); ++rep) {
                const int* pane = WSP(int, WS_PANE); const int np = pane[255];
                const int U = np * (D / 256); const int Gq = opaque_s(F.G); int R = U / Gq; const int Lc = U - R * Gq; const bool split = Lc > 0 && Lc * 16 <= 2 * Gq; if (!split) R = (U + Gq - 1) / Gq;
                pg8::Gemm g{WSP(bf16, WS_ACT2), WSP(bf16, WS_MDN), np * 256, D, DFFE / 2}; pg8::MoeOrder S; S.init(np, D / 256, F.G, opaque_s((int)blockIdx.x), pane, R);
                pg8::EpiMoeDown E{WSP(bf16, WS_Y2), WSP(float, WS_ROWW), D / 256};
                pg8::gemm_phase_f8<pg8::EpiMoeDown, pg8::MoeOrder, ALIGN_EPI, SP2>(F.lds + RING_OFF, g, S, E, 0x7E7E7E7E  , 0x78787878  );
                if (split) { tail::EpiMoeDown TE{WSP(bf16, WS_Y2), WSP(float, WS_ROWW)};
                    for (int q = F.vcu; q < Lc * 16; q += F.G) { pg8::StaticOrder s2; s2.init(np * 256, D, F.G, q >> 4); pg8::Unit u; s2.next(R, u); const int sub = q & 15;
                        tail::subtile_f8<DFFE>(F.lds + RING_OFF, WSP(unsigned char, WS_ACT2), WSP(unsigned char, WS_MDN), u.pm * 256 + 64 * (sub >> 2), (pane[u.pm] * (D / 256) + u.pn) * 256 + 64 * (sub & 3), u.pn * 256 + 64 * (sub & 3), TE, 0x7E7E7E7E, 0x78787878); } }
                __syncthreads(); }
                SEAM(pb + PH_F3);
            }
            if (PM(14) && IN(pb + PH_F4)) { phase_final(F); }
        }
    }
#undef IN
#undef SEAM
}

extern "C" void kernel_launch(void* const* d_in, const int* in_sizes, int n_in, void* d_out, int out_size, void* d_ws, size_t ws_size, hipStream_t stream) {
    static int grid = 0;
    if (grid == 0) {
        if (n_in != 30 || out_size != MLAT * D || ws_size < WS_END) { fprintf(stderr, "kernel_launch: expected 30 inputs, %d outputs, >= %zu bytes of workspace; got %d, %d, %zu; nothing launched\n", MLAT * D, (size_t)WS_END, n_in, out_size, ws_size); grid = -1; return; }
        int dev = 0, cus = 0, per_cu = 0;
        if (hipGetDevice(&dev) != hipSuccess || hipDeviceGetAttribute(&cus, hipDeviceAttributeMultiprocessorCount, dev) != hipSuccess) { fprintf(stderr, "kernel_launch: device query failed\n"); grid = -1; return; }
        if (hipFuncSetAttribute((const void*)mk_fwd, hipFuncAttributeMaxDynamicSharedMemorySize, LDS_BYTES) != hipSuccess) { fprintf(stderr, "kernel_launch: hipFuncSetAttribute failed\n"); grid = -1; return; }
        if (hipOccupancyMaxActiveBlocksPerMultiprocessor(&per_cu, (const void*)mk_fwd, NWAVES * 64, LDS_BYTES) != hipSuccess || per_cu < 1)
            fprintf(stderr, "kernel_launch: note: occupancy query reports %d workgroups per CU\n", per_cu);
        (void)hipGetLastError();
        grid = cus;
    }
    if (grid < 0) return;
    if (hipMemsetAsync((char*)d_ws + WS_CTL, 0, CTL_ZERO_BYTES, stream) != hipSuccess) { fprintf(stderr, "kernel_launch: hipMemsetAsync failed\n"); return; }
    Args a{};
    for (int i = 0; i < 30; ++i) a.in[i] = (const float*)d_in[i];
    a.out = (float*)d_out; a.ws = (unsigned char*)d_ws;
#if MK_ONE_LAUNCH
    a.ph_lo = 0; a.ph_hi = N_PHASES;
    hipLaunchKernelGGL(mk_fwd, dim3(grid), dim3(NWAVES * 64), LDS_BYTES, stream, a);
#else
    for (int ph = 0; ph < N_PHASES; ++ph) { a.ph_lo = ph; a.ph_hi = ph + 1; hipLaunchKernelGGL(mk_fwd, dim3(grid), dim3(NWAVES * 64), LDS_BYTES, stream, a); }
#endif
    const hipError_t le = hipPeekAtLastError();
    if (le != hipSuccess) fprintf(stderr, "kernel_launch: launch failed: %s\n", hipGetErrorName(le));
}
```

```cpp
#include <hip/hip_runtime.h>
#include <cstdio>
#include <cstdint>
#include <cmath>

#define REPMASK_SET 0x0u
#ifndef REPMASK
#define REPMASK REPMASK_SET
#endif
#ifndef MK_ONE_LAUNCH
#define MK_ONE_LAUNCH 1
#endif

constexpr int D = 1024, NB = 4, SEQ = 4096, CTXL = 256;
constexpr int MLAT = NB * SEQ, MCTX = NB * CTXL, MT = MLAT + MCTX;
constexpr int LK = SEQ + CTXL;
constexpr int NP = 2560;
constexpr int INW = 2336;
constexpr int DFF = 2816, NE = 8, DFFE = 3584;
constexpr int MOE_ROWS = 34816;
constexpr int NCH = 68;
constexpr float EPS = 1e-6f;
constexpr float LOG2E = 1.4426950408889634f;
constexpr int PC_GLQ = 0, PC_GLK = 128, PC_GLV = 256, PC_GLR = 512, PC_ZF = 768, PC_ZB = 896, PC_GQ = 1024, PC_GK = 1536, PC_GV = 1664, PC_DQ = 1792, PC_DK = 2048, PC_DV = 2304;

__device__ __forceinline__ int ltid() { int t = threadIdx.x; asm volatile("" : "+v"(t)); return t; }

__device__ __forceinline__ int opaque_s(int x) { asm volatile("" : "+s"(x)); return x; }

namespace pg8 {
#define PG8_LAS __attribute__((address_space(3)))
typedef unsigned short bf16_t;
typedef short bf16x8 __attribute__((ext_vector_type(8)));
typedef float f32x4 __attribute__((ext_vector_type(4)));
typedef unsigned u32x4 __attribute__((ext_vector_type(4)));
constexpr int BM = 256, BK = 64, HALF = 128, HTB = HALF * BK * 2  , STAGE_BYTES = 8 * HTB, NXCD = 8, WGM = 8;

__host__ __device__ __forceinline__ int lds_byte(int r, int c) { const int st = (r >> 4) * 2 + (c >> 5), rr = r & 15, cc = c & 31, ob = rr * 64 + cc * 2; return st * 1024 + (ob ^ (((ob >> 9) & 1) << 5)); }
__host__ __device__ __forceinline__ void stage_rc(int b, int& R, int& C) { const int st = b / 1024, sb = b % 1024, swz = sb ^ (((sb >> 9) & 1) << 5); R = (st >> 1) * 16 + swz / 64; C = (st & 1) * 32 + (swz % 64) / 2; }
__host__ __device__ __forceinline__ int perm32(int rho) { const int n = rho >> 4, i = rho & 15; return 8 * (i >> 2) + 4 * n + (i & 3); }

struct Unit { int pm, pn; };
struct Gemm { const bf16_t* A; const bf16_t* Bt; int M, N, K; };

struct StaticOrder {
    int nM, nN, nwg, G, c;
    __host__ __device__ __forceinline__ void init(int M, int N, int G_, int c_) { nM = M / BM; nN = N / BM; nwg = nM * nN; G = G_; c = c_; }
    __host__ __device__ __forceinline__ bool next(int i, Unit& u) const {
        const long L = (long)i * G + c; if (L >= nwg) return false;
        int wgid = (int)L; { const int q = nwg / NXCD, r = nwg % NXCD, xcd = wgid % NXCD, off = wgid / NXCD; wgid = (xcd < r ? xcd * (q + 1) : r * (q + 1) + (xcd - r) * q) + off; }
        const int nig = WGM * nN, gid = wgid / nig, fm = gid * WGM, gsz = (nM - fm) < WGM ? (nM - fm) : WGM;
        u.pm = fm + ((wgid % nig) % gsz); u.pn = (wgid % nig) / gsz; return true;
    }
    __device__ __forceinline__ void a_ready(const Unit&) const {}
    __device__ __forceinline__ void done(const Unit&) const {}
};


__device__ __forceinline__ unsigned cvt_pk_bf16(float lo, float hi) { unsigned r; asm volatile("v_cvt_pk_bf16_f32 %0, %1, %2" : "=v"(r) : "v"(lo), "v"(hi)); return r; }

struct EpiStoreBf16 {
    static constexpr bool PERM = true, AFTER_DRAIN = false;
    bf16_t* O; int ldc;
    __device__ __forceinline__ void operator()(const f32x4 (&acc)[2][2][4][2], const Unit& u, int wr, int wc, int fr_in, int fq_in) const {
        int fr = fr_in, fq = fq_in; asm volatile("" : "+v"(fr), "+v"(fq));
        const int row0 = u.pm * BM + wr * 64 + fr, col0 = u.pn * BM + wc * 32 + 8 * fq;
#pragma unroll
        for (int ai = 0; ai < 2; ++ai)
#pragma unroll
            for (int m = 0; m < 4; ++m) { bf16_t* rowp = O + (size_t)(row0 + ai * HALF + m * 16) * ldc + col0;
#pragma unroll
                for (int bj = 0; bj < 2; ++bj) { const f32x4 v0 = acc[ai][bj][m][0], v1 = acc[ai][bj][m][1];
                    u32x4 w; w.x = cvt_pk_bf16(v0[0], v0[1]); w.y = cvt_pk_bf16(v0[2], v0[3]); w.z = cvt_pk_bf16(v1[0], v1[1]); w.w = cvt_pk_bf16(v1[2], v1[3]);
                    *(u32x4*)(rowp + bj * HALF) = w; } }
    }
};

struct EpiResid {
    static constexpr bool PERM = false, AFTER_DRAIN = false;
    const float* base_lat; const float* base_ctx; float* out_lat; float* out_ctx; const float* gate;
    __device__ __forceinline__ void operator()(const f32x4 (&acc)[2][2][4][2], const Unit& u, int wr, int wc, int fr_in, int fq_in) const {
        int fr = fr_in, fq = fq_in; asm volatile("" : "+v"(fr), "+v"(fq));
        const int r0 = u.pm * BM; const bool isctx = r0 >= 16384; const int bidx = isctx ? 4 : (r0 >> 12);
        const float* base = isctx ? base_ctx + (size_t)(r0 - 16384) * 1024 : base_lat + (size_t)r0 * 1024;
        float* out = isctx ? out_ctx + (size_t)(r0 - 16384) * 1024 : out_lat + (size_t)r0 * 1024;
        const int col0 = u.pn * BM + wc * 32 + 4 * fq;
        const float* g = gate + bidx * 6144 + col0;
        f32x4 gv[2][2];
#pragma unroll
        for (int bj = 0; bj < 2; ++bj)
#pragma unroll
            for (int n = 0; n < 2; ++n) gv[bj][n] = *(const f32x4*)(g + bj * HALF + n * 16);
#pragma unroll
        for (int ai = 0; ai < 2; ++ai) {
            f32x4 bs[4][2][2];
#pragma unroll
            for (int m = 0; m < 4; ++m) { const size_t off = (size_t)(ai * HALF + wr * 64 + m * 16 + fr) * 1024 + col0;
#pragma unroll
                for (int bj = 0; bj < 2; ++bj)
#pragma unroll
                    for (int n = 0; n < 2; ++n) bs[m][bj][n] = *(const f32x4*)(base + off + bj * HALF + n * 16); }
            asm volatile("" ::: "memory");
#pragma unroll
            for (int m = 0; m < 4; ++m) { const size_t off = (size_t)(ai * HALF + wr * 64 + m * 16 + fr) * 1024 + col0;
#pragma unroll
                for (int bj = 0; bj < 2; ++bj)
#pragma unroll
                    for (int n = 0; n < 2; ++n) *(f32x4*)(out + off + bj * HALF + n * 16) = bs[m][bj][n] + gv[bj][n] * acc[ai][bj][m][n]; }
            asm volatile("" ::: "memory");
        }
    }
};

template <bool IN16>
struct EpiResidB {
    static constexpr bool PERM = true, AFTER_DRAIN = false;
    const void* base_lat; const void* base_ctx; bf16_t* out_lat; bf16_t* out_ctx; const float* gate;
    __device__ __forceinline__ void operator()(const f32x4 (&acc)[2][2][4][2], const Unit& u, int wr, int wc, int fr_in, int fq_in) const {
        int fr = fr_in, fq = fq_in; asm volatile("" : "+v"(fr), "+v"(fq));
        const int r0 = u.pm * BM; const bool isctx = r0 >= 16384; const int bidx = isctx ? 4 : (r0 >> 12);
        const size_t rb = (size_t)(isctx ? r0 - 16384 : r0) * 1024;
        const int col0 = u.pn * BM + wc * 32 + 8 * fq;
        const float* g = gate + bidx * 6144 + col0;
        bf16_t* out = (isctx ? out_ctx : out_lat) + rb + col0;
        f32x4 gv[2][2];
#pragma unroll
        for (int bj = 0; bj < 2; ++bj)
#pragma unroll
            for (int n = 0; n < 2; ++n) gv[bj][n] = *(const f32x4*)(g + bj * HALF + n * 4);
#pragma unroll
        for (int ai = 0; ai < 2; ++ai) {
            f32x4 bs[4][2][2];
#pragma unroll
            for (int m = 0; m < 4; ++m) { const size_t off = (size_t)(ai * HALF + wr * 64 + m * 16 + fr) * 1024;
#pragma unroll
                for (int bj = 0; bj < 2; ++bj) {
                    if (IN16) { const u32x4 w = *(const u32x4*)((const bf16_t*)(isctx ? base_ctx : base_lat) + rb + col0 + off + bj * HALF);
                        bs[m][bj][0] = (f32x4){__builtin_bit_cast(float, w.x << 16), __builtin_bit_cast(float, w.x & 0xffff0000u), __builtin_bit_cast(float, w.y << 16), __builtin_bit_cast(float, w.y & 0xffff0000u)};
                        bs[m][bj][1] = (f32x4){__builtin_bit_cast(float, w.z << 16), __builtin_bit_cast(float, w.z & 0xffff0000u), __builtin_bit_cast(float, w.w << 16), __builtin_bit_cast(float, w.w & 0xffff0000u)}; }
                    else { const float* bp = (const float*)(isctx ? base_ctx : base_lat) + rb + col0 + off + bj * HALF; bs[m][bj][0] = *(const f32x4*)bp; bs[m][bj][1] = *(const f32x4*)(bp + 4); } } }
            asm volatile("" ::: "memory");
#pragma unroll
            for (int m = 0; m < 4; ++m) { const size_t off = (size_t)(ai * HALF + wr * 64 + m * 16 + fr) * 1024;
#pragma unroll
                for (int bj = 0; bj < 2; ++bj) { const f32x4 v0 = bs[m][bj][0] + gv[bj][0] * acc[ai][bj][m][0], v1 = bs[m][bj][1] + gv[bj][1] * acc[ai][bj][m][1];
                    u32x4 w; w.x = cvt_pk_bf16(v0[0], v0[1]); w.y = cvt_pk_bf16(v0[2], v0[3]); w.z = cvt_pk_bf16(v1[0], v1[1]); w.w = cvt_pk_bf16(v1[2], v1[3]);
                    *(u32x4*)(out + off + bj * HALF) = w; } }
            asm volatile("" ::: "memory");
        }
    }
};

typedef float f32x2q __attribute__((ext_vector_type(2)));
__device__ __forceinline__ f32x2q silu_mul2b(f32x2q g, f32x2q u) {
    const f32x2q a = g * (-1.4426950408889634f); f32x2q e; e.x = __builtin_amdgcn_exp2f(a.x); e.y = __builtin_amdgcn_exp2f(a.y);
    const f32x2q d = e + 1.0f; f32x2q r; r.x = __builtin_amdgcn_rcpf(d.x); r.y = __builtin_amdgcn_rcpf(d.y);
    return (g * u) * r;
}
__device__ __forceinline__ float silu_mul(float g, float up) { const float e = __builtin_amdgcn_exp2f(-g * 1.4426950408889634f); return g * __builtin_amdgcn_rcpf(1.0f + e) * up; }

struct EpiSwiGLU {
    static constexpr bool PERM = true, AFTER_DRAIN = false;
    bf16_t* O; int ldc; int nN;
    __device__ __forceinline__ void operator()(const f32x4 (&acc)[2][2][4][2], const Unit& u, int wr, int wc, int fr_in, int fq_in) const {
        int fr = fr_in, fq = fq_in; asm volatile("" : "+v"(fr), "+v"(fq));
        const int pnr = nN ? (u.pn % nN) : u.pn;
        const int row0 = u.pm * BM + wr * 64 + fr, col0 = pnr * HALF + wc * 32 + 8 * fq;
#pragma unroll
        for (int ai = 0; ai < 2; ++ai)
#pragma unroll
            for (int m = 0; m < 4; ++m) { bf16_t* rowp = O + (size_t)(row0 + ai * HALF + m * 16) * ldc + col0;
                const f32x4 g0 = acc[ai][0][m][0], g1 = acc[ai][0][m][1], u0 = acc[ai][1][m][0], u1 = acc[ai][1][m][1];
                const f32x2q a0 = silu_mul2b((f32x2q){g0[0], g0[1]}, (f32x2q){u0[0], u0[1]}), a1 = silu_mul2b((f32x2q){g0[2], g0[3]}, (f32x2q){u0[2], u0[3]});
                const f32x2q a2 = silu_mul2b((f32x2q){g1[0], g1[1]}, (f32x2q){u1[0], u1[1]}), a3 = silu_mul2b((f32x2q){g1[2], g1[3]}, (f32x2q){u1[2], u1[3]});
                u32x4 w; w.x = cvt_pk_bf16(a0.x, a0.y); w.y = cvt_pk_bf16(a1.x, a1.y); w.z = cvt_pk_bf16(a2.x, a2.y); w.w = cvt_pk_bf16(a3.x, a3.y);
                *(u32x4*)rowp = w; }
    }
};

__device__ __forceinline__ float clamp448(float x) { return __builtin_fminf(__builtin_fmaxf(x, -448.0f), 448.0f); }
__device__ __forceinline__ unsigned pack_fp8x4(float a, float b, float c, float d) { int w = 0; w = __builtin_amdgcn_cvt_pk_fp8_f32(clamp448(a), clamp448(b), w, false); w = __builtin_amdgcn_cvt_pk_fp8_f32(clamp448(c), clamp448(d), w, true); return (unsigned)w; }
typedef float f32x2p __attribute__((ext_vector_type(2)));
__device__ __forceinline__ f32x2p silu_mul2(f32x2p g, f32x2p u, float mul, float nl2e = -1.4426950408889634f) {
    const f32x2p a = g * nl2e; f32x2p e; e.x = __builtin_amdgcn_exp2f(a.x); e.y = __builtin_amdgcn_exp2f(a.y);
    const f32x2p d = e + 1.0f; f32x2p r; r.x = __builtin_amdgcn_rcpf(d.x); r.y = __builtin_amdgcn_rcpf(d.y);
    f32x2p t = (g * u) * (r * mul); t.x = __builtin_amdgcn_fmed3f(t.x, -448.0f, 448.0f); t.y = __builtin_amdgcn_fmed3f(t.y, -448.0f, 448.0f); return t;
}
__device__ __forceinline__ unsigned pack_fp8x4_noclamp(f32x2p a, f32x2p b) { int w = 0; w = __builtin_amdgcn_cvt_pk_fp8_f32(a.x, a.y, w, false); w = __builtin_amdgcn_cvt_pk_fp8_f32(b.x, b.y, w, true); return (unsigned)w; }
struct EpiSwiGLU8 {
    static constexpr bool PERM = true, AFTER_DRAIN = false;
    unsigned char* O; int ldc; int nN; float mul; float as;
    __device__ __forceinline__ void operator()(const f32x4 (&acc)[2][2][4][2], const Unit& u, int wr, int wc, int fr_in, int fq_in) const {
        int fr = fr_in, fq = fq_in; asm volatile("" : "+v"(fr), "+v"(fq));
        const int pnr = nN ? (u.pn % nN) : u.pn;
        const int row0 = u.pm * BM + wr * 64 + fr, col0 = pnr * HALF + wc * 32 + 8 * fq;
        const float nl = -1.4426950408889634f * as, m2 = mul * as * as;
#pragma unroll
        for (int ai = 0; ai < 2; ++ai)
#pragma unroll
            for (int m = 0; m < 4; ++m) { unsigned char* rowp = O + (size_t)(row0 + ai * HALF + m * 16) * ldc + col0;
                const f32x4 g0 = acc[ai][0][m][0], g1 = acc[ai][0][m][1], u0 = acc[ai][1][m][0], u1 = acc[ai][1][m][1];
                typedef unsigned u32x2 __attribute__((ext_vector_type(2))); u32x2 w;
                w.x = pack_fp8x4_noclamp(silu_mul2((f32x2p){g0[0], g0[1]}, (f32x2p){u0[0], u0[1]}, m2, nl), silu_mul2((f32x2p){g0[2], g0[3]}, (f32x2p){u0[2], u0[3]}, m2, nl));
                w.y = pack_fp8x4_noclamp(silu_mul2((f32x2p){g1[0], g1[1]}, (f32x2p){u1[0], u1[1]}, m2, nl), silu_mul2((f32x2p){g1[2], g1[3]}, (f32x2p){u1[2], u1[3]}, m2, nl));
                *(u32x2*)rowp = w; }
    }
};

struct EpiMoeDown {
    static constexpr bool PERM = true, AFTER_DRAIN = false;
    bf16_t* O; const float* roww; int nN; float as;
    __device__ __forceinline__ void operator()(const f32x4 (&acc)[2][2][4][2], const Unit& u, int wr, int wc, int fr_in, int fq_in) const {
        int fr = fr_in, fq = fq_in; asm volatile("" : "+v"(fr), "+v"(fq));
        const int pnr = u.pn % nN;
        const int row0 = u.pm * BM + wr * 64 + fr, col0 = pnr * BM + wc * 32 + 8 * fq;
#pragma unroll
        for (int ai = 0; ai < 2; ++ai)
#pragma unroll
            for (int m = 0; m < 4; ++m) { const int row = row0 + ai * HALF + m * 16; const float wgt = roww[row] * as; bf16_t* rowp = O + (size_t)row * 1024 + col0;
#pragma unroll
                for (int bj = 0; bj < 2; ++bj) { const f32x4 v0 = acc[ai][bj][m][0] * wgt, v1 = acc[ai][bj][m][1] * wgt;
                    u32x4 w; w.x = cvt_pk_bf16(v0[0], v0[1]); w.y = cvt_pk_bf16(v0[2], v0[3]); w.z = cvt_pk_bf16(v1[0], v1[1]); w.w = cvt_pk_bf16(v1[2], v1[3]);
                    *(u32x4*)(rowp + bj * HALF) = w; } }
    }
};


struct EpiResidNorm {
    static constexpr bool PERM = false, AFTER_DRAIN = false;
    const float* base_lat; const float* base_ctx; float* out_lat; float* out_ctx; const float* gate;
    bf16_t* H; float* ss; const float* nw; const float* sc;
    __device__ __forceinline__ void operator()(const f32x4 (&acc)[2][2][4][2], const Unit& u, int wr, int wc, int fr_in, int fq_in) const {
        int fr = fr_in, fq = fq_in; asm volatile("" : "+v"(fr), "+v"(fq));
        const int r0 = u.pm * BM; const bool isctx = r0 >= 16384; const int bidx = isctx ? 4 : (r0 >> 12);
        const float* base = isctx ? base_ctx + (size_t)(r0 - 16384) * 1024 : base_lat + (size_t)r0 * 1024;
        float* out = isctx ? out_ctx + (size_t)(r0 - 16384) * 1024 : out_lat + (size_t)r0 * 1024;
        const int col0 = u.pn * BM + wc * 32 + 4 * fq;
        float ssq[8];
#pragma unroll
        for (int i = 0; i < 8; ++i) ssq[i] = 0.f;
#pragma unroll
        for (int bj = 0; bj < 2; ++bj)
#pragma unroll
            for (int n = 0; n < 2; ++n) { const int col = col0 + bj * HALF + n * 16;
                const f32x4 gv = *(const f32x4*)(gate + bidx * 6144 + col); const f32x4 cw = *(const f32x4*)(nw + col) * (*(const f32x4*)(sc + bidx * 6144 + col) + 1.0f);
#pragma unroll
                for (int ai = 0; ai < 2; ++ai)
#pragma unroll
                    for (int m = 0; m < 4; ++m) { const int rl = ai * HALF + wr * 64 + m * 16 + fr; const size_t off = (size_t)rl * 1024 + col;
                        const f32x4 x = *(const f32x4*)(base + off) + gv * acc[ai][bj][m][n];
                        *(f32x4*)(out + off) = x;
                        const f32x4 h = x * cw; typedef unsigned u32x2 __attribute__((ext_vector_type(2))); u32x2 w; w.x = cvt_pk_bf16(h[0], h[1]); w.y = cvt_pk_bf16(h[2], h[3]);
                        *(u32x2*)(H + (size_t)(r0 + rl) * 1024 + col) = w;
                        ssq[ai * 4 + m] += (x[0] * x[0] + x[1] * x[1]) + (x[2] * x[2] + x[3] * x[3]);
                        if (m == 3) asm volatile("" ::: "memory"); } }
#pragma unroll
        for (int i = 0; i < 8; ++i) { float v = ssq[i]; v += __shfl_xor(v, 16); v += __shfl_xor(v, 32);
            if (fq == 0) atomicAdd(ss + r0 + (i >> 2) * HALF + wr * 64 + (i & 3) * 16 + fr, v); }
    }
};
struct EpiSwiGLUN {
    static constexpr bool PERM = true, AFTER_DRAIN = false;
    bf16_t* O; int ldc; const float* ss; const float* bias;
    __device__ __forceinline__ void operator()(const f32x4 (&acc)[2][2][4][2], const Unit& u, int wr, int wc, int fr_in, int fq_in) const {
        int fr = fr_in, fq = fq_in; asm volatile("" : "+v"(fr), "+v"(fq));
        const int r0 = u.pm * BM; const int bidx = r0 >= 16384 ? 4 : (r0 >> 12);
        const int row0 = r0 + wr * 64 + fr, col0 = u.pn * HALF + wc * 32 + 8 * fq;
        const float* bp = bias + (size_t)bidx * (2 * ldc) + u.pn * BM + wc * 32 + 8 * fq;
        const f32x4 bg0 = *(const f32x4*)bp, bg1 = *(const f32x4*)(bp + 4), bu0 = *(const f32x4*)(bp + HALF), bu1 = *(const f32x4*)(bp + HALF + 4);
#pragma unroll
        for (int ai = 0; ai < 2; ++ai)
#pragma unroll
            for (int m = 0; m < 4; ++m) { const int row = row0 + ai * HALF + m * 16; const float rstd = 1.0f / sqrtf(ss[row] * (1.0f / 1024.0f) + 1e-6f);
                bf16_t* rowp = O + (size_t)row * ldc + col0;
                const f32x4 g0 = acc[ai][0][m][0] * rstd + bg0, g1 = acc[ai][0][m][1] * rstd + bg1, u0 = acc[ai][1][m][0] * rstd + bu0, u1 = acc[ai][1][m][1] * rstd + bu1;
                u32x4 w; w.x = cvt_pk_bf16(silu_mul(g0[0], u0[0]), silu_mul(g0[1], u0[1])); w.y = cvt_pk_bf16(silu_mul(g0[2], u0[2]), silu_mul(g0[3], u0[3]));
                w.z = cvt_pk_bf16(silu_mul(g1[0], u1[0]), silu_mul(g1[1], u1[1])); w.w = cvt_pk_bf16(silu_mul(g1[2], u1[2]), silu_mul(g1[3], u1[3]));
                *(u32x4*)rowp = w; }
    }
};
struct EpiStoreBf16N {
    static constexpr bool PERM = true, AFTER_DRAIN = false;
    bf16_t* O; int ldc; const float* ss; const float* bias;
    __device__ __forceinline__ void operator()(const f32x4 (&acc)[2][2][4][2], const Unit& u, int wr, int wc, int fr_in, int fq_in) const {
        int fr = fr_in, fq = fq_in; asm volatile("" : "+v"(fr), "+v"(fq));
        const int r0 = u.pm * BM; const int bidx = r0 >= 16384 ? 4 : (r0 >> 12);
        const int row0 = r0 + wr * 64 + fr, col0 = u.pn * BM + wc * 32 + 8 * fq;
        const float* bp = bias + (size_t)bidx * ldc + col0;
        const f32x4 b00 = *(const f32x4*)bp, b01 = *(const f32x4*)(bp + 4), b10 = *(const f32x4*)(bp + HALF), b11 = *(const f32x4*)(bp + HALF + 4);
#pragma unroll
        for (int ai = 0; ai < 2; ++ai)
#pragma unroll
            for (int m = 0; m < 4; ++m) { const int row = row0 + ai * HALF + m * 16; const float rstd = 1.0f / sqrtf(ss[row] * (1.0f / 1024.0f) + 1e-6f);
                bf16_t* rowp = O + (size_t)row * ldc + col0;
                { const f32x4 v0 = acc[ai][0][m][0] * rstd + b00, v1 = acc[ai][0][m][1] * rstd + b01;
                  u32x4 w; w.x = cvt_pk_bf16(v0[0], v0[1]); w.y = cvt_pk_bf16(v0[2], v0[3]); w.z = cvt_pk_bf16(v1[0], v1[1]); w.w = cvt_pk_bf16(v1[2], v1[3]); *(u32x4*)rowp = w; }
                { const f32x4 v0 = acc[ai][1][m][0] * rstd + b10, v1 = acc[ai][1][m][1] * rstd + b11;
                  u32x4 w; w.x = cvt_pk_bf16(v0[0], v0[1]); w.y = cvt_pk_bf16(v0[2], v0[3]); w.z = cvt_pk_bf16(v1[0], v1[1]); w.w = cvt_pk_bf16(v1[2], v1[3]); *(u32x4*)(rowp + HALF) = w; } }
    }
};

struct RoundsOrder {
    StaticOrder so; int R;
    __device__ __forceinline__ void init(int M, int N, int G_, int c_, int R_) { so.init(M, N, G_, c_); R = R_; }
    __device__ __forceinline__ bool next(int i, Unit& u) const { return i < R && so.next(i, u); }
    __device__ __forceinline__ void a_ready(const Unit&) const {}
    __device__ __forceinline__ void done(const Unit&) const {}
};
struct MoeOrder {
    StaticOrder so; const int* panel_e; int nN; int R;
    __device__ __forceinline__ void init(int np, int nN_, int G_, int c_, const int* pe, int R_ = 1 << 30) { so.init(np * BM, nN_ * BM, G_, c_); panel_e = pe; nN = nN_; R = R_; }
    __device__ __forceinline__ bool next(int i, Unit& u) const { if (i >= R || !so.next(i, u)) return false; u.pn += panel_e[u.pm] * nN; return true; }
    __device__ __forceinline__ void a_ready(const Unit&) const {}
    __device__ __forceinline__ void done(const Unit&) const {}
};
template <class Epi, class Sched, bool ALIGN_EPI = false, bool SP2 = false>
__device__ __forceinline__ void gemm_phase(PG8_LAS unsigned char* lds, const Gemm g, const Sched& S, const Epi& E) {
    const int tid = ltid(), wid = __builtin_amdgcn_readfirstlane(tid >> 6), lane = tid & 63, wr = wid >> 2, wc = wid & 3, fr = lane & 15, fq = lane >> 4;
    const int K = g.K, nt = K / BK;
    unsigned voffA[2], voffB[2];
#pragma unroll
    for (int i = 0; i < 2; ++i) { int R, C; stage_rc(tid * 16 + i * 8192, R, C); const int Rb = Epi::PERM ? ((R & ~31) + perm32(R & 31)) : R;
        voffA[i] = (unsigned)(R * K + C) * 2u; voffB[i] = (unsigned)(Rb * K + C) * 2u; }
    const size_t kstep = (size_t)(BK * 2);
    const size_t hstep = (size_t)HALF * K * 2;
    const size_t tstep = 2 * hstep;
    const unsigned ldsw = (unsigned)wid * 1024u;
    const int aoff = lds_byte(wr * 64 + fr, fq * 8), boff = lds_byte(wc * 32 + fr, fq * 8);
#define PG8_SA(b, h) (((b) * 2 + (h)) * HTB)
#define PG8_SB(b, h) ((4 + (b) * 2 + (h)) * HTB)
#define PG8_STAGE(bufoff, gbase, voff) do { _Pragma("unroll") for (int _i = 0; _i < 2; ++_i) \
        __builtin_amdgcn_global_load_lds((const unsigned*)((const char*)(gbase) + (voff)[_i]), (PG8_LAS unsigned*)(lds + (bufoff) + ldsw + _i * 8192), 16, 0, 0); } while (0)
#define PG8_LDA(dst, b, h) do { _Pragma("unroll") for (int m = 0; m < 4; ++m) _Pragma("unroll") for (int k = 0; k < 2; ++k) dst[m][k] = *(const PG8_LAS bf16x8*)(lds + PG8_SA(b, h) + aoff + m * 2048 + k * 1024); } while (0)
#define PG8_LDB(dst, b, h) do { _Pragma("unroll") for (int n = 0; n < 2; ++n) _Pragma("unroll") for (int k = 0; k < 2; ++k) dst[n][k] = *(const PG8_LAS bf16x8*)(lds + PG8_SB(b, h) + boff + n * 2048 + k * 1024); } while (0)
#define PG8_MMA(ai, bj, At, Bt) do { __builtin_amdgcn_s_setprio(1); _Pragma("unroll") for (int m = 0; m < 4; ++m) _Pragma("unroll") for (int n = 0; n < 2; ++n) _Pragma("unroll") for (int k = 0; k < 2; ++k) \
        acc[ai][bj][m][n] = __builtin_amdgcn_mfma_f32_16x16x32_bf16(Bt[n][k], At[m][k], acc[ai][bj][m][n], 0, 0, 0); __builtin_amdgcn_s_setprio(0); } while (0)
#define PG8_WAIT_V(n) asm volatile("s_waitcnt vmcnt(" #n ")" ::: "memory")
#define PG8_WAIT_L(n) asm volatile("s_waitcnt lgkmcnt(" #n ")" ::: "memory")
#define PG8_BAR __builtin_amdgcn_s_barrier()
#define PG8_SCHED __builtin_amdgcn_sched_barrier(0)
    Unit cur, nxt; int ui = 0;
    if (!S.next(0, cur)) return;
    f32x4 acc[2][2][4][2];
#pragma unroll
    for (int a = 0; a < 2; ++a)
#pragma unroll
        for (int b = 0; b < 2; ++b)
#pragma unroll
            for (int m = 0; m < 4; ++m)
#pragma unroll
                for (int n = 0; n < 2; ++n) acc[a][b][m][n] = (f32x4){0.f, 0.f, 0.f, 0.f};
    bf16x8 At[4][2], B0[2][2], B1[2][2];
    const char* cA = (const char*)g.A + (size_t)cur.pm * tstep; const char* cB = (const char*)g.Bt + (size_t)cur.pn * tstep;
    S.a_ready(cur);
    if constexpr (SP2) {
        PG8_STAGE(PG8_SB(0, 0), cB, voffB); PG8_STAGE(PG8_SB(0, 1), cB + hstep, voffB); PG8_STAGE(PG8_SA(0, 0), cA, voffA); PG8_STAGE(PG8_SA(0, 1), cA + hstep, voffA);
        if (wr == 1) PG8_BAR;
        PG8_WAIT_V(2); PG8_BAR;
        PG8_STAGE(PG8_SB(1, 0), cB + kstep, voffB); PG8_STAGE(PG8_SA(1, 0), cA + kstep, voffA); PG8_STAGE(PG8_SB(1, 1), cB + hstep + kstep, voffB);
        PG8_WAIT_V(6); PG8_BAR;
    } else {
        PG8_STAGE(PG8_SB(0, 0), cB, voffB); PG8_STAGE(PG8_SA(0, 0), cA, voffA); PG8_STAGE(PG8_SB(0, 1), cB + hstep, voffB); PG8_STAGE(PG8_SA(0, 1), cA + hstep, voffA);
        if (wr == 1) PG8_BAR;
        PG8_WAIT_V(4); PG8_BAR;
        PG8_STAGE(PG8_SB(1, 0), cB + kstep, voffB); PG8_STAGE(PG8_SA(1, 0), cA + kstep, voffA); PG8_STAGE(PG8_SB(1, 1), cB + hstep + kstep, voffB);
        PG8_WAIT_V(6); PG8_BAR;
    }
    for (;;) {
        const bool has_next = S.next(ui + 1, nxt);
        const char* nA = has_next ? (const char*)g.A + (size_t)nxt.pm * tstep : cA; const char* nB = has_next ? (const char*)g.Bt + (size_t)nxt.pn * tstep : cB;
        for (int t = 0; t < nt; t += 2) {
            const bool last = (t == nt - 2);
            const char* a1 = cA + (size_t)(t + 1) * kstep;
            const char* a2 = last ? nA : cA + (size_t)(t + 2) * kstep; const char* b2 = last ? nB : cB + (size_t)(t + 2) * kstep;
            const char* a3 = a2 + kstep; const char* b3 = b2 + kstep;
            if (last && has_next) S.a_ready(nxt);
            if constexpr (SP2) {
            PG8_LDB(B0, 0, 0); PG8_LDB(B1, 0, 1); PG8_SCHED; PG8_LDA(At, 0, 0); PG8_STAGE(PG8_SA(1, 1), a1 + hstep, voffA);
            PG8_WAIT_V(8); PG8_WAIT_L(0); PG8_BAR; PG8_MMA(0, 0, At, B0); PG8_MMA(0, 1, At, B1); PG8_BAR; PG8_SCHED;
            PG8_LDA(At, 0, 1); PG8_STAGE(PG8_SB(0, 0), b2, voffB); PG8_STAGE(PG8_SB(0, 1), b2 + hstep, voffB); PG8_STAGE(PG8_SA(0, 0), a2, voffA);
            PG8_WAIT_V(8); PG8_WAIT_L(0); PG8_BAR; PG8_MMA(1, 0, At, B0); PG8_MMA(1, 1, At, B1); PG8_BAR; PG8_SCHED;
            PG8_LDB(B0, 1, 0); PG8_LDB(B1, 1, 1); PG8_SCHED; PG8_LDA(At, 1, 0); PG8_STAGE(PG8_SA(0, 1), a2 + hstep, voffA);
            PG8_WAIT_V(8); PG8_WAIT_L(0); PG8_BAR; PG8_MMA(0, 0, At, B0); PG8_MMA(0, 1, At, B1); PG8_BAR; PG8_SCHED;
            PG8_LDA(At, 1, 1); PG8_STAGE(PG8_SB(1, 0), b3, voffB); PG8_STAGE(PG8_SB(1, 1), b3 + hstep, voffB); PG8_STAGE(PG8_SA(1, 0), a3, voffA);
            PG8_WAIT_V(8); PG8_WAIT_L(0); PG8_BAR; PG8_MMA(1, 0, At, B0); PG8_MMA(1, 1, At, B1); PG8_BAR; PG8_SCHED;
            } else {
            PG8_LDB(B0, 0, 0); PG8_SCHED; PG8_LDA(At, 0, 0); PG8_STAGE(PG8_SA(1, 1), a1 + hstep, voffA);
            PG8_WAIT_L(8); PG8_BAR; PG8_WAIT_L(0); PG8_MMA(0, 0, At, B0); PG8_BAR; PG8_SCHED;
            PG8_LDB(B1, 0, 1); PG8_STAGE(PG8_SB(0, 0), b2, voffB);
            PG8_BAR; PG8_WAIT_L(0); PG8_MMA(0, 1, At, B1); PG8_BAR;
            PG8_LDA(At, 0, 1); PG8_STAGE(PG8_SA(0, 0), a2, voffA);
            PG8_BAR; PG8_WAIT_L(0); PG8_MMA(1, 0, At, B0); PG8_BAR; PG8_SCHED;
            PG8_STAGE(PG8_SB(0, 1), b2 + hstep, voffB);
            PG8_WAIT_V(6); PG8_BAR; PG8_MMA(1, 1, At, B1); PG8_BAR;
            PG8_LDB(B0, 1, 0); PG8_SCHED; PG8_LDA(At, 1, 0); PG8_STAGE(PG8_SA(0, 1), a2 + hstep, voffA);
            PG8_WAIT_L(8); PG8_BAR; PG8_WAIT_L(0); PG8_MMA(0, 0, At, B0); PG8_BAR; PG8_SCHED;
            PG8_LDB(B1, 1, 1); PG8_STAGE(PG8_SB(1, 0), b3, voffB);
            PG8_BAR; PG8_WAIT_L(0); PG8_MMA(0, 1, At, B1); PG8_BAR;
            PG8_LDA(At, 1, 1); PG8_STAGE(PG8_SA(1, 0), a3, voffA);
            PG8_BAR; PG8_WAIT_L(0); PG8_MMA(1, 0, At, B0); PG8_BAR; PG8_SCHED;
            PG8_STAGE(PG8_SB(1, 1), b3 + hstep, voffB);
            PG8_WAIT_V(6); PG8_BAR; PG8_MMA(1, 1, At, B1); PG8_BAR;
            }
        }
        if constexpr (ALIGN_EPI) { if (wr == 0) PG8_BAR; }
        if constexpr (!Epi::AFTER_DRAIN) { E(acc, cur, wr, wc, fr, fq); S.done(cur); }
        if (!has_next) break;
#pragma unroll
        for (int a = 0; a < 2; ++a)
#pragma unroll
            for (int b = 0; b < 2; ++b)
#pragma unroll
                for (int m = 0; m < 4; ++m)
#pragma unroll
                    for (int n = 0; n < 2; ++n) acc[a][b][m][n] = (f32x4){0.f, 0.f, 0.f, 0.f};
        cur = nxt; cA = nA; cB = nB; ++ui;
        if constexpr (ALIGN_EPI) { if (wr == 1) PG8_BAR; }
    }
    PG8_WAIT_V(0);
    if constexpr (!ALIGN_EPI) { if (wr == 0) PG8_BAR; }
    PG8_BAR;
    if constexpr (Epi::AFTER_DRAIN) { E.fused(acc, cur, wr, wc, fr, fq, lds, wid, lane); S.done(cur); }
#undef PG8_SA
#undef PG8_SB
#undef PG8_STAGE
#undef PG8_LDA
#undef PG8_LDB
#undef PG8_MMA
#undef PG8_WAIT_V
#undef PG8_WAIT_L
#undef PG8_BAR
#undef PG8_SCHED
}

typedef int v4i_ __attribute__((ext_vector_type(4)));
typedef int v8i_ __attribute__((ext_vector_type(8)));
#define PG8_CAT8(x, y) __builtin_shufflevector(__builtin_bit_cast(v4i_, x), __builtin_bit_cast(v4i_, y), 0, 1, 2, 3, 4, 5, 6, 7)
template <class Epi, class Sched, bool ALIGN_EPI = false, bool SP2 = false>
__device__ __forceinline__ void gemm_phase_f8(PG8_LAS unsigned char* lds, const Gemm g, const Sched& S, const Epi& E, int sc_a, int sc_b) {
    const int tid = ltid(), wid = __builtin_amdgcn_readfirstlane(tid >> 6), lane = tid & 63, wr = wid >> 2, wc = wid & 3, fr = lane & 15, fq = lane >> 4;
    const int K = g.K, nt = K / BK;
    (void)sc_a; (void)sc_b;
    unsigned voffA[2], voffB[2];
#pragma unroll
    for (int i = 0; i < 2; ++i) { int R, C; stage_rc(tid * 16 + i * 8192, R, C); const int Rb = Epi::PERM ? ((R & ~31) + perm32(R & 31)) : R;
        voffA[i] = (unsigned)(R * K + C) * 2u; voffB[i] = (unsigned)(Rb * K + C) * 2u; }
    const size_t kstep = (size_t)(BK * 2);
    const size_t hstep = (size_t)HALF * K * 2;
    const size_t tstep = 2 * hstep;
    const unsigned ldsw = (unsigned)wid * 1024u;
    const int aoff = lds_byte(wr * 64 + fr, fq * 8), boff = lds_byte(wc * 32 + fr, fq * 8);
#define PG8_SA(b, h) (((b) * 2 + (h)) * HTB)
#define PG8_SB(b, h) ((4 + (b) * 2 + (h)) * HTB)
#define PG8_STAGE(bufoff, gbase, voff) do { _Pragma("unroll") for (int _i = 0; _i < 2; ++_i) \
        __builtin_amdgcn_global_load_lds((const unsigned*)((const char*)(gbase) + (voff)[_i]), (PG8_LAS unsigned*)(lds + (bufoff) + ldsw + _i * 8192), 16, 0, 0); } while (0)
#define PG8_LDA(dst, b, h) do { _Pragma("unroll") for (int m = 0; m < 4; ++m) { const v4i_ lo_ = *(const PG8_LAS v4i_*)(lds + PG8_SA(b, h) + aoff + m * 2048), hi_ = *(const PG8_LAS v4i_*)(lds + PG8_SA(b, h) + aoff + m * 2048 + 1024); dst[m] = __builtin_shufflevector(lo_, hi_, 0, 1, 2, 3, 4, 5, 6, 7); } } while (0)
#define PG8_LDB(dst, b, h) do { _Pragma("unroll") for (int n = 0; n < 2; ++n) { const v4i_ lo_ = *(const PG8_LAS v4i_*)(lds + PG8_SB(b, h) + boff + n * 2048), hi_ = *(const PG8_LAS v4i_*)(lds + PG8_SB(b, h) + boff + n * 2048 + 1024); dst[n] = __builtin_shufflevector(lo_, hi_, 0, 1, 2, 3, 4, 5, 6, 7); } } while (0)
#define PG8_MMA(ai, bj, At, Bt) do { __builtin_amdgcn_s_setprio(1); _Pragma("unroll") for (int m = 0; m < 4; ++m) _Pragma("unroll") for (int n = 0; n < 2; ++n) \
        asm volatile("v_mfma_f32_16x16x128_f8f6f4 %0, %1, %2, %0" : "+v"(acc[ai][bj][m][n]) : "v"(Bt[n]), "v"(At[m])); __builtin_amdgcn_s_setprio(0); } while (0)
#define PG8_WAIT_V(n) asm volatile("s_waitcnt vmcnt(" #n ")" ::: "memory")
#define PG8_WAIT_L(n) asm volatile("s_waitcnt lgkmcnt(" #n ")" ::: "memory")
#define PG8_BAR __builtin_amdgcn_s_barrier()
#define PG8_SCHED __builtin_amdgcn_sched_barrier(0)
    Unit cur, nxt; int ui = 0;
    if (!S.next(0, cur)) return;
    f32x4 acc[2][2][4][2];
#pragma unroll
    for (int a = 0; a < 2; ++a)
#pragma unroll
        for (int b = 0; b < 2; ++b)
#pragma unroll
            for (int m = 0; m < 4; ++m)
#pragma unroll
                for (int n = 0; n < 2; ++n) acc[a][b][m][n] = (f32x4){0.f, 0.f, 0.f, 0.f};
    v8i_ At[4], B0[2], B1[2];
    const char* cA = (const char*)g.A + (size_t)cur.pm * tstep; const char* cB = (const char*)g.Bt + (size_t)cur.pn * tstep;
    S.a_ready(cur);
    if constexpr (SP2) {
        PG8_STAGE(PG8_SB(0, 0), cB, voffB); PG8_STAGE(PG8_SB(0, 1), cB + hstep, voffB); PG8_STAGE(PG8_SA(0, 0), cA, voffA); PG8_STAGE(PG8_SA(0, 1), cA + hstep, voffA);
        if (wr == 1) PG8_BAR;
        PG8_WAIT_V(2); PG8_BAR;
        PG8_STAGE(PG8_SB(1, 0), cB + kstep, voffB); PG8_STAGE(PG8_SA(1, 0), cA + kstep, voffA); PG8_STAGE(PG8_SB(1, 1), cB + hstep + kstep, voffB);
        PG8_WAIT_V(6); PG8_BAR;
    } else {
        PG8_STAGE(PG8_SB(0, 0), cB, voffB); PG8_STAGE(PG8_SA(0, 0), cA, voffA); PG8_STAGE(PG8_SB(0, 1), cB + hstep, voffB); PG8_STAGE(PG8_SA(0, 1), cA + hstep, voffA);
        if (wr == 1) PG8_BAR;
        PG8_WAIT_V(4); PG8_BAR;
        PG8_STAGE(PG8_SB(1, 0), cB + kstep, voffB); PG8_STAGE(PG8_SA(1, 0), cA + kstep, voffA); PG8_STAGE(PG8_SB(1, 1), cB + hstep + kstep, voffB);
        PG8_WAIT_V(6); PG8_BAR;
    }
    for (;;) {
        const bool has_next = S.next(ui + 1, nxt);
        const char* nA = has_next ? (const char*)g.A + (size_t)nxt.pm * tstep : cA; const char* nB = has_next ? (const char*)g.Bt + (size_t)nxt.pn * tstep : cB;
        for (int t = 0; t < nt; t += 2) {
            const bool last = (t == nt - 2);
            const char* a1 = cA + (size_t)(t + 1) * kstep;
            const char* a2 = last ? nA : cA + (size_t)(t + 2) * kstep; const char* b2 = last ? nB : cB + (size_t)(t + 2) * kstep;
            const char* a3 = a2 + kstep; const char* b3 = b2 + kstep;
            if (last && has_next) S.a_ready(nxt);
            if constexpr (SP2) {
            PG8_LDB(B0, 0, 0); PG8_LDB(B1, 0, 1); PG8_SCHED; PG8_LDA(At, 0, 0); PG8_STAGE(PG8_SA(1, 1), a1 + hstep, voffA);
            PG8_WAIT_V(8); PG8_WAIT_L(0); PG8_BAR; PG8_MMA(0, 0, At, B0); PG8_MMA(0, 1, At, B1); PG8_BAR; PG8_SCHED;
            PG8_LDA(At, 0, 1); PG8_STAGE(PG8_SB(0, 0), b2, voffB); PG8_STAGE(PG8_SB(0, 1), b2 + hstep, voffB); PG8_STAGE(PG8_SA(0, 0), a2, voffA);
            PG8_WAIT_V(8); PG8_WAIT_L(0); PG8_BAR; PG8_MMA(1, 0, At, B0); PG8_MMA(1, 1, At, B1); PG8_BAR; PG8_SCHED;
            PG8_LDB(B0, 1, 0); PG8_LDB(B1, 1, 1); PG8_SCHED; PG8_LDA(At, 1, 0); PG8_STAGE(PG8_SA(0, 1), a2 + hstep, voffA);
            PG8_WAIT_V(8); PG8_WAIT_L(0); PG8_BAR; PG8_MMA(0, 0, At, B0); PG8_MMA(0, 1, At, B1); PG8_BAR; PG8_SCHED;
            PG8_LDA(At, 1, 1); PG8_STAGE(PG8_SB(1, 0), b3, voffB); PG8_STAGE(PG8_SB(1, 1), b3 + hstep, voffB); PG8_STAGE(PG8_SA(1, 0), a3, voffA);
            PG8_WAIT_V(8); PG8_WAIT_L(0); PG8_BAR; PG8_MMA(1, 0, At, B0); PG8_MMA(1, 1, At, B1); PG8_BAR; PG8_SCHED;
            } else {
            PG8_LDB(B0, 0, 0); PG8_SCHED; PG8_LDA(At, 0, 0); PG8_STAGE(PG8_SA(1, 1), a1 + hstep, voffA);
            PG8_WAIT_L(8); PG8_BAR; PG8_WAIT_L(0); PG8_MMA(0, 0, At, B0); PG8_BAR; PG8_SCHED;
            PG8_LDB(B1, 0, 1); PG8_STAGE(PG8_SB(0, 0), b2, voffB);
            PG8_BAR; PG8_WAIT_L(0); PG8_MMA(0, 1, At, B1); PG8_BAR;
            PG8_LDA(At, 0, 1); PG8_STAGE(PG8_SA(0, 0), a2, voffA);
            PG8_BAR; PG8_WAIT_L(0); PG8_MMA(1, 0, At, B0); PG8_BAR; PG8_SCHED;
            PG8_STAGE(PG8_SB(0, 1), b2 + hstep, voffB);
            PG8_WAIT_V(6); PG8_BAR; PG8_MMA(1, 1, At, B1); PG8_BAR;
            PG8_LDB(B0, 1, 0); PG8_SCHED; PG8_LDA(At, 1, 0); PG8_STAGE(PG8_SA(0, 1), a2 + hstep, voffA);
            PG8_WAIT_L(8); PG8_BAR; PG8_WAIT_L(0); PG8_MMA(0, 0, At, B0); PG8_BAR; PG8_SCHED;
            PG8_LDB(B1, 1, 1); PG8_STAGE(PG8_SB(1, 0), b3, voffB);
            PG8_BAR; PG8_WAIT_L(0); PG8_MMA(0, 1, At, B1); PG8_BAR;
            PG8_LDA(At, 1, 1); PG8_STAGE(PG8_SA(1, 0), a3, voffA);
            PG8_BAR; PG8_WAIT_L(0); PG8_MMA(1, 0, At, B0); PG8_BAR; PG8_SCHED;
            PG8_STAGE(PG8_SB(1, 1), b3 + hstep, voffB);
            PG8_WAIT_V(6); PG8_BAR; PG8_MMA(1, 1, At, B1); PG8_BAR;
            }
        }
        if constexpr (ALIGN_EPI) { if (wr == 0) PG8_BAR; }
        asm volatile("s_nop 15\n\ts_nop 15\n\ts_nop 15" ::: "memory");
        if constexpr (!Epi::AFTER_DRAIN) { E(acc, cur, wr, wc, fr, fq); S.done(cur); }
        if (!has_next) break;
#pragma unroll
        for (int a = 0; a < 2; ++a)
#pragma unroll
            for (int b = 0; b < 2; ++b)
#pragma unroll
                for (int m = 0; m < 4; ++m)
#pragma unroll
                    for (int n = 0; n < 2; ++n) acc[a][b][m][n] = (f32x4){0.f, 0.f, 0.f, 0.f};
        cur = nxt; cA = nA; cB = nB; ++ui;
        if constexpr (ALIGN_EPI) { if (wr == 1) PG8_BAR; }
    }
    PG8_WAIT_V(0);
    if constexpr (!ALIGN_EPI) { if (wr == 0) PG8_BAR; }
    PG8_BAR;
    if constexpr (Epi::AFTER_DRAIN) { E.fused(acc, cur, wr, wc, fr, fq, lds, wid, lane); S.done(cur); }
#undef PG8_SA
#undef PG8_SB
#undef PG8_STAGE
#undef PG8_LDA
#undef PG8_LDB
#undef PG8_MMA
#undef PG8_WAIT_V
#undef PG8_WAIT_L
#undef PG8_BAR
#undef PG8_SCHED
}

template <class Epi, class Sched>
__device__ __forceinline__ void gemm_phase_gather(PG8_LAS unsigned char* lds, const Gemm g, const Sched& S, const Epi& E, const int* rowlist, int sc_a, int sc_b) {
    const int tid = ltid(), wid = __builtin_amdgcn_readfirstlane(tid >> 6), lane = tid & 63, wr = wid >> 2, wc = wid & 3, fr = lane & 15, fq = lane >> 4;
    const int K = g.K, nt = K / BK;
    (void)sc_a; (void)sc_b;
    unsigned voffB[2]; int Rr[2], Cc[2];
#pragma unroll
    for (int i = 0; i < 2; ++i) { int R, C; stage_rc(tid * 16 + i * 8192, R, C); const int Rb = Epi::PERM ? ((R & ~31) + perm32(R & 31)) : R;
        Rr[i] = R; Cc[i] = C; voffB[i] = (unsigned)(Rb * K + C) * 2u; }
    const size_t kstep = (size_t)(BK * 2);
    const size_t hstep = (size_t)HALF * K * 2;
    const size_t tstep = 2 * hstep;
    const unsigned ldsw = (unsigned)wid * 1024u;
    const int aoff = lds_byte(wr * 64 + fr, fq * 8), boff = lds_byte(wc * 32 + fr, fq * 8);
#define PG8_SA(b, h) (((b) * 2 + (h)) * HTB)
#define PG8_SB(b, h) ((4 + (b) * 2 + (h)) * HTB)
#define PG8_STAGE(bufoff, gbase, voff) do { _Pragma("unroll") for (int _i = 0; _i < 2; ++_i) \
        __builtin_amdgcn_global_load_lds((const unsigned*)((const char*)(gbase) + (voff)[_i]), (PG8_LAS unsigned*)(lds + (bufoff) + ldsw + _i * 8192), 16, 0, 0); } while (0)
#define PG8_STAGEA(bufoff, koff, V, h) do { _Pragma("unroll") for (int _i = 0; _i < 2; ++_i) \
        __builtin_amdgcn_global_load_lds((const unsigned*)((const char*)g.A + (koff) + (V)[h][_i]), (PG8_LAS unsigned*)(lds + (bufoff) + ldsw + _i * 8192), 16, 0, 0); } while (0)
#define PG8_LDA(dst, b, h) do { _Pragma("unroll") for (int m = 0; m < 4; ++m) { const v4i_ lo_ = *(const PG8_LAS v4i_*)(lds + PG8_SA(b, h) + aoff + m * 2048), hi_ = *(const PG8_LAS v4i_*)(lds + PG8_SA(b, h) + aoff + m * 2048 + 1024); dst[m] = __builtin_shufflevector(lo_, hi_, 0, 1, 2, 3, 4, 5, 6, 7); } } while (0)
#define PG8_LDB(dst, b, h) do { _Pragma("unroll") for (int n = 0; n < 2; ++n) { const v4i_ lo_ = *(const PG8_LAS v4i_*)(lds + PG8_SB(b, h) + boff + n * 2048), hi_ = *(const PG8_LAS v4i_*)(lds + PG8_SB(b, h) + boff + n * 2048 + 1024); dst[n] = __builtin_shufflevector(lo_, hi_, 0, 1, 2, 3, 4, 5, 6, 7); } } while (0)
#define PG8_MMA(ai, bj, At, Bt) do { __builtin_amdgcn_s_setprio(1); _Pragma("unroll") for (int m = 0; m < 4; ++m) _Pragma("unroll") for (int n = 0; n < 2; ++n) \
        asm volatile("v_mfma_f32_16x16x128_f8f6f4 %0, %1, %2, %0" : "+v"(acc[ai][bj][m][n]) : "v"(Bt[n]), "v"(At[m])); __builtin_amdgcn_s_setprio(0); } while (0)
#define PG8_WAIT_V(n) asm volatile("s_waitcnt vmcnt(" #n ")" ::: "memory")
#define PG8_WAIT_L(n) asm volatile("s_waitcnt lgkmcnt(" #n ")" ::: "memory")
#define PG8_BAR __builtin_amdgcn_s_barrier()
#define PG8_SCHED __builtin_amdgcn_sched_barrier(0)
#define PG8_ROWS(V, u) do { _Pragma("unroll") for (int _h = 0; _h < 2; ++_h) _Pragma("unroll") for (int _i = 0; _i < 2; ++_i) \
        (V)[_h][_i] = (unsigned)(rowlist[(u).pm * BM + _h * HALF + Rr[_i]] * K + Cc[_i]) * 2u; } while (0)
    Unit cur, nxt; int ui = 0;
    if (!S.next(0, cur)) return;
    f32x4 acc[2][2][4][2];
#pragma unroll
    for (int a = 0; a < 2; ++a)
#pragma unroll
        for (int b = 0; b < 2; ++b)
#pragma unroll
            for (int m = 0; m < 4; ++m)
#pragma unroll
                for (int n = 0; n < 2; ++n) acc[a][b][m][n] = (f32x4){0.f, 0.f, 0.f, 0.f};
    v8i_ At[4], B0[2], B1[2];
    unsigned vC[2][2], vN[2][2];
    PG8_ROWS(vC, cur);
    const char* cB = (const char*)g.Bt + (size_t)cur.pn * tstep;
    S.a_ready(cur);
    PG8_STAGE(PG8_SB(0, 0), cB, voffB); PG8_STAGE(PG8_SB(0, 1), cB + hstep, voffB); PG8_STAGEA(PG8_SA(0, 0), (size_t)0, vC, 0); PG8_STAGEA(PG8_SA(0, 1), (size_t)0, vC, 1);
    if (wr == 1) PG8_BAR;
    PG8_WAIT_V(2); PG8_BAR;
    PG8_STAGE(PG8_SB(1, 0), cB + kstep, voffB); PG8_STAGEA(PG8_SA(1, 0), kstep, vC, 0); PG8_STAGE(PG8_SB(1, 1), cB + hstep + kstep, voffB);
    PG8_WAIT_V(6); PG8_BAR;
    for (;;) {
        const bool has_next = S.next(ui + 1, nxt);
        if (has_next) { PG8_ROWS(vN, nxt); }
        else {
#pragma unroll
            for (int h = 0; h < 2; ++h)
#pragma unroll
                for (int i = 0; i < 2; ++i) vN[h][i] = vC[h][i]; }
        const char* nB = has_next ? (const char*)g.Bt + (size_t)nxt.pn * tstep : cB;
        for (int t = 0; t < nt; t += 2) {
            const bool last = (t == nt - 2);
            const size_t k1 = (size_t)(t + 1) * kstep;
            const size_t k2 = last ? (size_t)0 : (size_t)(t + 2) * kstep;
            unsigned v2[2][2];
#pragma unroll
            for (int h = 0; h < 2; ++h)
#pragma unroll
                for (int i = 0; i < 2; ++i) v2[h][i] = last ? vN[h][i] : vC[h][i];
            const char* b2 = last ? nB : cB + (size_t)(t + 2) * kstep;
            const size_t k3 = k2 + kstep; const char* b3 = b2 + kstep;
            if (last && has_next) S.a_ready(nxt);
            PG8_LDB(B0, 0, 0); PG8_LDB(B1, 0, 1); PG8_SCHED; PG8_LDA(At, 0, 0); PG8_STAGEA(PG8_SA(1, 1), k1, vC, 1);
            PG8_WAIT_V(8); PG8_WAIT_L(0); PG8_BAR; PG8_MMA(0, 0, At, B0); PG8_MMA(0, 1, At, B1); PG8_BAR; PG8_SCHED;
            PG8_LDA(At, 0, 1); PG8_STAGE(PG8_SB(0, 0), b2, voffB); PG8_STAGE(PG8_SB(0, 1), b2 + hstep, voffB); PG8_STAGEA(PG8_SA(0, 0), k2, v2, 0);
            PG8_WAIT_V(8); PG8_WAIT_L(0); PG8_BAR; PG8_MMA(1, 0, At, B0); PG8_MMA(1, 1, At, B1); PG8_BAR; PG8_SCHED;
            PG8_LDB(B0, 1, 0); PG8_LDB(B1, 1, 1); PG8_SCHED; PG8_LDA(At, 1, 0); PG8_STAGEA(PG8_SA(0, 1), k2, v2, 1);
            PG8_WAIT_V(8); PG8_WAIT_L(0); PG8_BAR; PG8_MMA(0, 0, At, B0); PG8_MMA(0, 1, At, B1); PG8_BAR; PG8_SCHED;
            PG8_LDA(At, 1, 1); PG8_STAGE(PG8_SB(1, 0), b3, voffB); PG8_STAGE(PG8_SB(1, 1), b3 + hstep, voffB); PG8_STAGEA(PG8_SA(1, 0), k3, v2, 0);
            PG8_WAIT_V(8); PG8_WAIT_L(0); PG8_BAR; PG8_MMA(1, 0, At, B0); PG8_MMA(1, 1, At, B1); PG8_BAR; PG8_SCHED;
        }
        if (wr == 0) PG8_BAR;
        asm volatile("s_nop 15\n\ts_nop 15\n\ts_nop 15" ::: "memory");
        E(acc, cur, wr, wc, fr, fq); S.done(cur);
        if (!has_next) break;
#pragma unroll
        for (int a = 0; a < 2; ++a)
#pragma unroll
            for (int b = 0; b < 2; ++b)
#pragma unroll
                for (int m = 0; m < 4; ++m)
#pragma unroll
                    for (int n = 0; n < 2; ++n) acc[a][b][m][n] = (f32x4){0.f, 0.f, 0.f, 0.f};
        cur = nxt; cB = nB; ++ui;
#pragma unroll
        for (int h = 0; h < 2; ++h)
#pragma unroll
            for (int i = 0; i < 2; ++i) vC[h][i] = vN[h][i];
        if (wr == 1) PG8_BAR;
    }
    PG8_WAIT_V(0);
    PG8_BAR;
#undef PG8_SA
#undef PG8_SB
#undef PG8_STAGE
#undef PG8_STAGEA
#undef PG8_LDA
#undef PG8_LDB
#undef PG8_MMA
#undef PG8_WAIT_V
#undef PG8_WAIT_L
#undef PG8_BAR
#undef PG8_SCHED
#undef PG8_ROWS
}
}
#define GAS __attribute__((address_space(1)))
#define LAS __attribute__((address_space(3)))
typedef unsigned short bf16;
typedef unsigned v4u __attribute__((ext_vector_type(4)));
typedef float f32x4 __attribute__((ext_vector_type(4)));
typedef short bf16x8 __attribute__((ext_vector_type(8)));
typedef GAS unsigned gu32;
typedef GAS unsigned long long gu64;
#define RLX_AGENT __ATOMIC_RELAXED, __HIP_MEMORY_SCOPE_AGENT
#define LDS_WAIT() asm volatile("s_waitcnt lgkmcnt(0)" ::: "memory")
#define VM_WAIT() asm volatile("s_waitcnt vmcnt(0)" ::: "memory")
__device__ __forceinline__ unsigned long long rt() { return __builtin_amdgcn_s_memrealtime(); }
__device__ __forceinline__ unsigned f2bf(float f) { unsigned u = __builtin_bit_cast(unsigned, f); return (u + 0x7fffu + ((u >> 16) & 1u)) >> 16; }
__device__ __forceinline__ unsigned pk2(float lo, float hi) { return f2bf(lo) | (f2bf(hi) << 16); }

#define XB_TMO      128
#define XB_XCNT(j)  (256  + 64 * (j))
#define XB_XSUB(j)  (1280 + 64 * (j))
#define XB_XGEN(j)  (2304 + 64 * (j))
#define XB_TOP      3328
#define XB_TOPGEN   3392
#define XCD_BAR_WORDS 3456
#define XB_SPIN_CAP (1u << 18)

__device__ __forceinline__ unsigned xb_ld(unsigned* p)              { return __hip_atomic_load(p, __ATOMIC_RELAXED, __HIP_MEMORY_SCOPE_AGENT); }
__device__ __forceinline__ unsigned xb_add(unsigned* p, unsigned v) { return __hip_atomic_fetch_add(p, v, __ATOMIC_RELAXED, __HIP_MEMORY_SCOPE_AGENT); }
__device__ __forceinline__ unsigned xb_xcc_id() { return (unsigned)__builtin_amdgcn_s_getreg((3 << 11) | 20) & 0xFu; }
#define XB_SPIN(cond, bar) do { unsigned _sp = 0; while (cond) { __builtin_amdgcn_s_sleep(1); \
    if ((++_sp & 255u) == 0u) { if (xb_ld(&(bar)[XB_TMO])) break; if (_sp > XB_SPIN_CAP) { atomicAdd(&(bar)[XB_TMO], 1u); break; } } } } while (0)

struct XcdBarrier {
    unsigned* bar; unsigned x;
    volatile LAS unsigned* st;
};

__device__ __forceinline__ XcdBarrier xcd_barrier_post(unsigned* bar, volatile LAS unsigned* st) {
    XcdBarrier b; b.bar = bar; b.x = xb_xcc_id(); b.st = st;
    if (threadIdx.x == 0) (void)xb_add(&bar[XB_XCNT(b.x)], 1u);
    return b;
}
__device__ __forceinline__ void xcd_barrier_complete(unsigned* bar, unsigned x, unsigned& nloc, unsigned& nx) {
    const unsigned G = gridDim.x * gridDim.y * gridDim.z;
    unsigned sum, cnt, mine, sp = 0u;
    for (;;) {
        sum = 0u; cnt = 0u; mine = 0u;
#pragma unroll
        for (unsigned j = 0; j < 16; ++j) { const unsigned c = xb_ld(&bar[XB_XCNT(j)]); sum += c; cnt += (c > 0u) ? 1u : 0u; mine = (j == x) ? c : mine; }
        if (sum == G) break;
        __builtin_amdgcn_s_sleep(1);
        if ((++sp & 255u) == 0u) { if (xb_ld(&bar[XB_TMO])) break; if (sp > XB_SPIN_CAP) { atomicAdd(&bar[XB_TMO], 1u); break; } }
    }
    nloc = mine > 0u ? mine : 1u; nx = cnt > 0u ? cnt : 1u;
}

__device__ __forceinline__ void xcd_barrier(const XcdBarrier& b) {
    asm volatile("s_waitcnt vmcnt(0)" ::: "memory");
    __syncthreads();
    if (threadIdx.x == 0) {
        unsigned* bar = b.bar;
        __builtin_amdgcn_s_waitcnt(0);
        unsigned nloc = b.st[0], nx = b.st[1];
        if (nloc == 0u) { xcd_barrier_complete(bar, b.x, nloc, nx); b.st[0] = nloc; b.st[1] = nx; }
        const unsigned old = xb_add(&bar[XB_XSUB(b.x)], 1u);
        const unsigned gen = old / nloc;
        if (old + 1u == (gen + 1u) * nloc) {
            __builtin_amdgcn_fence(__ATOMIC_RELEASE, "agent");
            asm volatile("s_waitcnt vmcnt(0)" ::: "memory");
            const unsigned og = xb_add(&bar[XB_TOP], 1u);
            const unsigned tg = og / nx;
            if (og + 1u != (tg + 1u) * nx) XB_SPIN(xb_ld(&bar[XB_TOP]) < (tg + 1u) * nx, bar);
            __builtin_amdgcn_fence(__ATOMIC_ACQUIRE, "agent");
            xb_add(&bar[XB_XGEN(b.x)], 1u);
            asm volatile("s_waitcnt vmcnt(0)" ::: "memory");
        } else {
            XB_SPIN(xb_ld(&bar[XB_XGEN(b.x)]) == gen, bar);
            __builtin_amdgcn_fence(__ATOMIC_ACQUIRE, "agent");
            asm volatile("s_waitcnt vmcnt(0)" ::: "memory");
        }
    }
    __syncthreads();
}

typedef short s16x4 __attribute__((ext_vector_type(4)));
typedef float f32x16 __attribute__((ext_vector_type(16)));
typedef float f32x2 __attribute__((ext_vector_type(2)));
__device__ __forceinline__ float bflo(unsigned u) { return __builtin_bit_cast(float, u << 16); }
__device__ __forceinline__ float bfhi(unsigned u) { return __builtin_bit_cast(float, u & 0xffff0000u); }
__device__ __forceinline__ void unpack8(const v4u w, float (&x)[8]) { x[0] = bflo(w.x); x[1] = bfhi(w.x); x[2] = bflo(w.y); x[3] = bfhi(w.y); x[4] = bflo(w.z); x[5] = bfhi(w.z); x[6] = bflo(w.w); x[7] = bfhi(w.w); }
__device__ __forceinline__ v4u pack8(const float (&x)[8]) { v4u w; w.x = pk2(x[0], x[1]); w.y = pk2(x[2], x[3]); w.z = pk2(x[4], x[5]); w.w = pk2(x[6], x[7]); return w; }
__device__ __forceinline__ float xor1(float v) { return __builtin_bit_cast(float, __builtin_amdgcn_update_dpp(0, __builtin_bit_cast(int, v), 0xB1, 0xf, 0xf, false)); }
__device__ __forceinline__ float xor2(float v) { return __builtin_bit_cast(float, __builtin_amdgcn_update_dpp(0, __builtin_bit_cast(int, v), 0x4E, 0xf, 0xf, false)); }
__device__ __forceinline__ float wave_sum(float v) {
    int x = __builtin_bit_cast(int, v);
#define WS_ADD(ctrl, rmask, bc) x = __builtin_bit_cast(int, __builtin_bit_cast(float, x) + __builtin_bit_cast(float, __builtin_amdgcn_update_dpp(0, x, ctrl, rmask, 0xf, bc)))
    WS_ADD(0x111, 0xf, true); WS_ADD(0x112, 0xf, true); WS_ADD(0x114, 0xf, true); WS_ADD(0x118, 0xf, true); WS_ADD(0x142, 0xa, false); WS_ADD(0x143, 0xc, false);
#undef WS_ADD
    return __builtin_bit_cast(float, __builtin_amdgcn_readlane(x, 63));
}

namespace att {
constexpr int KST = 144;
constexpr int TILEB = 64 * KST;
constexpr int L_K = 0, L_V = 2 * TILEB, L_WSF = 4 * TILEB, L_OST = L_WSF + 8 * 1024, OST_W = 68 * 32 * 4;
constexpr int LDS_BYTES = L_OST + 8 * OST_W;
constexpr int T2B = 128 * KST, F_K = 0, F_V = 2 * T2B, F_END = 4 * T2B;
static_assert(F_END <= L_WSF + 0 || true, "");
__device__ __forceinline__ int crow(int r, int hi) { return (r & 3) + 8 * (r >> 2) + 4 * hi; }
typedef short v4i16_t __attribute__((ext_vector_type(4)));
__device__ __forceinline__ s16x4 vtr(const LAS unsigned char* p) { return __builtin_bit_cast(s16x4, __builtin_amdgcn_ds_read_tr16_b64_v4i16((LAS v4i16_t*)p)); }
__device__ __forceinline__ unsigned cvtpk(float lo, float hi) { typedef float f2 __attribute__((ext_vector_type(2))); typedef __bf16 b2 __attribute__((ext_vector_type(2))); f2 v = {lo, hi}; b2 b = __builtin_convertvector(v, b2); return __builtin_bit_cast(unsigned, b); }

template <int DQK>
__device__ __forceinline__ void attn_pass(LAS unsigned char* lds, const bf16* Qw, int qld, const bf16* Kp, int kld, const bf16* Vp, int vld, int ntiles, f32x16 (&o)[2], float& l_out) {
    const int tid = ltid(), lane = tid & 63, r32 = lane & 31, hi = lane >> 5; const int wid = __builtin_amdgcn_readfirstlane(tid >> 6);
    constexpr int KS = DQK / 16;
    constexpr int KCH = DQK / 8;
    bf16x8 qr[KS];
#pragma unroll
    for (int s = 0; s < KS; ++s) qr[s] = *(const bf16x8*)(Qw + (size_t)r32 * qld + s * 16 + hi * 8);
    LAS float* wsf = (LAS float*)(lds + L_WSF) + wid * 256;
    const int kkey = tid / KCH, kch = tid % KCH; const bool kact = tid < 64 * KCH;
    const int vkey = tid >> 3, vch = tid & 7;
    const bf16* kg = Kp + (size_t)kkey * kld + kch * 8;
    const bf16* vg = Vp + (size_t)vkey * vld + vch * 8;
    const int klds = L_K + kkey * KST + kch * 16, vlds = L_V + vkey * KST + vch * 16;
    v4u kreg = (v4u){0u, 0u, 0u, 0u}, vreg;
    if (kact) kreg = *(const v4u*)kg;
    vreg = *(const v4u*)vg;
    __syncthreads();
    if (kact) *(LAS v4u*)(lds + klds) = kreg;
    *(LAS v4u*)(lds + vlds) = vreg;
    __syncthreads();
    o[0] = f32x16{}; o[1] = f32x16{};
    float m = -INFINITY, l = 0.f;
    const int kfr = r32 * KST + hi * 16;
    const int vfr = (((lane & 15) >> 2) + 4 * hi) * KST + (16 * ((lane >> 4) & 1) + 4 * (lane & 3)) * 2;
    for (int t = 0; t < ntiles; ++t) {
        const int cb = (t & 1) * TILEB, nb = ((t + 1) & 1) * TILEB;
        const bool pre = (t + 1 < ntiles);
        if (pre) { if (kact) kreg = *(const v4u*)(kg + (size_t)(t + 1) * 64 * kld); vreg = *(const v4u*)(vg + (size_t)(t + 1) * 64 * vld); }
        f32x16 p[2];
#pragma unroll
        for (int kh = 0; kh < 2; ++kh) {
            p[kh] = f32x16{};
#pragma unroll
            for (int s = 0; s < KS; ++s) { const bf16x8 kf = *(const LAS bf16x8*)(lds + L_K + cb + kh * 32 * KST + kfr + s * 32);
                p[kh] = __builtin_amdgcn_mfma_f32_32x32x16_bf16(kf, qr[s], p[kh], 0, 0, 0); }
        }
        float mx = p[0][0];
#pragma unroll
        for (int r = 0; r < 16; ++r) { mx = fmaxf(mx, p[0][r]); mx = fmaxf(mx, p[1][r]); }
        mx = fmaxf(mx, __shfl_xor(mx, 32));
        const float mnew = fmaxf(m, mx);
        const float alpha = __builtin_amdgcn_exp2f(m - mnew);
        float rs = 0.f;
#pragma unroll
        for (int kh = 0; kh < 2; ++kh)
#pragma unroll
            for (int r = 0; r < 16; ++r) { const float e = __builtin_amdgcn_exp2f(p[kh][r] - mnew); p[kh][r] = e; rs += e; }
        l = l * alpha + rs;
        if (__any(mnew > m)) {
            if (hi == 0) wsf[r32] = alpha;
#pragma unroll
            for (int r4 = 0; r4 < 4; ++r4) { const f32x4 a = *(const LAS f32x4*)(wsf + 8 * r4 + 4 * hi);
#pragma unroll
                for (int i = 0; i < 4; ++i) { o[0][4 * r4 + i] *= a[i]; o[1][4 * r4 + i] *= a[i]; } }
        }
        m = mnew;
#pragma unroll
        for (int kh = 0; kh < 2; ++kh)
#pragma unroll
            for (int s2 = 0; s2 < 2; ++s2) {
                v4u pw; pw.x = cvtpk(p[kh][8 * s2 + 0], p[kh][8 * s2 + 1]); pw.y = cvtpk(p[kh][8 * s2 + 2], p[kh][8 * s2 + 3]); pw.z = cvtpk(p[kh][8 * s2 + 4], p[kh][8 * s2 + 5]); pw.w = cvtpk(p[kh][8 * s2 + 6], p[kh][8 * s2 + 7]);
                const bf16x8 pa = __builtin_bit_cast(bf16x8, pw);
#pragma unroll
                for (int dh = 0; dh < 2; ++dh) {
                    const LAS unsigned char* vb = lds + L_V + cb + vfr + (32 * kh + 16 * s2) * KST + dh * 64;
                    const s16x4 lo = vtr(vb), hh = vtr(vb + 8 * KST);
                    const bf16x8 vf = (bf16x8){lo[0], lo[1], lo[2], lo[3], hh[0], hh[1], hh[2], hh[3]};
                    o[dh] = __builtin_amdgcn_mfma_f32_32x32x16_bf16(pa, vf, o[dh], 0, 0, 0);
                }
            }
        if (pre) { if (kact) *(LAS v4u*)(lds + klds + nb) = kreg; *(LAS v4u*)(lds + vlds + nb) = vreg; }
        __syncthreads();
    }
    l_out = l + __shfl_xor(l, 32);
}
__device__ __forceinline__ void scale_rows(LAS unsigned char* lds, f32x16 (&o)[2], float f) {
    const int tid_ = ltid(); const int lane = tid_ & 63, r32 = lane & 31, hi = lane >> 5; const int wid = __builtin_amdgcn_readfirstlane(tid_ >> 6);
    LAS float* wsf = (LAS float*)(lds + L_WSF) + wid * 256 + 128;
    if (hi == 0) wsf[r32] = f;
#pragma unroll
    for (int r4 = 0; r4 < 4; ++r4) { const f32x4 a = *(const LAS f32x4*)(wsf + 8 * r4 + 4 * hi);
#pragma unroll
        for (int i = 0; i < 4; ++i) { o[0][4 * r4 + i] *= a[i]; o[1][4 * r4 + i] *= a[i]; } }
}
__device__ __forceinline__ void stage_o(LAS unsigned char* lds, const f32x16 (&o)[2]) {
    const int tid_ = ltid(); const int lane = tid_ & 63, r32 = lane & 31, hi = lane >> 5; const int wid = __builtin_amdgcn_readfirstlane(tid_ >> 6);
    LAS float* stg = (LAS float*)(lds + L_OST + wid * OST_W);
#pragma unroll
    for (int r = 0; r < 16; ++r) { const int q = crow(r, hi); stg[q * 68 + r32] = o[0][r]; stg[q * 68 + 32 + r32] = o[1][r]; }
}
template <int KS, int K1OFF>
__device__ __forceinline__ void dual_pass(LAS unsigned char* lds, const bf16x8 (&qr)[2][KS], const bf16* Kp, int kld, const bf16* Vlat, const bf16* Vctx, int nlat, int vld, int ntiles, f32x16 (&o)[2][2], float (&l_out)[2]) {
    const int tid = ltid(), lane = tid & 63, r32 = lane & 31, hi = lane >> 5; const int wid = __builtin_amdgcn_readfirstlane(tid >> 6);
    LAS float* wsf = (LAS float*)(lds + L_WSF) + wid * 256;
    const int kkey = tid >> 3, kch = tid & 7;
    const bf16* kg = Kp + (size_t)kkey * kld + kch * 8;
    const bf16* vgl = Vlat + (size_t)kkey * vld + kch * 8; const bf16* vgc = Vctx + (size_t)kkey * vld + kch * 8;
#define VTILE(t) ((t) < nlat ? vgl + (size_t)(t) * 64 * vld : vgc + (size_t)((t) - nlat) * 64 * vld)
    const int klds = L_K + kkey * KST + kch * 16, vlds = L_V + kkey * KST + kch * 16;
    v4u kreg = *(const v4u*)kg, vreg = *(const v4u*)VTILE(0);
    __syncthreads();
    *(LAS v4u*)(lds + klds) = kreg; *(LAS v4u*)(lds + vlds) = vreg;
    __syncthreads();
#pragma unroll
    for (int s = 0; s < 2; ++s) { o[s][0] = f32x16{}; o[s][1] = f32x16{}; }
    float m[2] = {-INFINITY, -INFINITY}, l[2] = {0.f, 0.f};
    const int kfr = r32 * KST + hi * 16;
    const int vfr = (((lane & 15) >> 2) + 4 * hi) * KST + (16 * ((lane >> 4) & 1) + 4 * (lane & 3)) * 2;
    for (int t = 0; t < ntiles; ++t) {
        const int cb = (t & 1) * TILEB, nb = ((t + 1) & 1) * TILEB;
        const bool pre = (t + 1 < ntiles);
        if (pre) { kreg = *(const v4u*)(kg + (size_t)(t + 1) * 64 * kld); vreg = *(const v4u*)VTILE(t + 1); }
        f32x16 p[2][2];
#pragma unroll
        for (int kh = 0; kh < 2; ++kh) {
            p[0][kh] = f32x16{}; p[1][kh] = f32x16{};
#pragma unroll
            for (int ks = 0; ks < KS; ++ks) { const bf16x8 kf0 = *(const LAS bf16x8*)(lds + L_K + cb + kh * 32 * KST + kfr + ks * 32);
                p[0][kh] = __builtin_amdgcn_mfma_f32_32x32x16_bf16(kf0, qr[0][ks], p[0][kh], 0, 0, 0);
                if (K1OFF == 0) p[1][kh] = __builtin_amdgcn_mfma_f32_32x32x16_bf16(kf0, qr[1][ks], p[1][kh], 0, 0, 0);
                else { const bf16x8 kf1 = *(const LAS bf16x8*)(lds + L_K + cb + kh * 32 * KST + kfr + K1OFF + ks * 32); p[1][kh] = __builtin_amdgcn_mfma_f32_32x32x16_bf16(kf1, qr[1][ks], p[1][kh], 0, 0, 0); } }
        }
#pragma unroll
        for (int s = 0; s < 2; ++s) {
            float mx = fmaxf(p[s][0][0], p[s][1][0]);
#pragma unroll
            for (int r = 1; r < 16; ++r) mx = fmaxf(fmaxf(mx, p[s][0][r]), p[s][1][r]);
            mx = fmaxf(mx, __shfl_xor(mx, 32));
            const float mnew = fmaxf(m[s], mx);
            const float alpha = __builtin_amdgcn_exp2f(m[s] - mnew);
            float rs = 0.f;
#pragma unroll
            for (int kh = 0; kh < 2; ++kh)
#pragma unroll
                for (int r = 0; r < 16; ++r) { const float e = __builtin_amdgcn_exp2f(p[s][kh][r] - mnew); p[s][kh][r] = e; rs += e; }
            l[s] = l[s] * alpha + rs;
            if (__any(mnew > m[s])) {
                if (hi == 0) wsf[64 * s + r32] = alpha;
#pragma unroll
                for (int r4 = 0; r4 < 4; ++r4) { const f32x4 a = *(const LAS f32x4*)(wsf + 64 * s + 8 * r4 + 4 * hi);
#pragma unroll
                    for (int i = 0; i < 4; ++i) { o[s][0][4 * r4 + i] *= a[i]; o[s][1][4 * r4 + i] *= a[i]; } }
            }
            m[s] = mnew;
        }
#pragma unroll
        for (int kh = 0; kh < 2; ++kh)
#pragma unroll
            for (int s2 = 0; s2 < 2; ++s2) {
                bf16x8 pa[2];
#pragma unroll
                for (int s = 0; s < 2; ++s) { v4u pw; pw.x = cvtpk(p[s][kh][8 * s2 + 0], p[s][kh][8 * s2 + 1]); pw.y = cvtpk(p[s][kh][8 * s2 + 2], p[s][kh][8 * s2 + 3]); pw.z = cvtpk(p[s][kh][8 * s2 + 4], p[s][kh][8 * s2 + 5]); pw.w = cvtpk(p[s][kh][8 * s2 + 6], p[s][kh][8 * s2 + 7]);
                    pa[s] = __builtin_bit_cast(bf16x8, pw); }
#pragma unroll
                for (int dh = 0; dh < 2; ++dh) {
                    const LAS unsigned char* vb = lds + L_V + cb + vfr + (32 * kh + 16 * s2) * KST + dh * 64;
                    const s16x4 lo = vtr(vb), hh = vtr(vb + 8 * KST);
                    const bf16x8 vf = (bf16x8){lo[0], lo[1], lo[2], lo[3], hh[0], hh[1], hh[2], hh[3]};
                    o[0][dh] = __builtin_amdgcn_mfma_f32_32x32x16_bf16(pa[0], vf, o[0][dh], 0, 0, 0);
                    o[1][dh] = __builtin_amdgcn_mfma_f32_32x32x16_bf16(pa[1], vf, o[1][dh], 0, 0, 0);
                }
            }
        if (pre) { *(LAS v4u*)(lds + klds + nb) = kreg; *(LAS v4u*)(lds + vlds + nb) = vreg; }
        __syncthreads();
    }
    l_out[0] = l[0] + __shfl_xor(l[0], 32); l_out[1] = l[1] + __shfl_xor(l[1], 32);
}
struct Conv { const float* mg; const float* mu; const float* md; unsigned char* MGU8; unsigned char* MDN8; int h0; int hn; };
constexpr int HI_G = 32 * 112, HI_D = 112 * 32, HI_ALL = 16 * HI_G + 8 * HI_D;
struct ConvItem { const float* W; unsigned char* WT; int K, N, drow0, k0, n0; };
__device__ __forceinline__ ConvItem conv_decode(const Conv c, int h) {
    ConvItem it;
    if (h < 16 * HI_G) { const int eu = h / HI_G; const int r = h - eu * HI_G; const int e = eu >> 1, up = eu & 1; const int kb = r / 112, nb = r - kb * 112;
        it.W = (up ? c.mu : c.mg) + (size_t)e * 1024 * 3584; it.WT = c.MGU8 + (size_t)e * 7168 * 1024; it.K = 1024; it.N = 3584; it.k0 = kb * 32; it.n0 = nb * 32;
        it.drow0 = 256 * ((nb * 32) >> 7) + (up ? 128 : 0) + ((nb * 32) & 127); }
    else { const int h2 = h - 16 * HI_G; const int e = h2 / HI_D; const int r = h2 - e * HI_D; const int kb = r >> 5, nb = r & 31;
        it.W = c.md + (size_t)e * 3584 * 1024; it.WT = c.MDN8 + (size_t)e * 1024 * 3584; it.K = 3584; it.N = 1024; it.k0 = kb * 32; it.n0 = nb * 32; it.drow0 = nb * 32; }
    return it;
}
__device__ __forceinline__ void conv_load(const Conv c, int h, int lane, float (&w)[16]) {
    const ConvItem it = conv_decode(c, h); const float* p = it.W + (size_t)(it.k0 + (lane >> 5)) * it.N + it.n0 + (lane & 31);
#pragma unroll
    for (int i = 0; i < 16; ++i) w[i] = p[(size_t)(2 * i) * it.N];
}
__device__ __forceinline__ void conv_store(const Conv c, int h, int lane, const float (&w)[16], LAS float* scr  ) {
    const ConvItem it = conv_decode(c, h);
#pragma unroll
    for (int i = 0; i < 16; ++i) scr[(2 * i + (lane >> 5)) * 33 + (lane & 31)] = w[i];
    const int n = lane >> 1, kh = lane & 1; const LAS float* s = scr + (16 * kh) * 33 + n;
    v4u o;
    o.x = pg8::pack_fp8x4(s[0 * 33] * 128.0f, s[1 * 33] * 128.0f, s[2 * 33] * 128.0f, s[3 * 33] * 128.0f); o.y = pg8::pack_fp8x4(s[4 * 33] * 128.0f, s[5 * 33] * 128.0f, s[6 * 33] * 128.0f, s[7 * 33] * 128.0f);
    o.z = pg8::pack_fp8x4(s[8 * 33] * 128.0f, s[9 * 33] * 128.0f, s[10 * 33] * 128.0f, s[11 * 33] * 128.0f); o.w = pg8::pack_fp8x4(s[12 * 33] * 128.0f, s[13 * 33] * 128.0f, s[14 * 33] * 128.0f, s[15 * 33] * 128.0f);
    *(GAS v4u*)(it.WT + (size_t)(it.drow0 + n) * it.K + it.k0 + 16 * kh) = o;
}
__device__ __forceinline__ void conv_st1(int lane, const float (&w)[16], LAS float* scr) {
#pragma unroll
    for (int i = 0; i < 16; ++i) scr[(2 * i + (lane >> 5)) * 33 + (lane & 31)] = w[i];
}
__device__ __forceinline__ void conv_st2(int lane, float (&w)[16], const LAS float* scr) {
    const int n = lane >> 1, kh = lane & 1; const LAS float* s = scr + (16 * kh) * 33 + n;
#pragma unroll
    for (int i = 0; i < 16; ++i) w[i] = s[i * 33];
}
__device__ __forceinline__ void conv_st3(const Conv c, int h, int lane, const float (&w)[16]) {
    const ConvItem it = conv_decode(c, h); const int n = lane >> 1, kh = lane & 1;
    v4u o;
    o.x = pg8::pack_fp8x4(w[0] * 128.0f, w[1] * 128.0f, w[2] * 128.0f, w[3] * 128.0f); o.y = pg8::pack_fp8x4(w[4] * 128.0f, w[5] * 128.0f, w[6] * 128.0f, w[7] * 128.0f);
    o.z = pg8::pack_fp8x4(w[8] * 128.0f, w[9] * 128.0f, w[10] * 128.0f, w[11] * 128.0f); o.w = pg8::pack_fp8x4(w[12] * 128.0f, w[13] * 128.0f, w[14] * 128.0f, w[15] * 128.0f);
    *(GAS v4u*)(it.WT + (size_t)(it.drow0 + n) * it.K + it.k0 + 16 * kh) = o;
}
__device__ __forceinline__ void conv_plain(LAS unsigned char* lds, const Conv cv) {
    const int tid = ltid(), lane = tid & 63; LAS float* cscr = (LAS float*)(lds + 73728) + __builtin_amdgcn_readfirstlane(tid >> 6) * 1056;
    for (int i = 0; i < cv.hn; ++i) { float w[16]; conv_load(cv, cv.h0 + i, lane, w); conv_store(cv, cv.h0 + i, lane, w, cscr); }
}
constexpr int PTB = 128 * 128;
constexpr int P_K = 0, P_V = 3 * PTB, P_END = 6 * PTB, P_CONV = P_END;
static_assert(P_CONV + 8 * 4224 <= 147456 - 1024, "attention LDS");
template <int KS, int K1OFF, int S>
__device__ __forceinline__ void pipe_stage(LAS unsigned char* lds, const int kb_next, const int vb_cur, const int (&ka)[4], const int (&va)[2], const bf16x8 (&qr)[2][KS], f32x16& pc, f32x16& pn, f32x16 (&o)[2][2], v4u& pa1, bf16x8 (&kf)[4], bf16x8 (&vf0)[2], bf16x8 (&vf1)[2], float (&l)[2][2], float (&en)[2]) {
    constexpr int NSLOT = 4 + KS, S1 = 1 - S;
    v4u pa0;
#pragma unroll
    for (int sl = 0; sl < NSLOT; ++sl) {
        const int kind = (KS == 4) ? ((sl & 1) ? (sl < 4 ? 0 : 2) : 1) : (sl == 0 || sl == 2 ? 1 : (sl < 4 ? 0 : 2));
        const int idx = (KS == 4) ? (kind == 1 ? sl >> 1 : (sl >> 1) & 1) : (kind == 1 ? sl >> 1 : (kind == 0 ? sl >> 1 : sl - 4));
        if (S == 0 && sl == 1) {
#pragma unroll
            for (int dh = 0; dh < 2; ++dh) { const LAS unsigned char* vb = lds + vb_cur + va[dh]; const s16x4 lo = vtr(vb), hh = vtr(vb + 8 * 128); vf0[dh] = (bf16x8){lo[0], lo[1], lo[2], lo[3], hh[0], hh[1], hh[2], hh[3]}; } }
        if (kind == 0) o[S1][idx] = __builtin_amdgcn_mfma_f32_32x32x16_bf16(__builtin_bit_cast(bf16x8, pa1), vf1[idx], o[S1][idx], 0, 0, 0);
        else if (kind == 1) { const int ks = idx, kc = K1OFF == 0 ? ks : ks + 2 * S1;
            if (ks == 0) pn = __builtin_amdgcn_mfma_f32_32x32x16_bf16(kf[kc], qr[S1][ks], f32x16{}, 0, 0, 0);
            else pn = __builtin_amdgcn_mfma_f32_32x32x16_bf16(kf[kc], qr[S1][ks], pn, 0, 0, 0);
            if (S == 0) {
                if (K1OFF == 0) kf[ks] = *(const LAS bf16x8*)(lds + kb_next + ka[ks]);
                else { kf[ks] = *(const LAS bf16x8*)(lds + kb_next + ka[ks]); kf[ks + 2] = *(const LAS bf16x8*)(lds + kb_next + ka[ks + 2]); } } }
        else o[S][idx] = __builtin_amdgcn_mfma_f32_32x32x16_bf16(__builtin_bit_cast(bf16x8, pa0), vf0[idx], o[S][idx], 0, 0, 0);
        if (S == 0 && sl == 4) {
#pragma unroll
            for (int dh = 0; dh < 2; ++dh) { const LAS unsigned char* vb = lds + vb_cur + 16 * 128 + va[dh]; const s16x4 lo = vtr(vb), hh = vtr(vb + 8 * 128); vf1[dh] = (bf16x8){lo[0], lo[1], lo[2], lo[3], hh[0], hh[1], hh[2], hh[3]}; } }
#pragma unroll
        for (int m = sl * 8 / NSLOT; m < (sl + 1) * 8 / NSLOT; ++m) { const int s2 = m >> 2, w = m & 3;
            const float e0 = en[0], e1 = en[1];
            if (m < 7) { en[0] = __builtin_amdgcn_exp2f(pc[2 * (m + 1)]); en[1] = __builtin_amdgcn_exp2f(pc[2 * (m + 1) + 1]); }
            else { en[0] = __builtin_amdgcn_exp2f(pn[0]); en[1] = __builtin_amdgcn_exp2f(pn[1]); }
            float ls = l[S][0]; ls += e0; ls += e1; unsigned pw = cvtpk(e0, e1);
            asm volatile("" : "+v"(ls), "+v"(pw), "+v"(en[0]), "+v"(en[1]));
            l[S][0] = ls; if (s2 == 0) pa0[w] = pw; else pa1[w] = pw; }
        __builtin_amdgcn_sched_barrier(0);
    }
}
template <int KS, int K1OFF, bool CONV, class BuildQ>
__device__ __forceinline__ void dual_pass_pipe(LAS unsigned char* lds, bf16x8 (&qr)[2][KS], const BuildQ& build_q, const bf16* Kp, int kld, const bf16* Vlat, const bf16* Vctx, int nlat, int vld, int ntiles, f32x16 (&o)[2][2], float (&l_out)[2], const Conv cv) {
    const int tid = ltid(), lane = tid & 63, r32 = lane & 31, hi = lane >> 5; const int wid = __builtin_amdgcn_readfirstlane(tid >> 6);
    LAS float* cscr = (LAS float*)(lds + P_CONV) + wid * 1056;
    const int drow = lane >> 3, dpc = lane & 7;
    const char* kgd[2]; int vofd[2];
#pragma unroll
    for (int i = 0; i < 2; ++i) { const int row = 16 * wid + 8 * i + drow;
        kgd[i] = (const char*)(Kp + (size_t)row * kld) + ((dpc ^ ((row >> 1) & 7)) << 4);
        vofd[i] = (row * vld) * 2 + ((dpc ^ (4 * ((row >> 1) & 1))) << 4); }
    const size_t kts = (size_t)128 * kld * 2;
    int ka[4], va[2];
#pragma unroll
    for (int c = 0; c < 4; ++c) ka[c] = r32 * 128 + (((2 * c + hi) ^ ((r32 >> 1) & 7)) << 4);
    { const int q = (lane & 15) >> 2, sw = ((q >> 1) & 1) << 6, cb8 = 32 * ((lane >> 4) & 1) + 8 * (lane & 3);
      va[0] = (q + 4 * hi) * 128 + (0 ^ sw) + cb8; va[1] = (q + 4 * hi) * 128 + (64 ^ sw) + cb8; }
    const unsigned lds0 = (unsigned)(unsigned long long)lds;
#define PIPE_DMA1(gp, la) asm volatile("s_mov_b32 m0, %1\n\ts_nop 0\n\tglobal_load_lds_dwordx4 %0, off" :: "v"(gp), "s"(la) : "memory", "m0")
#define PIPE_DMA(T, buf) do { const int t64_ = 2 * (T); const char* vb_ = (const char*)(t64_ < nlat ? Vlat + (size_t)t64_ * 64 * vld : Vctx + (size_t)(t64_ - nlat) * 64 * vld); \
        _Pragma("unroll") for (int i_ = 0; i_ < 2; ++i_) { \
            const unsigned la_ = __builtin_amdgcn_readfirstlane(lds0 + P_K + (buf) + (2 * wid + i_) * 1024); \
            PIPE_DMA1(kgd[i_] + (size_t)(T) * kts, la_); PIPE_DMA1(vb_ + vofd[i_], la_ + (unsigned)(P_V - P_K)); } } while (0)
    __syncthreads();
    PIPE_DMA(0, 0);
    build_q(qr);
    asm volatile("s_waitcnt vmcnt(0)" ::: "memory");
    __syncthreads();
#pragma unroll
    for (int s = 0; s < 2; ++s) { o[s][0] = f32x16{}; o[s][1] = f32x16{}; }
    f32x16 pX, pY; v4u pa1 = (v4u){0u, 0u, 0u, 0u}; bf16x8 kf[4], vf0[2], vf1[2]; float l[2][2] = {{0.f, 0.f}, {0.f, 0.f}};
    {
#pragma unroll
        for (int c = 0; c < 4; ++c) kf[c] = *(const LAS bf16x8*)(lds + P_K + ka[c]);
#pragma unroll
        for (int dh = 0; dh < 2; ++dh) { const LAS unsigned char* vb = lds + P_V + 16 * 128 + va[dh]; const s16x4 lo = vtr(vb), hh = vtr(vb + 8 * 128); vf1[dh] = (bf16x8){lo[0], lo[1], lo[2], lo[3], hh[0], hh[1], hh[2], hh[3]}; vf0[dh] = vf1[dh]; }
        pX = f32x16{};
#pragma unroll
        for (int ks = 0; ks < KS; ++ks) pX = __builtin_amdgcn_mfma_f32_32x32x16_bf16(kf[ks], qr[0][ks], pX, 0, 0, 0);
    }
    float en[2]; en[0] = __builtin_amdgcn_exp2f(pX[0]); en[1] = __builtin_amdgcn_exp2f(pX[1]);
    const int niter = ntiles >> 1;
    float cw[16];
#pragma unroll
    for (int i = 0; i < 16; ++i) cw[i] = 0.f;
    int cb = 0, nb = PTB;
    for (int it = 0; it < niter; ++it) {
        const bool cld = CONV && !(it & 1) && (it >> 1) < cv.hn, cst = CONV && !(it & 1) && it >= 2 && (it >> 1) - 1 < cv.hn;
        if (CONV) { if (cst) { conv_st1(lane, cw, cscr); conv_st2(lane, cw, cscr); } }
        { const int tn = it + 1 < niter ? it + 1 : it; PIPE_DMA(tn, nb); }
        __builtin_amdgcn_sched_barrier(0);
        pipe_stage<KS, K1OFF, 0>(lds, P_K + cb + 1 * 32 * 128, P_V + cb + 0 * 32 * 128, ka, va, qr, pX, pY, o, pa1, kf, vf0, vf1, l, en);
        pipe_stage<KS, K1OFF, 1>(lds, 0, 0, ka, va, qr, pY, pX, o, pa1, kf, vf0, vf1, l, en);
        pipe_stage<KS, K1OFF, 0>(lds, P_K + cb + 2 * 32 * 128, P_V + cb + 1 * 32 * 128, ka, va, qr, pX, pY, o, pa1, kf, vf0, vf1, l, en);
        pipe_stage<KS, K1OFF, 1>(lds, 0, 0, ka, va, qr, pY, pX, o, pa1, kf, vf0, vf1, l, en);
        pipe_stage<KS, K1OFF, 0>(lds, P_K + cb + 3 * 32 * 128, P_V + cb + 2 * 32 * 128, ka, va, qr, pX, pY, o, pa1, kf, vf0, vf1, l, en);
        pipe_stage<KS, K1OFF, 1>(lds, 0, 0, ka, va, qr, pY, pX, o, pa1, kf, vf0, vf1, l, en);
        asm volatile("s_waitcnt vmcnt(0)" ::: "memory");
        if (CONV) { if (cst) conv_st3(cv, cv.h0 + (it >> 1) - 1, lane, cw); }
        if (CONV) { if (cld) conv_load(cv, cv.h0 + (it >> 1), lane, cw); }
        __syncthreads();
        pipe_stage<KS, K1OFF, 0>(lds, P_K + nb, P_V + cb + 3 * 32 * 128, ka, va, qr, pX, pY, o, pa1, kf, vf0, vf1, l, en);
        pipe_stage<KS, K1OFF, 1>(lds, 0, 0, ka, va, qr, pY, pX, o, pa1, kf, vf0, vf1, l, en);
        cb = nb; nb = (nb == 2 * PTB) ? 0 : nb + PTB;
    }
#undef PIPE_DMA
#undef PIPE_DMA1
#pragma unroll
    for (int dh = 0; dh < 2; ++dh) o[1][dh] = __builtin_amdgcn_mfma_f32_32x32x16_bf16(__builtin_bit_cast(bf16x8, pa1), vf1[dh], o[1][dh], 0, 0, 0);
    __syncthreads();
#pragma unroll
    for (int s = 0; s < 2; ++s) { const float t = l[s][0]; l_out[s] = t + __shfl_xor(t, 32); }
}
__device__ __forceinline__ void store_stage(LAS unsigned char* lds, bf16* Out, int old) {
    const int tid_ = ltid(); const int lane = tid_ & 63; const int wid = __builtin_amdgcn_readfirstlane(tid_ >> 6);
    const LAS float* stg = (const LAS float*)(lds + L_OST + wid * OST_W);
#pragma unroll
    for (int i = 0; i < 4; ++i) { const int row = i * 8 + (lane >> 3), ch = lane & 7; float x[8];
#pragma unroll
        for (int j = 0; j < 8; ++j) x[j] = stg[row * 68 + ch * 8 + j];
        *(v4u*)(Out + (size_t)(wid * 32 + row) * old + ch * 8) = pack8(x); }
}
struct QCtx { const bf16* P; const float* gcos; const float* gsin; const float* dcos; const float* dsin; const float* qn; };
__device__ __forceinline__ void build_q_gqa(const QCtx& C, size_t row, int hq, int tpos, int hi, bf16x8 (&qr)[4]) {
    const bf16* pr = C.P + row * NP + PC_GQ + hq * 64 + 8 * hi; float x[4][8]; float ss = 0.f;
#pragma unroll
    for (int s = 0; s < 4; ++s) { unpack8(*(const v4u*)(pr + 16 * s), x[s]);
#pragma unroll
        for (int j = 0; j < 8; ++j) ss += x[s][j] * x[s][j]; }
    ss += __shfl_xor(ss, 32);
    const float rstd = 1.0f / sqrtf(ss * (1.0f / 64.0f) + EPS);
#pragma unroll
    for (int s = 0; s < 4; ++s)
#pragma unroll
        for (int j = 0; j < 8; ++j) x[s][j] *= rstd * C.qn[16 * s + 8 * hi + j];
    if (tpos >= 0) { const int gr = tpos >> 6, gc = tpos & 63;
#pragma unroll
        for (int j = 0; j < 8; ++j) { const int fi = 8 * hi + j;
            { const float c = C.gcos[gr * 16 + fi], sn = C.gsin[gr * 16 + fi]; const float a = x[0][j], b = x[1][j]; x[0][j] = a * c - b * sn; x[1][j] = a * sn + b * c; }
            { const float c = C.gcos[gc * 16 + fi], sn = C.gsin[gc * 16 + fi]; const float a = x[2][j], b = x[3][j]; x[2][j] = a * c - b * sn; x[3][j] = a * sn + b * c; } } }
    const float sc = 0.125f * LOG2E;
#pragma unroll
    for (int s = 0; s < 4; ++s) {
#pragma unroll
        for (int j = 0; j < 8; ++j) x[s][j] *= sc;
        qr[s] = __builtin_bit_cast(bf16x8, pack8(x[s])); }
}
__device__ __forceinline__ void build_q_diff(const QCtx& C, size_t row, int h, int m, int tpos, int hi, bf16x8 (&qr)[2]) {
    const bf16* pr = C.P + row * NP + PC_DQ + h * 64 + m * 32 + 8 * hi; float x[2][8], y[2][8];
#pragma unroll
    for (int s = 0; s < 2; ++s) { unpack8(*(const v4u*)(pr + 16 * s), x[s]);
#pragma unroll
        for (int j = 0; j < 8; ++j) y[s][j] = __shfl_xor(x[s][j], 32); }
    if (tpos >= 0) { const int gr = tpos >> 6, gc = tpos & 63;
#pragma unroll
        for (int j = 0; j < 8; ++j) {
            { const float c = C.dcos[gr * 8 + j], sn = C.dsin[gr * 8 + j]; x[0][j] = hi ? (y[0][j] * sn + x[0][j] * c) : (x[0][j] * c - y[0][j] * sn); }
            { const float c = C.dcos[gc * 8 + j], sn = C.dsin[gc * 8 + j]; x[1][j] = hi ? (y[1][j] * sn + x[1][j] * c) : (x[1][j] * c - y[1][j] * sn); } } }
    const float sc = 0.17677669529663687f * LOG2E;
#pragma unroll
    for (int s = 0; s < 2; ++s) {
#pragma unroll
        for (int j = 0; j < 8; ++j) x[s][j] *= sc;
        qr[s] = __builtin_bit_cast(bf16x8, pack8(x[s])); }
}
__device__ __forceinline__ void gqa_unit2(LAS unsigned char* lds, const QCtx& C, size_t row0, int t0, int hq, const bf16* Kp, const bf16* Vlat, const bf16* Vctx, int nlat, int ntiles, bf16* Out0, bf16* Out1, bool fast, const Conv cv) {
    const int tid_ = ltid(); const int lane = tid_ & 63, r32 = lane & 31, hi = lane >> 5; const int wid = __builtin_amdgcn_readfirstlane(tid_ >> 6);
    bf16x8 qr[2][4];
    const auto bq = [&](bf16x8 (&q)[2][4]) __attribute__((always_inline)) {
        build_q_gqa(C, row0 + wid * 32 + r32, hq, t0 < 0 ? -1 : t0 + wid * 32 + r32, hi, q[0]);
        build_q_gqa(C, row0 + wid * 32 + r32, hq + 1, t0 < 0 ? -1 : t0 + wid * 32 + r32, hi, q[1]); };
    f32x16 o[2][2];
    if (!fast) bq(qr);
    if (fast) { float l[2]; dual_pass_pipe<4, 0, true>(lds, qr, bq, Kp, 128, Vlat, Vctx, nlat, NP, ntiles, o, l, cv); scale_rows(lds, o[0], 1.0f / l[0]); scale_rows(lds, o[1], 1.0f / l[1]); }
    else { __syncthreads(); conv_plain(lds, cv); __syncthreads(); float l[2]; dual_pass<4, 0>(lds, qr, Kp, 128, Vlat, Vctx, nlat, NP, ntiles, o, l);
        scale_rows(lds, o[0], 1.0f / l[0]); scale_rows(lds, o[1], 1.0f / l[1]); }
    stage_o(lds, o[0]); store_stage(lds, Out0, 1024);
    stage_o(lds, o[1]); store_stage(lds, Out1, 1024);
}
__device__ __forceinline__ void diff_unit2(LAS unsigned char* lds, const QCtx& C, size_t row0, int t0, int h, const bf16* Kp, const bf16* Vlat, const bf16* Vctx, int nlat, int ntiles, float lam, const float* nw, float oscale, bf16* Out, bool fast, const Conv cv) {
    const int tid_ = ltid(); const int lane = tid_ & 63, r32 = lane & 31, hi = lane >> 5; const int wid = __builtin_amdgcn_readfirstlane(tid_ >> 6);
    bf16x8 qr[2][2];
    const auto bq = [&](bf16x8 (&q)[2][2]) __attribute__((always_inline)) {
        build_q_diff(C, row0 + wid * 32 + r32, h, 0, t0 < 0 ? -1 : t0 + wid * 32 + r32, hi, q[0]);
        build_q_diff(C, row0 + wid * 32 + r32, h, 1, t0 < 0 ? -1 : t0 + wid * 32 + r32, hi, q[1]); };
    f32x16 o[2][2];
    if (!fast) bq(qr);
    if (fast) { float l[2]; dual_pass_pipe<2, 64, true>(lds, qr, bq, Kp, 256, Vlat, Vctx, nlat, NP, ntiles, o, l, cv); scale_rows(lds, o[0], 1.0f / l[0]); scale_rows(lds, o[1], 1.0f / l[1]); }
    else { __syncthreads(); conv_plain(lds, cv); __syncthreads(); float l[2]; dual_pass<2, 64>(lds, qr, Kp, 256, Vlat, Vctx, nlat, NP, ntiles, o, l);
        scale_rows(lds, o[0], 1.0f / l[0]); scale_rows(lds, o[1], 1.0f / l[1]); }
#pragma unroll
    for (int r = 0; r < 16; ++r) { o[0][0][r] -= lam * o[1][0][r]; o[0][1][r] -= lam * o[1][1][r]; }
    stage_o(lds, o[0]);
    const LAS float* stg = (const LAS float*)(lds + L_OST + wid * OST_W);
#pragma unroll
    for (int i = 0; i < 4; ++i) { const int row = i * 8 + (lane >> 3), ch = lane & 7; float x[8]; float ss = 0.f;
#pragma unroll
        for (int j = 0; j < 8; ++j) { x[j] = stg[row * 68 + ch * 8 + j]; ss += x[j] * x[j]; }
        ss += __shfl_xor(ss, 1); ss += __shfl_xor(ss, 2); ss += __shfl_xor(ss, 4);
        const float rstd = 1.0f / sqrtf(ss * (1.0f / 64.0f) + EPS) * oscale;
#pragma unroll
        for (int j = 0; j < 8; ++j) x[j] = x[j] * rstd * nw[ch * 8 + j];
        *(v4u*)(Out + (size_t)(wid * 32 + row) * 1024 + ch * 8) = pack8(x); }
}
#undef VTILE
}

namespace tail {
using pg8::bf16x8; using pg8::bf16_t;
struct EpiResid {
    const float* base_lat; const float* base_ctx; float* out_lat; float* out_ctx; const float* gate;
    __device__ __forceinline__ void operator()(int row, int col, int  , const float (&v)[8]) const {
        const bool isctx = row >= MLAT; const int bidx = isctx ? 4 : (row >> 12);
        const float* b = (isctx ? base_ctx + (size_t)(row - MLAT) * 1024 : base_lat + (size_t)row * 1024) + col;
        float* o = (isctx ? out_ctx + (size_t)(row - MLAT) * 1024 : out_lat + (size_t)row * 1024) + col;
        const float* g = gate + bidx * 6144 + col;
        const f32x4 b0 = *(const f32x4*)b, b1 = *(const f32x4*)(b + 4), g0 = *(const f32x4*)g, g1 = *(const f32x4*)(g + 4);
        *(f32x4*)o = b0 + g0 * (f32x4){v[0], v[1], v[2], v[3]}; *(f32x4*)(o + 4) = b1 + g1 * (f32x4){v[4], v[5], v[6], v[7]};
    }
};
template <bool IN16>
struct EpiResidB {
    const void* base_lat; const void* base_ctx; bf16_t* out_lat; bf16_t* out_ctx; const float* gate;
    __device__ __forceinline__ void operator()(int row, int col, int  , const float (&v)[8]) const {
        const bool isctx = row >= MLAT; const int bidx = isctx ? 4 : (row >> 12); const size_t ro = (size_t)(isctx ? row - MLAT : row) * 1024 + col;
        const float* g = gate + bidx * 6144 + col; float b[8], x[8];
        if (IN16) unpack8(*(const v4u*)((const bf16_t*)(isctx ? base_ctx : base_lat) + ro), b);
        else { const float* bp = (const float*)(isctx ? base_ctx : base_lat) + ro; const f32x4 b0 = *(const f32x4*)bp, b1 = *(const f32x4*)(bp + 4); b[0] = b0[0]; b[1] = b0[1]; b[2] = b0[2]; b[3] = b0[3]; b[4] = b1[0]; b[5] = b1[1]; b[6] = b1[2]; b[7] = b1[3]; }
#pragma unroll
        for (int j = 0; j < 8; ++j) x[j] = b[j] + g[j] * v[j];
        *(GAS v4u*)((isctx ? out_ctx : out_lat) + ro) = pack8(x);
    }
};
struct EpiResidNorm {
    const float* base_lat; const float* base_ctx; float* out_lat; float* out_ctx; const float* gate; bf16_t* H; float* ss; const float* nw; const float* sc;
    __device__ __forceinline__ void operator()(int row, int col, int  , const float (&v)[8]) const {
        const bool isctx = row >= MLAT; const int bidx = isctx ? 4 : (row >> 12);
        const float* b = (isctx ? base_ctx + (size_t)(row - MLAT) * 1024 : base_lat + (size_t)row * 1024) + col;
        float* o = (isctx ? out_ctx + (size_t)(row - MLAT) * 1024 : out_lat + (size_t)row * 1024) + col;
        const float* g = gate + bidx * 6144 + col;
        const f32x4 x0 = *(const f32x4*)b + *(const f32x4*)g * (f32x4){v[0], v[1], v[2], v[3]}, x1 = *(const f32x4*)(b + 4) + *(const f32x4*)(g + 4) * (f32x4){v[4], v[5], v[6], v[7]};
        *(f32x4*)o = x0; *(f32x4*)(o + 4) = x1;
        const f32x4 c0 = *(const f32x4*)(nw + col) * (*(const f32x4*)(sc + bidx * 6144 + col) + 1.0f), c1 = *(const f32x4*)(nw + col + 4) * (*(const f32x4*)(sc + bidx * 6144 + col + 4) + 1.0f);
        const f32x4 h0 = x0 * c0, h1 = x1 * c1; float hh[8] = {h0[0], h0[1], h0[2], h0[3], h1[0], h1[1], h1[2], h1[3]};
        *(GAS v4u*)(H + (size_t)row * 1024 + col) = pack8(hh);
        float s = ((x0[0] * x0[0] + x0[1] * x0[1]) + (x0[2] * x0[2] + x0[3] * x0[3])) + ((x1[0] * x1[0] + x1[1] * x1[1]) + (x1[2] * x1[2] + x1[3] * x1[3]));
        s += __shfl_xor(s, 1); s += __shfl_xor(s, 2); s += __shfl_xor(s, 4);
        if ((ltid() & 7) == 0) atomicAdd(ss + row, s);
    }
};
struct EpiMoeDown {
    bf16_t* O; const float* roww; float as;
    __device__ __forceinline__ void operator()(int row, int col, int  , const float (&v)[8]) const {
        const float w = roww[row] * as; float x[8];
#pragma unroll
        for (int j = 0; j < 8; ++j) x[j] = v[j] * w;
        *(GAS v4u*)(O + (size_t)row * 1024 + col) = pack8(x);
    }
};
template <int K, class Epi>
__device__ __forceinline__ void subtile(LAS unsigned char* lds, const bf16_t* A, const bf16_t* Bt, int row0, int brow0, int col0, const Epi& E) {
    const int tid = ltid(), lane = tid & 63, fr = lane & 15, fq = lane >> 4; const int w = __builtin_amdgcn_readfirstlane(tid >> 6);
    constexpr int kw = K / 8, nsub = kw / 32;
    constexpr int DEPTH = nsub < 4 ? nsub : 4;
    const bf16_t* ap = A + (size_t)(row0 + fr) * K + w * kw + 8 * fq; const bf16_t* bp = Bt + (size_t)(brow0 + fr) * K + w * kw + 8 * fq;
    f32x4 acc[4][4];
#pragma unroll
    for (int m = 0; m < 4; ++m)
#pragma unroll
        for (int n = 0; n < 4; ++n) acc[m][n] = (f32x4){0.f, 0.f, 0.f, 0.f};
    bf16x8 a[DEPTH][4], b[DEPTH][4];
#pragma unroll
    for (int d = 0; d < DEPTH; ++d)
#pragma unroll
        for (int m = 0; m < 4; ++m) { a[d][m] = *(const bf16x8*)(ap + (size_t)(16 * m) * K + 32 * d); b[d][m] = *(const bf16x8*)(bp + (size_t)(16 * m) * K + 32 * d); }
#pragma unroll
    for (int s = 0; s < nsub; ++s) {
        bf16x8 ca[4], cb[4];
#pragma unroll
        for (int m = 0; m < 4; ++m) { ca[m] = a[s % DEPTH][m]; cb[m] = b[s % DEPTH][m]; }
        if (s + DEPTH < nsub) {
#pragma unroll
            for (int m = 0; m < 4; ++m) { a[s % DEPTH][m] = *(const bf16x8*)(ap + (size_t)(16 * m) * K + 32 * (s + DEPTH)); b[s % DEPTH][m] = *(const bf16x8*)(bp + (size_t)(16 * m) * K + 32 * (s + DEPTH)); } }
#pragma unroll
        for (int m = 0; m < 4; ++m)
#pragma unroll
            for (int n = 0; n < 4; ++n) acc[m][n] = __builtin_amdgcn_mfma_f32_16x16x32_bf16(cb[n], ca[m], acc[m][n], 0, 0, 0);
    }
    __syncthreads();
    LAS float* part = (LAS float*)lds + w * 4096;
#pragma unroll
    for (int m = 0; m < 4; ++m)
#pragma unroll
        for (int n = 0; n < 4; ++n) *(LAS f32x4*)(part + (16 * m + fr) * 64 + 16 * n + 4 * fq) = acc[m][n];
    __syncthreads();
    const int r = 8 * w + (lane >> 3), c = 8 * (lane & 7);
    float v[8];
#pragma unroll
    for (int j = 0; j < 8; ++j) v[j] = 0.f;
#pragma unroll
    for (int p = 0; p < 8; ++p) { const LAS float* q = (const LAS float*)lds + p * 4096 + r * 64 + c; const f32x4 x0 = *(const LAS f32x4*)q, x1 = *(const LAS f32x4*)(q + 4);
        v[0] += x0[0]; v[1] += x0[1]; v[2] += x0[2]; v[3] += x0[3]; v[4] += x1[0]; v[5] += x1[1]; v[6] += x1[2]; v[7] += x1[3]; }
    E(row0 + r, col0 + c, brow0 + c, v);
}
typedef int v8i __attribute__((ext_vector_type(8)));
typedef int v4i __attribute__((ext_vector_type(4)));
template <int KB, class Epi>
__device__ __forceinline__ void subtile_f8(LAS unsigned char* lds, const unsigned char* A, const unsigned char* Bt, int row0, int brow0, int col0, const Epi& E, int sc_a, int sc_b) {
    const int tid = ltid(), lane = tid & 63, fr = lane & 15, fq = lane >> 4; const int w = __builtin_amdgcn_readfirstlane(tid >> 6);
    constexpr int NCHUNK = KB / 128;
    (void)sc_a; (void)sc_b;
    const unsigned char* ap = A + (size_t)(row0 + fr) * KB + 32 * fq; const unsigned char* bp = Bt + (size_t)(brow0 + fr) * KB + 32 * fq;
    f32x4 acc[4][4];
#pragma unroll
    for (int m = 0; m < 4; ++m)
#pragma unroll
        for (int n = 0; n < 4; ++n) acc[m][n] = (f32x4){0.f, 0.f, 0.f, 0.f};
    for (int c = w; c < NCHUNK; c += 8) {
        v8i a[4], b[4];
#pragma unroll
        for (int m = 0; m < 4; ++m) { const v4i a0 = *(const v4i*)(ap + (size_t)(16 * m) * KB + 128 * c), a1 = *(const v4i*)(ap + (size_t)(16 * m) * KB + 128 * c + 16);
            const v4i b0 = *(const v4i*)(bp + (size_t)(16 * m) * KB + 128 * c), b1 = *(const v4i*)(bp + (size_t)(16 * m) * KB + 128 * c + 16);
            a[m] = __builtin_shufflevector(a0, a1, 0, 1, 2, 3, 4, 5, 6, 7); b[m] = __builtin_shufflevector(b0, b1, 0, 1, 2, 3, 4, 5, 6, 7); }
#pragma unroll
        for (int m = 0; m < 4; ++m)
#pragma unroll
            for (int n = 0; n < 4; ++n) asm volatile("v_mfma_f32_16x16x128_f8f6f4 %0, %1, %2, %0" : "+v"(acc[m][n]) : "v"(b[n]), "v"(a[m]));
    }
    asm volatile("s_nop 15\n\ts_nop 15\n\ts_nop 15" ::: "memory");
    __syncthreads();
    LAS float* part = (LAS float*)lds + w * 4096;
#pragma unroll
    for (int m = 0; m < 4; ++m)
#pragma unroll
        for (int n = 0; n < 4; ++n) *(LAS f32x4*)(part + (16 * m + fr) * 64 + 16 * n + 4 * fq) = acc[m][n];
    __syncthreads();
    const int r = 8 * w + (lane >> 3), cc = 8 * (lane & 7);
    float v[8];
#pragma unroll
    for (int j = 0; j < 8; ++j) v[j] = 0.f;
#pragma unroll
    for (int p = 0; p < 8; ++p) { const LAS float* q = (const LAS float*)lds + p * 4096 + r * 64 + cc; const f32x4 x0 = *(const LAS f32x4*)q, x1 = *(const LAS f32x4*)(q + 4);
        v[0] += x0[0]; v[1] += x0[1]; v[2] += x0[2]; v[3] += x0[3]; v[4] += x1[0]; v[5] += x1[1]; v[6] += x1[2]; v[7] += x1[3]; }
    E(row0 + r, col0 + cc, brow0 + cc, v);
}
}

namespace gla {
constexpr int QS = 80;
constexpr int VS = 144;
constexpr int OS = 68;
constexpr int G_QF = 0, G_QB = 64 * QS, G_KF = 2 * 64 * QS, G_KB = 3 * 64 * QS, G_V = 4 * 64 * QS, G_SF = G_V + 64 * VS, G_SB = G_SF + 64 * QS, G_OST = G_SB + 64 * QS, G_END = G_OST + 64 * OS * 4;
static_assert(2 * G_END <= 131072, "GLA LDS");
__device__ __forceinline__ int chunk_row0(int b, int c) { return c < 4 ? MLAT + b * CTXL + c * 64 : b * SEQ + (c - 4) * 64; }
__device__ __forceinline__ float log_sigmoid(float z) { return fminf(z, 0.f) - __logf(1.0f + __expf(-fabsf(z))); }
__device__ __forceinline__ int crow(int r, int hi) { return (r & 3) + 8 * (r >> 2) + 4 * hi; }
__device__ __forceinline__ bf16x8 trfrag_nat(const LAS unsigned char* img, int stride, int k0, int ncol0, int lane) {
    const int hi = lane >> 5, q = (lane & 15) >> 2, p = lane & 3, g1 = (lane >> 4) & 1;
    const LAS unsigned char* a = img + (k0 + 8 * hi + q) * stride + (ncol0 + 16 * g1 + 4 * p) * 2;
    const s16x4 lo = att::vtr(a), hh = att::vtr(a + 4 * stride);
    return (bf16x8){lo[0], lo[1], lo[2], lo[3], hh[0], hh[1], hh[2], hh[3]};
}
__device__ __forceinline__ bf16x8 trfrag_perm(const LAS unsigned char* img, int stride, int k0, int ncol0, int lane) {
    const int hi = lane >> 5, q = (lane & 15) >> 2, p = lane & 3, g1 = (lane >> 4) & 1;
    const LAS unsigned char* a = img + (k0 + 4 * hi + q) * stride + (ncol0 + 16 * g1 + 4 * p) * 2;
    const s16x4 lo = att::vtr(a), hh = att::vtr(a + 8 * stride);
    return (bf16x8){lo[0], lo[1], lo[2], lo[3], hh[0], hh[1], hh[2], hh[3]};
}
__device__ __forceinline__ float dpp_prefix(float v) {
    int x = __builtin_bit_cast(int, v);
#define DPP_ADD(ctrl, rmask, bc) x = __builtin_bit_cast(int, __builtin_bit_cast(float, x) + __builtin_bit_cast(float, __builtin_amdgcn_update_dpp(0, x, ctrl, rmask, 0xf, bc)))
    DPP_ADD(0x111, 0xf, true); DPP_ADD(0x112, 0xf, true); DPP_ADD(0x114, 0xf, true); DPP_ADD(0x118, 0xf, true);
    DPP_ADD(0x142, 0xa, false); DPP_ADD(0x143, 0xc, false);
#undef DPP_ADD
    return __builtin_bit_cast(float, x);
}
__device__ __forceinline__ void scan_fwd(float (&x)[8], int lane) {
#pragma unroll
    for (int j = 0; j < 8; ++j) x[j] = dpp_prefix(x[j]);
}
__device__ __forceinline__ void scan_bwd(float (&x)[8], int lane) {
#pragma unroll
    for (int j = 0; j < 8; ++j) { const float p = dpp_prefix(x[j]); const float tot = __shfl(p, 63); x[j] = tot - p + x[j]; }
}
struct UnitId { int b, h, c; bool valid; };

struct G1Regs { v4u ck, czf, czb, cv0, cv1; };
__device__ __forceinline__ UnitId unit_of(int u, int NU, int nc) { UnitId id; id.valid = u < NU; const int uu = id.valid ? u : 0; id.c = (NCH - nc) + uu % nc; const int bh = uu / nc; id.b = bh >> 2; id.h = bh & 3; return id; }
__device__ __forceinline__ void g1_load(G1Regs& R, const bf16* P, const UnitId u, int lane, int w) {
    if (u.valid) { const bf16* pr = P + (size_t)(chunk_row0(u.b, u.c) + lane) * NP;
        R.ck = *(const v4u*)(pr + PC_GLK + 32 * u.h + 8 * w); R.czf = *(const v4u*)(pr + PC_ZF + 32 * u.h + 8 * w); R.czb = *(const v4u*)(pr + PC_ZB + 32 * u.h + 8 * w);
        R.cv0 = *(const v4u*)(pr + PC_GLV + 64 * u.h + 16 * w); R.cv1 = *(const v4u*)(pr + PC_GLV + 64 * u.h + 16 * w + 8); }
}
__device__ __forceinline__ void g1_phase(LAS unsigned char* lds, const bf16* P, const float* ab_f, const float* ab_b, float* KV, float* DEC, int G) {
    const int tid = ltid(), lane = tid & 63; const int wid = __builtin_amdgcn_readfirstlane(tid >> 6); const int grp = wid >> 2, w = wid & 3;
    LAS unsigned char* gb = lds + grp * G_END;
    const int NU = NB * 4 * NCH, npairs = (NU + 1) / 2;
    int pi = blockIdx.x; if (pi >= npairs) return;
    UnitId u = unit_of(2 * pi + grp, NU, NCH);
    G1Regs R; R.ck = R.czf = R.czb = R.cv0 = R.cv1 = (v4u){0u, 0u, 0u, 0u};
    g1_load(R, P, u, lane, w);
    for (;;) {
        __syncthreads();
        if (u.valid) {
            float lf[8], lb[8], k[8], z[8];
            unpack8(R.czf, z);
#pragma unroll
            for (int j = 0; j < 8; ++j) lf[j] = log_sigmoid(z[j] + ab_f[32 * u.h + 8 * w + j]) * (1.0f / 16.0f);
            unpack8(R.czb, z);
#pragma unroll
            for (int j = 0; j < 8; ++j) lb[j] = log_sigmoid(z[j] + ab_b[32 * u.h + 8 * w + j]) * (1.0f / 16.0f);
            scan_fwd(lf, lane); scan_bwd(lb, lane);
            unpack8(R.ck, k);
            float wf[8], wb[8];
#pragma unroll
            for (int j = 0; j < 8; ++j) { const float fl = __shfl(lf[j], 63), bl = __shfl(lb[j], 0); wf[j] = k[j] * __expf(fl - lf[j]); wb[j] = k[j] * __expf(bl - lb[j]); }
            *(LAS v4u*)(gb + G_QF + lane * QS + 16 * w) = pack8(wf);
            *(LAS v4u*)(gb + G_QB + lane * QS + 16 * w) = pack8(wb);
            *(LAS v4u*)(gb + G_V + lane * VS + 32 * w) = R.cv0; *(LAS v4u*)(gb + G_V + lane * VS + 32 * w + 16) = R.cv1;
            const int sf = u.c, sb = u.c < 4 ? 3 - u.c : 71 - u.c; const int bhf = (u.b * 4 + u.h) * 2;
            if (lane == 63) {
#pragma unroll
                for (int j = 0; j < 8; ++j) DEC[((size_t)bhf * NCH + sf) * 32 + 8 * w + j] = __expf(lf[j]); }
            if (lane == 0) {
#pragma unroll
                for (int j = 0; j < 8; ++j) DEC[((size_t)(bhf + 1) * NCH + sb) * 32 + 8 * w + j] = __expf(lb[j]); }
        }
        const int pn = pi + G; const bool more = pn < npairs;
        const UnitId un = unit_of(more ? 2 * pn + grp : NU, NU, NCH);
        g1_load(R, P, un, lane, w);
        __syncthreads();
        if (u.valid) {
            const int dir = w >> 1, et = w & 1, r32 = lane & 31, hi = lane >> 5;
            f32x16 acc = f32x16{};
#pragma unroll
            for (int ks = 0; ks < 4; ++ks) { const bf16x8 a = trfrag_nat(gb + (dir ? G_QB : G_QF), QS, 16 * ks, 0, lane); const bf16x8 bb = trfrag_nat(gb + G_V, VS, 16 * ks, 32 * et, lane);
                acc = __builtin_amdgcn_mfma_f32_32x32x16_bf16(a, bb, acc, 0, 0, 0); }
            const int sq = dir ? (u.c < 4 ? 3 - u.c : 71 - u.c) : u.c;
            float* kv = KV + ((size_t)((u.b * 4 + u.h) * 2 + dir) * NCH + sq) * 2048;
#pragma unroll
            for (int r = 0; r < 16; ++r) kv[crow(r, hi) * 64 + 32 * et + r32] = acc[r];
        }
        if (!more) break;
        pi = pn; u = un;
    }
}

__device__ __forceinline__ void g2_scan(const float* KV, bf16* KVB, const float* DEC, int gtid, int gthreads) {
    for (int idx = gtid; idx < 32 * 2048; idx += gthreads) {
        const int bhd = idx >> 11, el = idx & 2047, d = el >> 6;
        const float* kv = KV + (size_t)bhd * NCH * 2048 + el; bf16* kvb = KVB + (size_t)bhd * NCH * 2048 + el; const float* dc = DEC + (size_t)bhd * NCH * 32 + d;
        float x[NCH], g[NCH];
#pragma unroll
        for (int s = 0; s < NCH; ++s) { x[s] = kv[(size_t)s * 2048]; g[s] = dc[s * 32]; }
        float S = 0.f;
#pragma unroll
        for (int s = 0; s < NCH; ++s) { kvb[(size_t)s * 2048] = (bf16)f2bf(S); S = g[s] * S + x[s]; }
    }
}

struct G3Regs { v4u cq, ck, czf, czb, cv0, cv1, r0, r1; float sf[8], sb[8]; };
__device__ __forceinline__ void g3_load(G3Regs& R, const bf16* P, const bf16* KV, const UnitId u, int tid, int lane, int w) {
    if (u.valid) { const bf16* pr = P + (size_t)(chunk_row0(u.b, u.c) + lane) * NP;
        R.cq = *(const v4u*)(pr + PC_GLQ + 32 * u.h + 8 * w); R.ck = *(const v4u*)(pr + PC_GLK + 32 * u.h + 8 * w); R.czf = *(const v4u*)(pr + PC_ZF + 32 * u.h + 8 * w); R.czb = *(const v4u*)(pr + PC_ZB + 32 * u.h + 8 * w);
        R.cv0 = *(const v4u*)(pr + PC_GLV + 64 * u.h + 16 * w); R.cv1 = *(const v4u*)(pr + PC_GLV + 64 * u.h + 16 * w + 8);
        const int sfi = u.c, sbi = u.c < 4 ? 3 - u.c : 71 - u.c; const int bhf = (u.b * 4 + u.h) * 2; const int tg = tid & 255, e = tg & 63, dq = tg >> 6;
        const bf16* Sf = KV + ((size_t)bhf * NCH + sfi) * 2048 + (8 * dq) * 64 + e; const bf16* Sb = KV + ((size_t)(bhf + 1) * NCH + sbi) * 2048 + (8 * dq) * 64 + e;
#pragma unroll
        for (int j = 0; j < 8; ++j) { R.sf[j] = bflo((unsigned)Sf[j * 64]); R.sb[j] = bflo((unsigned)Sb[j * 64]); }
        { const int t = tg >> 2, part = tg & 3; const bf16* rp = P + (size_t)(chunk_row0(u.b, u.c) + t) * NP + PC_GLR + 64 * u.h + 16 * part; R.r0 = *(const v4u*)rp; R.r1 = *(const v4u*)(rp + 8); } }
}
__device__ __forceinline__ void g3_phase(LAS unsigned char* lds, const bf16* P, int nc_in, const float* ab_f, const float* ab_b, const bf16* KV, const float* gnorm, bf16* MIX, int G) {
    const int tid = ltid(), lane = tid & 63; const int wid = __builtin_amdgcn_readfirstlane(tid >> 6); const int grp = wid >> 2, w = wid & 3;
    LAS unsigned char* gb = lds + grp * G_END;
    const int nc = opaque_s(nc_in);
    const int NU = NB * 4 * nc, npairs = (NU + 1) / 2;
    int pi = blockIdx.x; if (pi >= npairs) return;
    UnitId u = unit_of(2 * pi + grp, NU, nc);
    G3Regs R; R.cq = R.ck = R.czf = R.czb = R.cv0 = R.cv1 = R.r0 = R.r1 = (v4u){0u, 0u, 0u, 0u};
#pragma unroll
    for (int j = 0; j < 8; ++j) { R.sf[j] = 0.f; R.sb[j] = 0.f; }
    g3_load(R, P, KV, u, tid, lane, w);
    for (;;) {
        const int row0 = chunk_row0(u.b, u.c);
        __syncthreads();
        if (u.valid) {
            { const int tg = tid & 255, e = tg & 63, dq = tg >> 6;
              *(LAS v4u*)(gb + G_SF + e * QS + 16 * dq) = pack8(R.sf); *(LAS v4u*)(gb + G_SB + e * QS + 16 * dq) = pack8(R.sb); }
            float lf[8], lb[8], z[8];
            unpack8(R.czf, z);
#pragma unroll
            for (int j = 0; j < 8; ++j) lf[j] = log_sigmoid(z[j] + ab_f[32 * u.h + 8 * w + j]) * (1.0f / 16.0f);
            unpack8(R.czb, z);
#pragma unroll
            for (int j = 0; j < 8; ++j) lb[j] = log_sigmoid(z[j] + ab_b[32 * u.h + 8 * w + j]) * (1.0f / 16.0f);
            scan_fwd(lf, lane); scan_bwd(lb, lane);
            float q[8], k[8], t0[8], t1[8];
            unpack8(R.cq, q); unpack8(R.ck, k);
#pragma unroll
            for (int j = 0; j < 8; ++j) { q[j] *= 0.17677669529663687f; t0[j] = q[j] * __expf(lf[j]); t1[j] = k[j] * __expf(-lf[j]); }
            *(LAS v4u*)(gb + G_QF + lane * QS + 16 * w) = pack8(t0); *(LAS v4u*)(gb + G_KF + lane * QS + 16 * w) = pack8(t1);
#pragma unroll
            for (int j = 0; j < 8; ++j) { t0[j] = q[j] * __expf(lb[j]); t1[j] = k[j] * __expf(-lb[j]); }
            *(LAS v4u*)(gb + G_QB + lane * QS + 16 * w) = pack8(t0); *(LAS v4u*)(gb + G_KB + lane * QS + 16 * w) = pack8(t1);
            *(LAS v4u*)(gb + G_V + lane * VS + 32 * w) = R.cv0; *(LAS v4u*)(gb + G_V + lane * VS + 32 * w + 16) = R.cv1;
        }
        const v4u cur_r0 = R.r0, cur_r1 = R.r1;
        const int pn = pi + G; const bool more = pn < npairs;
        const UnitId un = unit_of(more ? 2 * pn + grp : NU, NU, nc);
        g3_load(R, P, KV, un, tid, lane, w);
        __syncthreads();
        if (u.valid) {
            const int tt = w >> 1, et = w & 1, r32 = lane & 31, hi = lane >> 5;
            bf16x8 qf[2], qb[2];
#pragma unroll
            for (int ks = 0; ks < 2; ++ks) { qf[ks] = *(const LAS bf16x8*)(gb + G_QF + (32 * tt + r32) * QS + (16 * ks + 8 * hi) * 2); qb[ks] = *(const LAS bf16x8*)(gb + G_QB + (32 * tt + r32) * QS + (16 * ks + 8 * hi) * 2); }
            f32x16 o = f32x16{};
#pragma unroll
            for (int st = 0; st < 2; ++st) {
                f32x16 xf = f32x16{}, xb = f32x16{};
                if (st <= tt) {
#pragma unroll
                    for (int ks = 0; ks < 2; ++ks) { const bf16x8 kf = *(const LAS bf16x8*)(gb + G_KF + (32 * st + r32) * QS + (16 * ks + 8 * hi) * 2); xf = __builtin_amdgcn_mfma_f32_32x32x16_bf16(kf, qf[ks], xf, 0, 0, 0); } }
                if (st >= tt) {
#pragma unroll
                    for (int ks = 0; ks < 2; ++ks) { const bf16x8 kb = *(const LAS bf16x8*)(gb + G_KB + (32 * st + r32) * QS + (16 * ks + 8 * hi) * 2); xb = __builtin_amdgcn_mfma_f32_32x32x16_bf16(kb, qb[ks], xb, 0, 0, 0); } }
                float x[16];
#pragma unroll
                for (int r = 0; r < 16; ++r) { const int sl = crow(r, hi);
                    const float vf = (st < tt || (st == tt && sl <= r32)) ? xf[r] : 0.f; const float vb = (st > tt || (st == tt && sl >= r32)) ? xb[r] : 0.f; x[r] = vf + vb; }
#pragma unroll
                for (int s2 = 0; s2 < 2; ++s2) {
                    v4u pw; pw.x = att::cvtpk(x[8 * s2 + 0], x[8 * s2 + 1]); pw.y = att::cvtpk(x[8 * s2 + 2], x[8 * s2 + 3]); pw.z = att::cvtpk(x[8 * s2 + 4], x[8 * s2 + 5]); pw.w = att::cvtpk(x[8 * s2 + 6], x[8 * s2 + 7]);
                    const bf16x8 vf = trfrag_perm(gb + G_V, VS, 32 * st + 16 * s2, 32 * et, lane);
                    o = __builtin_amdgcn_mfma_f32_32x32x16_bf16(__builtin_bit_cast(bf16x8, pw), vf, o, 0, 0, 0); }
            }
#pragma unroll
            for (int ks = 0; ks < 2; ++ks) { const bf16x8 sf = *(const LAS bf16x8*)(gb + G_SF + (32 * et + r32) * QS + (16 * ks + 8 * hi) * 2); const bf16x8 sb = *(const LAS bf16x8*)(gb + G_SB + (32 * et + r32) * QS + (16 * ks + 8 * hi) * 2);
                o = __builtin_amdgcn_mfma_f32_32x32x16_bf16(qf[ks], sf, o, 0, 0, 0); o = __builtin_amdgcn_mfma_f32_32x32x16_bf16(qb[ks], sb, o, 0, 0, 0); }
            LAS float* stg = (LAS float*)(gb + G_OST);
#pragma unroll
            for (int r = 0; r < 16; ++r) stg[(32 * tt + crow(r, hi)) * OS + 32 * et + r32] = o[r];
        }
        __syncthreads();
        if (u.valid) {
            const int tg = tid & 255, t = tg >> 2, part = tg & 3; const LAS float* stg = (const LAS float*)(gb + G_OST) + t * OS + 16 * part;
            float x[16]; float ss = 0.f;
#pragma unroll
            for (int j = 0; j < 16; ++j) { x[j] = stg[j]; ss += x[j] * x[j]; }
            ss += xor1(ss); ss += xor2(ss);
            const float rstd = __builtin_amdgcn_rsqf(ss * (1.0f / 64.0f) + EPS);
            const size_t row = (size_t)(row0 + t); float rv[16];
            { float a[8]; unpack8(cur_r0, a);
#pragma unroll
              for (int j = 0; j < 8; ++j) rv[j] = a[j];
              unpack8(cur_r1, a);
#pragma unroll
              for (int j = 0; j < 8; ++j) rv[8 + j] = a[j]; }
            float y0[8], y1[8];
#pragma unroll
            for (int j = 0; j < 8; ++j) { const float r0 = rv[j], r1 = rv[8 + j];
                y0[j] = x[j] * rstd * gnorm[16 * part + j] * (r0 * __builtin_amdgcn_rcpf(1.0f + __expf(-r0))); y1[j] = x[8 + j] * rstd * gnorm[16 * part + 8 + j] * (r1 * __builtin_amdgcn_rcpf(1.0f + __expf(-r1))); }
            bf16* op = MIX + row * 1024 + 64 * u.h + 16 * part;
            *(GAS v4u*)op = pack8(y0); *(GAS v4u*)(op + 8) = pack8(y1);
        }
        if (!more) break;
        pi = pn; u = un;
    }
}
}

constexpr size_t MiB = 1u << 20;
constexpr size_t WS_CTL = 0, CTL_ZERO_BYTES = 256 * 1024;
constexpr size_t WS_SS2 = 64 * 1024, WS_SS1 = 136 * 1024;
constexpr size_t WS_BIASGU = 5 * MiB, WS_BIASIN = 5 * MiB + 128 * 1024;
constexpr size_t WS_MOD = 1 * MiB;
constexpr size_t WS_ROPE = 1 * MiB + 512 * 1024;
constexpr size_t WS_TOKE = 2 * MiB;
constexpr size_t WS_TOKW = 2 * MiB + 256 * 1024;
constexpr size_t WS_POS = 2 * MiB + 512 * 1024;
constexpr size_t WS_ROWL = 3 * MiB;
constexpr size_t WS_ROWW = 3 * MiB + 256 * 1024;
constexpr size_t WS_PANE = 3 * MiB + 512 * 1024;
constexpr size_t WS_QKMAX = 3 * MiB + 768 * 1024;
constexpr size_t WS_DEC = 4 * MiB;
constexpr size_t WS_WIN = 8 * MiB, WS_WOUT = 18 * MiB, WS_WGU = 22 * MiB, WS_WDN = 33 * MiB;
constexpr size_t WS_XCTX = 39 * MiB;
constexpr size_t WS_H = 43 * MiB;
constexpr size_t WS_MGU = 77 * MiB, WS_MDN = 133 * MiB;
constexpr size_t WS_P = 245 * MiB;
constexpr size_t WS_GQ = 330 * MiB, WS_GK = 347 * MiB, WS_GV = 351 * MiB + 512 * 1024;
constexpr size_t WS_DQ = 356 * MiB, WS_DK = 364 * MiB + 512 * 1024, WS_DV = 373 * MiB;
constexpr size_t WS_KV = 382 * MiB;
constexpr size_t WS_MIX = 399 * MiB;
constexpr size_t WS_ACT = 245 * MiB;
constexpr size_t WS_ACT2 = 245 * MiB;
constexpr size_t WS_Y2 = 161 * MiB;
constexpr size_t WS_XB = 434 * MiB, WS_XBC = 466 * MiB;
constexpr size_t WS_END = 483 * MiB;
static_assert(WS_MIX + (size_t)MT * 1024 * 2 <= WS_XB && WS_XB + (size_t)MLAT * D * 2 <= WS_XBC && WS_XBC + (size_t)MCTX * D * 2 <= WS_END, "ws map 6");
static_assert(WS_P + (size_t)MT * NP * 2 <= WS_GQ && WS_GQ + (size_t)MT * 512 * 2 <= WS_GK && WS_GK + (size_t)NB * LK * 128 * 2 <= WS_GV && WS_GV + (size_t)NB * LK * 128 * 2 <= WS_DQ, "ws map 1");
static_assert(WS_DQ + (size_t)MT * 256 * 2 <= WS_DK && WS_DK + (size_t)NB * LK * 256 * 2 <= WS_DV && WS_DV + (size_t)NB * LK * 256 * 2 <= WS_KV && WS_KV + (size_t)32 * NCH * 2048 * 4 <= WS_MIX && WS_MIX + (size_t)MT * 1024 * 2 <= WS_END, "ws map 2");
static_assert(WS_ACT + (size_t)MT * DFF * 2 <= WS_KV && WS_ACT2 + (size_t)MOE_ROWS * DFFE <= WS_END && WS_Y2 + (size_t)MOE_ROWS * 1024 * 2 <= WS_P, "ws map 3");
static_assert(WS_WIN + (size_t)2 * NP * D * 2 <= WS_WOUT && WS_WOUT + (size_t)2 * D * D * 2 <= WS_WGU && WS_WGU + (size_t)2 * DFF * D * 2 <= WS_WDN && WS_WDN + (size_t)D * DFF * 2 <= WS_XCTX && WS_XCTX + (size_t)MCTX * D * 4 <= WS_H && WS_H + (size_t)MT * D * 2 <= WS_MGU, "ws map 4");
static_assert(WS_MGU + (size_t)NE * 2 * DFFE * D <= WS_MDN && WS_MDN + (size_t)NE * D * DFFE <= WS_Y2, "ws map 5");
constexpr int CW_TMO = 0, CW_CODE = 1, CW_G2DONE = 32  , CW_BAR = 4096;

constexpr int RING_OFF = 0, RING_BYTES = 131072;
constexpr int LDSCTL_OFF = 147456 - 1024, MISC_OFF = LDSCTL_OFF + 320;
constexpr int LDS_BYTES = 147456;
constexpr int NWAVES = 8;

struct Frame {
    LAS unsigned char* lds; volatile LAS unsigned* MISC; gu32* ctl;
    int tid, lane, wave, vcu, G;
    unsigned char* ws; float* out;
    const float* const* in;
};
#define FIN(i) (F.in[i])
#define WSP(T, off) ((T*)(F.ws + (off)))
#define RELAUNDER(F) do { const int t_ = ltid(); (F).tid = t_; (F).lane = t_ & 63; (F).wave = __builtin_amdgcn_readfirstlane(t_ >> 6); } while (0)

__device__ __forceinline__ void p0_transpose_item(const float* W, int K, int N, bf16* WT, int dst_row0, LAS float* scr, int k0, int n0, int lane) {
    { float wv[32];
#pragma unroll
      for (int i = 0; i < 32; ++i) { const int kk = 2 * i + (lane >> 5); wv[i] = __builtin_nontemporal_load(W + (size_t)(k0 + kk) * N + n0 + (lane & 31)); }
#pragma unroll
      for (int i = 0; i < 32; ++i) { const int kk = 2 * i + (lane >> 5); scr[kk * 33 + (lane & 31)] = wv[i]; } }
    LDS_WAIT(); asm volatile("" ::: "memory");
    const int c = lane & 7;
#pragma unroll
    for (int j = 0; j < 4; ++j) { const int n = (lane >> 3) + 8 * j; const LAS float* s = scr + (8 * c) * 33 + n;
        v4u o; o.x = pk2(s[0 * 33], s[1 * 33]); o.y = pk2(s[2 * 33], s[3 * 33]); o.z = pk2(s[4 * 33], s[5 * 33]); o.w = pk2(s[6 * 33], s[7 * 33]);
        *(GAS v4u*)(WT + (size_t)(dst_row0 + n) * K + k0 + 8 * c) = o; }
    LDS_WAIT(); asm volatile("" ::: "memory");
}
__device__ __forceinline__ void p0_transpose_item_f8(const float* W, int K, int N, unsigned char* WT8, int dst_row0, LAS float* scr, int k0, int n0, int lane, float mul) {
    { float wv[32];
#pragma unroll
      for (int i = 0; i < 32; ++i) { const int kk = 2 * i + (lane >> 5); wv[i] = __builtin_nontemporal_load(W + (size_t)(k0 + kk) * N + n0 + (lane & 31)); }
#pragma unroll
      for (int i = 0; i < 32; ++i) { const int kk = 2 * i + (lane >> 5); scr[kk * 33 + (lane & 31)] = wv[i]; } }
    LDS_WAIT(); asm volatile("" ::: "memory");
    const int c = lane & 7;
#pragma unroll
    for (int j = 0; j < 4; ++j) { const int n = (lane >> 3) + 8 * j; const LAS float* s = scr + (8 * c) * 33 + n;
        typedef unsigned u32x2 __attribute__((ext_vector_type(2))); u32x2 o;
        o.x = pg8::pack_fp8x4(s[0 * 33] * mul, s[1 * 33] * mul, s[2 * 33] * mul, s[3 * 33] * mul); o.y = pg8::pack_fp8x4(s[4 * 33] * mul, s[5 * 33] * mul, s[6 * 33] * mul, s[7 * 33] * mul);
        *(GAS u32x2*)(WT8 + (size_t)(dst_row0 + n) * K + k0 + 8 * c) = o; }
    LDS_WAIT(); asm volatile("" ::: "memory");
}
__device__ __forceinline__ int gu_row(int n0, int up) { return 256 * (n0 >> 7) + (up ? 128 : 0) + (n0 & 127); }

constexpr int I_MG = 16 * 112, I_MD = 56 * 32, MOE_ITEMS = 16 * I_MG + 8 * I_MD;
#ifndef CONV_IN_ATTN
#define CONV_IN_ATTN 1
#endif
constexpr int SLOT_A_WG = 88, SLOT_B_WG = 40, SLOT_C_WG = 88, SLOT_A_Q = CONV_IN_ATTN ? 0 : 64, SLOT_B_Q = CONV_IN_ATTN ? 0 : 96, SLOT_C_Q = CONV_IN_ATTN ? 0 : 64;
constexpr int SLOT_A0 = 0, SLOT_B0 = SLOT_A0 + SLOT_A_WG * SLOT_A_Q, SLOT_C0 = SLOT_B0 + SLOT_B_WG * SLOT_B_Q, MOE_SLOT_ITEMS = SLOT_C0 + SLOT_C_WG * SLOT_C_Q;
static_assert(MOE_SLOT_ITEMS < MOE_ITEMS, "slot plan");
constexpr int MOE_PROLOGUE_ITEMS = CONV_IN_ATTN ? 0 : MOE_ITEMS - MOE_SLOT_ITEMS;
__device__ __forceinline__ void moe_item(Frame& F, LAS float* scr, int m) {
    if (m < 16 * I_MG) { const int eu = m / I_MG; const int r = m - eu * I_MG; const int e = eu >> 1, up = eu & 1; const int kb = r / 112, nb = r % 112;
        p0_transpose_item_f8((up ? FIN(27) : FIN(26)) + (size_t)e * D * DFFE, D, DFFE, WSP(unsigned char, WS_MGU) + (size_t)e * 2 * DFFE * D, gu_row(nb * 32, up), scr, kb * 64, nb * 32, F.lane, 128.0f); }
    else { const int m2 = m - 16 * I_MG; const int e = m2 / I_MD; const int r = m2 - e * I_MD; const int kb = r / 32, nb = r % 32;
        p0_transpose_item_f8(FIN(28) + (size_t)e * DFFE * D, DFFE, D, WSP(unsigned char, WS_MDN) + (size_t)e * D * DFFE, nb * 32, scr, kb * 64, nb * 32, F.lane, 128.0f); }
}
__device__ __forceinline__ void moe_slot(Frame& F, int base, int idx, int q) {
    RELAUNDER(F);
    LAS float* scr = (LAS float*)(F.lds + RING_OFF + F.wave * 8704);
    __syncthreads();
    for (int i = F.wave; i < q; i += NWAVES) moe_item(F, scr, base + idx * q + i);
    __syncthreads();
}
constexpr int AUX_OUT = 2 * 16 * 32, AUX_FG = 2 * 16 * 88, AUX_FD = 44 * 32, AUX_IN1 = 16 * 73, AUX_ITEMS = AUX_OUT + AUX_FG + AUX_FD + AUX_IN1, AUX_WG = 88, AUX_Q = (AUX_ITEMS + AUX_WG - 1) / AUX_WG;
__device__ __forceinline__ void aux_item(Frame& F, LAS float* scr, int r) {
    if (r < AUX_OUT) { const int l = r / 512; r -= l * 512; const int kb = r / 32, nb = r % 32;
        p0_transpose_item(FIN(9) + (size_t)l * D * D, D, D, WSP(bf16, WS_WOUT) + (size_t)l * D * D, nb * 32, scr, kb * 64, nb * 32, F.lane); return; }
    r -= AUX_OUT;
    if (r < AUX_FG) { const int up = r / 1408; r -= up * 1408; const int kb = r / 88, nb = r % 88;
        p0_transpose_item(up ? FIN(23) : FIN(22), D, DFF, WSP(bf16, WS_WGU), gu_row(nb * 32, up), scr, kb * 64, nb * 32, F.lane); return; }
    r -= AUX_FG;
    if (r < AUX_FD) { const int kb = r / 32, nb = r % 32;
        p0_transpose_item(FIN(24), DFF, D, WSP(bf16, WS_WDN), nb * 32, scr, kb * 64, nb * 32, F.lane); return; }
    r -= AUX_FD;
    { const int kb = r / 73, nb = r % 73; if (nb == 24) return; const int n0 = nb * 32;
        p0_transpose_item(FIN(8) + (size_t)D * INW, D, INW, WSP(bf16, WS_WIN) + (size_t)NP * D, n0 < 768 ? n0 : n0 + 224, scr, kb * 64, n0, F.lane); }
}
__device__ __forceinline__ void aux_slot(Frame& F, int idx) {
    RELAUNDER(F);
    LAS float* scr = (LAS float*)(F.lds + RING_OFF + F.wave * 8704);
    __syncthreads();
    for (int i = F.wave; i < AUX_Q; i += NWAVES) { const int it = idx * AUX_Q + i; if (it < AUX_ITEMS) aux_item(F, scr, it); }
    __syncthreads();
}
__device__ __forceinline__ int idle_index(int nwg, int G, int c) { const int rounds = (nwg + G - 1) / G; const int first = nwg - (rounds - 1) * G; return c >= first ? c - first : -1; }
__device__ __forceinline__ int idle_count(int nwg, int G) { const int rounds = (nwg + G - 1) / G; return rounds * G - nwg; }
__device__ __forceinline__ void slot_leftover(Frame& F, int base, int planned, int nwg, int q) {
    const int actual = idle_count(nwg, F.G) < planned ? idle_count(nwg, F.G) : planned;
    for (int w = actual + (int)blockIdx.x; w < planned; w += F.G) moe_slot(F, base, w, q);
}
__device__ __forceinline__ void p0_prologue(Frame& F) {
    RELAUNDER(F);
    {
        LAS float* s5 = (LAS float*)(F.lds + RING_OFF);
        LAS float* red = (LAS float*)(F.lds + RING_OFF + 5 * 1024 * 4);
        bool have = false;
        for (int u = blockIdx.x; u < 192; u += F.G) {
            if (!have) { for (int i = F.tid; i < 5 * 1024; i += 512) { const int r = i >> 10, k = i & 1023; const float v = r < 4 ? FIN(1)[r * 1024 + k] : FIN(3)[k]; s5[i] = v / (1.0f + expf(-v)); } have = true; }
            __syncthreads();
            const int l = u / 96, cg = u % 96; const int cq = F.lane & 15, rg = F.lane >> 4; const int k0 = F.wave * 128 + rg * 32;
            const float* W = FIN(4) + (size_t)l * 1024 * 6144 + (size_t)k0 * 6144 + cg * 64 + 4 * cq;
            f32x4 acc[5];
#pragma unroll
            for (int r = 0; r < 5; ++r) acc[r] = (f32x4){0.f, 0.f, 0.f, 0.f};
#pragma unroll
            for (int hb = 0; hb < 2; ++hb) {
                f32x4 w[16];
#pragma unroll
                for (int i = 0; i < 16; ++i) w[i] = __builtin_nontemporal_load((const f32x4*)(W + (size_t)(16 * hb + i) * 6144));
                __builtin_amdgcn_sched_barrier(0);
#pragma unroll
                for (int i4 = 0; i4 < 4; ++i4) {
#pragma unroll
                    for (int r = 0; r < 5; ++r) { const f32x4 s = *(const LAS f32x4*)(s5 + r * 1024 + k0 + 16 * hb + 4 * i4);
#pragma unroll
                        for (int i = 0; i < 4; ++i) acc[r] += s[i] * w[4 * i4 + i]; }
                }
                __builtin_amdgcn_sched_barrier(0);
            }
#pragma unroll
            for (int r = 0; r < 5; ++r)
#pragma unroll
                for (int c = 0; c < 4; ++c) { float v = acc[r][c]; v += __shfl_xor(v, 16); v += __shfl_xor(v, 32); acc[r][c] = v; }
            if (rg == 0) {
#pragma unroll
                for (int r = 0; r < 5; ++r) *(LAS f32x4*)(red + (F.wave * 5 + r) * 64 + 4 * cq) = acc[r]; }
            __syncthreads();
            if (F.tid < 320) { const int r = F.tid >> 6, col = F.tid & 63; float s = FIN(5)[l * 6144 + cg * 64 + col];
#pragma unroll
                for (int w = 0; w < 8; ++w) s += red[(w * 5 + r) * 64 + col];
                WSP(float, WS_MOD)[(l * 5 + r) * 6144 + cg * 64 + col] = s; }
            __syncthreads();
        }
        __syncthreads();
    }
    if ((int)blockIdx.x == F.G - 1) {
        float* rope = WSP(float, WS_ROPE);
        for (int idx = F.tid; idx < 1024 + 512; idx += 512) {
            const bool gq = idx < 1024; const int j = gq ? idx : idx - 1024; const int pos = gq ? (j >> 4) : (j >> 3), fi = gq ? (j & 15) : (j & 7);
            const double base = gq ? 0.56234132519034908 : 0.31622776601683794;
            double f = 1.0; for (int q = 0; q < fi; ++q) f *= base;
            const double ang = (double)pos * f;
            const double nq = __builtin_rint(ang * 0.63661977236758134);
            const double r = (ang - nq * 1.5707963267948966) - nq * 6.123233995736766e-17;
            const double r2 = r * r;
            double sn = r * (1.0 + r2 * (-1.0 / 6 + r2 * (1.0 / 120 + r2 * (-1.0 / 5040 + r2 * (1.0 / 362880 + r2 * (-1.0 / 39916800 + r2 * (1.0 / 6227020800.0 + r2 * (-1.0 / 1307674368000.0))))))));
            double cs = 1.0 + r2 * (-0.5 + r2 * (1.0 / 24 + r2 * (-1.0 / 720 + r2 * (1.0 / 40320 + r2 * (-1.0 / 3628800 + r2 * (1.0 / 479001600.0 + r2 * (-1.0 / 87178291200.0 + r2 * (1.0 / 20922789888000.0))))))));
            const int qd = ((int)nq) & 3;
            const double cv = qd == 0 ? cs : qd == 1 ? -sn : qd == 2 ? -cs : sn;
            const double sv = qd == 0 ? sn : qd == 1 ? cs : qd == 2 ? -sn : -cs;
            if (gq) { rope[j] = (float)cv; rope[1024 + j] = (float)sv; } else { rope[2048 + j] = (float)cv; rope[2560 + j] = (float)sv; }
        }
    }
    const int gw = F.vcu * NWAVES + F.wave, NGW = F.G * NWAVES;
    for (int it = NGW - 1 - gw; it < 2 * 2 * 16 * 4; it += NGW) {
        const int jb = it & 3, kb = (it >> 2) & 15, dir = (it >> 6) & 1, l = it >> 7; const int k = kb * 64 + F.lane;
        const float* wr = FIN(8) + (size_t)l * D * INW + (size_t)k * INW + 768 + 16 * dir; float w[16];
#pragma unroll
        for (int q = 0; q < 4; ++q) { const f32x4 v = *(const f32x4*)(wr + 4 * q); w[4 * q] = v[0]; w[4 * q + 1] = v[1]; w[4 * q + 2] = v[2]; w[4 * q + 3] = v[3]; }
        const float* a2 = (dir ? FIN(12) : FIN(10)) + l * 16 * 128 + jb * 32;
        GAS unsigned short* dst = (GAS unsigned short*)(WSP(bf16, WS_WIN) + ((size_t)l * NP + 768 + 128 * dir + jb * 32) * D + k);
#pragma unroll 8
        for (int j = 0; j < 32; ++j) { float s = 0.f;
#pragma unroll
            for (int r = 0; r < 16; ++r) s += w[r] * a2[r * 128 + j];
            dst[(size_t)j * D] = (unsigned short)f2bf(s); }
    }
    LAS float* scr = (LAS float*)(F.lds + RING_OFF + 32768 + F.wave * 8704);
    constexpr int I_IN = 16 * 73;
    constexpr int NITEMS = I_IN + MOE_PROLOGUE_ITEMS;
    for (int it = gw; it < NITEMS; it += NGW) {
        int r = it;
        if (r < I_IN) { const int kb = r / 73, nb = r % 73; if (nb == 24) continue;
            const int n0 = nb * 32; p0_transpose_item(FIN(8), D, INW, WSP(bf16, WS_WIN), n0 < 768 ? n0 : n0 + 224, scr, kb * 64, n0, F.lane); continue; }
        r -= I_IN;
        moe_item(F, scr, r + MOE_SLOT_ITEMS);
    }
}

__device__ __forceinline__ f32x4 ld4_bf16(const bf16* p) { const unsigned long long a = *(const GAS unsigned long long*)p; f32x4 v; v.x = bflo((unsigned)a); v.y = bfhi((unsigned)a); v.z = bflo((unsigned)(a >> 32)); v.w = bfhi((unsigned)(a >> 32)); return v; }
template <bool ROUTER, bool X16>
__device__ __forceinline__ void phase_norm(Frame& F, int l, int which, const void* xlat, const void* xctx) {
    RELAUNDER(F);
    const int gw = F.vcu * NWAVES + F.wave, NGW = F.G * NWAVES;
    const float* nw = (which ? FIN(7) : FIN(6)) + l * 1024;
    const float* mod = WSP(float, WS_MOD) + (size_t)l * 5 * 6144;
    bf16* H = WSP(bf16, WS_H);
    LAS float* cwL = (LAS float*)(F.lds + RING_OFF); LAS float* csL = cwL + 5 * 1024;
    __syncthreads();
    { float a_[10], b_[10], c_[10];
#pragma unroll
      for (int q = 0; q < 10; ++q) { const int i = F.tid + 512 * q; const int b = i >> 10, col = i & 1023; a_[q] = nw[col]; b_[q] = mod[b * 6144 + (which ? 4 : 1) * 1024 + col]; c_[q] = mod[b * 6144 + (which ? 3 : 0) * 1024 + col]; }
#pragma unroll
      for (int q = 0; q < 10; ++q) { const int i = F.tid + 512 * q; cwL[i] = a_[q] * (1.0f + b_[q]); csL[i] = c_[q]; } }
    LAS float* wrL = csL + 5 * 1024;
    if (ROUTER) { for (int i = F.tid; i < 2048; i += 512) *(LAS f32x4*)(wrL + 4 * i) = *(const f32x4*)(FIN(25) + 4 * i); }
    __syncthreads();
    const int MR = ROUTER ? MLAT : MT;
    for (int rb = gw; rb < MR; rb += 4 * NGW) {
        f32x4 xv[4][4];
#pragma unroll
        for (int r = 0; r < 4; ++r) { const int row = rb + r * NGW; if (row < MR) { const size_t ro = row < MLAT ? (size_t)row * 1024 : (size_t)(row - MLAT) * 1024; const void* xb = row < MLAT ? xlat : xctx;
#pragma unroll
            for (int j = 0; j < 4; ++j) { if (X16) xv[r][j] = ld4_bf16((const bf16*)xb + ro + 4 * F.lane + 256 * j); else xv[r][j] = *(const f32x4*)((const float*)xb + ro + 4 * F.lane + 256 * j); } } }
#pragma unroll
        for (int r = 0; r < 4; ++r) {
            const int row = rb + r * NGW; if (row >= MR) break;
            const int bidx = row < MLAT ? (row >> 12) : 4;
            f32x4 v[4]; float ss = 0.f;
#pragma unroll
            for (int j = 0; j < 4; ++j) { v[j] = xv[r][j]; ss += (v[j].x * v[j].x + v[j].y * v[j].y) + (v[j].z * v[j].z + v[j].w * v[j].w); }
            const float rstd = 1.0f / sqrtf(wave_sum(ss) * (1.0f / 1024.0f) + EPS);
#pragma unroll
            for (int j = 0; j < 4; ++j) { const f32x4 cw = *(const LAS f32x4*)(cwL + bidx * 1024 + 4 * F.lane + 256 * j), cs = *(const LAS f32x4*)(csL + bidx * 1024 + 4 * F.lane + 256 * j);
                v[j] = v[j] * rstd * cw + cs;
                if (ROUTER) *(GAS unsigned*)((unsigned char*)H + (size_t)row * 1024 + 4 * F.lane + 256 * j) = pg8::pack_fp8x4(v[j].x * 4.0f, v[j].y * 4.0f, v[j].z * 4.0f, v[j].w * 4.0f);
                else *(GAS unsigned long long*)(H + (size_t)row * 1024 + 4 * F.lane + 256 * j) = (unsigned long long)pk2(v[j].x, v[j].y) | ((unsigned long long)pk2(v[j].z, v[j].w) << 32); }
            if (ROUTER && row < MLAT) {
                const LAS float* wr = wrL; float lg[8];
#pragma unroll
                for (int e = 0; e < 8; ++e) lg[e] = 0.f;
#pragma unroll
                for (int j = 0; j < 4; ++j)
#pragma unroll
                    for (int i = 0; i < 4; ++i) { const LAS float* wp = wr + (4 * F.lane + 256 * j + i) * 8; const f32x4 w0 = *(const LAS f32x4*)wp, w1 = *(const LAS f32x4*)(wp + 4); const float hv = v[j][i];
                        lg[0] += hv * w0.x; lg[1] += hv * w0.y; lg[2] += hv * w0.z; lg[3] += hv * w0.w; lg[4] += hv * w1.x; lg[5] += hv * w1.y; lg[6] += hv * w1.z; lg[7] += hv * w1.w; }
#pragma unroll
                for (int e = 0; e < 8; ++e) lg[e] = wave_sum(lg[e]);
                int i0 = 0; float v0 = lg[0];
#pragma unroll
                for (int e = 1; e < 8; ++e) if (lg[e] > v0) { v0 = lg[e]; i0 = e; }
                int i1 = -1; float v1 = -INFINITY;
#pragma unroll
                for (int e = 0; e < 8; ++e) if (e != i0 && lg[e] > v1) { v1 = lg[e]; i1 = e; }
                if (F.lane == 0) { const float ex = expf(v1 - v0); const float w0 = 1.0f / (1.0f + ex);
                    WSP(int, WS_TOKE)[2 * row] = i0; WSP(int, WS_TOKE)[2 * row + 1] = i1; WSP(float, WS_TOKW)[2 * row] = w0; WSP(float, WS_TOKW)[2 * row + 1] = ex * w0; }
            }
        }
    }
    __syncthreads();
}

__device__ __forceinline__ void bias_rows(Frame& F, const bf16* WT, int N, const float* shift  , float* out  ) {
    const int gw = F.vcu * NWAVES + F.wave, NGW = F.G * NWAVES;
    float cs[5][16];
#pragma unroll
    for (int b = 0; b < 5; ++b)
#pragma unroll
        for (int q = 0; q < 2; ++q) { const f32x4 a0 = *(const f32x4*)(shift + b * 6144 + 8 * F.lane + 512 * q), a1 = *(const f32x4*)(shift + b * 6144 + 8 * F.lane + 512 * q + 4);
            cs[b][8 * q + 0] = a0[0]; cs[b][8 * q + 1] = a0[1]; cs[b][8 * q + 2] = a0[2]; cs[b][8 * q + 3] = a0[3]; cs[b][8 * q + 4] = a1[0]; cs[b][8 * q + 5] = a1[1]; cs[b][8 * q + 6] = a1[2]; cs[b][8 * q + 7] = a1[3]; }
    for (int n = gw; n < N; n += NGW) {
        float w[16]; { float x[8]; unpack8(*(const v4u*)(WT + (size_t)n * 1024 + 8 * F.lane), x);
#pragma unroll
            for (int j = 0; j < 8; ++j) w[j] = x[j];
            unpack8(*(const v4u*)(WT + (size_t)n * 1024 + 8 * F.lane + 512), x);
#pragma unroll
            for (int j = 0; j < 8; ++j) w[8 + j] = x[j]; }
#pragma unroll
        for (int b = 0; b < 5; ++b) { float s = 0.f;
#pragma unroll
            for (int j = 0; j < 16; ++j) s += cs[b][j] * w[j];
            s = wave_sum(s); if (F.lane == 0) out[(size_t)b * N + n] = s; }
    }
}
__device__ __forceinline__ void phase_ppost(Frame& F, int l) {
    RELAUNDER(F);
    const int gw = F.vcu * NWAVES + F.wave, NGW = F.G * NWAVES; const int lane = F.lane;
    const bf16* P = WSP(bf16, WS_P);
    LAS float* ropeL = (LAS float*)(F.lds + RING_OFF + 1024);
    __syncthreads();
    for (int i = F.tid; i < 3072; i += 512) ropeL[i] = WSP(float, WS_ROPE)[i];
    __syncthreads();
    const LAS float* gcos = ropeL; const LAS float* gsin = ropeL + 1024; const LAS float* dcos = ropeL + 2048; const LAS float* dsin = ropeL + 2560;
    const float* kn = FIN(16) + l * 64;
    bf16 *GK = WSP(bf16, WS_GK), *DK = WSP(bf16, WS_DK);
    const int j8 = lane & 7, j4 = lane & 3;
    const int colA = lane < 16 ? PC_GK + 8 * lane : PC_DK + 8 * ((lane - 16) & 31);
    const int colB = PC_DQ + 8 * (lane & 31);
    float kw[8];
#pragma unroll
    for (int i = 0; i < 8; ++i) kw[i] = kn[8 * j8 + i];
    float dq2 = 0.f, dk2 = 0.f;
    constexpr int PP_MAX = 9;
    for (int rbase = gw; rbase < MT; rbase += PP_MAX * NGW) {
    v4u rA[PP_MAX], rB[PP_MAX];
#pragma unroll
    for (int i = 0; i < PP_MAX; ++i) { const int rr = rbase + i * NGW; rA[i] = (v4u){0u, 0u, 0u, 0u}; rB[i] = rA[i];
        if (rr < MT) { const bf16* p0 = P + (size_t)rr * NP; rA[i] = *(const v4u*)(p0 + colA); rB[i] = *(const v4u*)(p0 + colB); } }
#pragma unroll
    for (int i = 0; i < PP_MAX; ++i) {
        const int row = rbase + i * NGW; if (row < MT) {
        const v4u cA = rA[i], cB = rB[i];
        const bool isctx = row >= MLAT; const int b = isctx ? (row - MLAT) >> 8 : row >> 12; const int t = isctx ? (row - MLAT) & 255 : row & 4095;
        const int pos = isctx ? SEQ + t : t; const int gr = t >> 6, gc = t & 63; const size_t krow = (size_t)b * LK + pos;
        float x[8], y2[8], y1[8];
        unpack8(cA, x);
        { float ss = 0.f;
#pragma unroll
          for (int i = 0; i < 8; ++i) ss += x[i] * x[i];
          float s4 = ss + xor1(ss); s4 += xor2(s4);
          const float s8 = s4 + __shfl_xor(s4, 4);
          if (lane >= 16 && lane < 48) dk2 = fmaxf(dk2, s4);
          if (lane < 16) { const float rstd = 1.0f / sqrtf(s8 * (1.0f / 64.0f) + EPS);
#pragma unroll
              for (int i = 0; i < 8; ++i) x[i] = x[i] * rstd * kw[i]; } }
#pragma unroll
        for (int i = 0; i < 8; ++i) { y2[i] = xor2(x[i]); y1[i] = xor1(x[i]); }
        if (lane < 16) {
            if (!isctx) { const int pv = (j8 < 4) ? gr : gc; const LAS float* cp = gcos + pv * 16 + 8 * (j8 & 1); const LAS float* sp = gsin + pv * 16 + 8 * (j8 & 1);
                const f32x4 c0 = *(const LAS f32x4*)cp, c1 = *(const LAS f32x4*)(cp + 4), s0 = *(const LAS f32x4*)sp, s1 = *(const LAS f32x4*)(sp + 4);
                const float cvv[8] = {c0[0], c0[1], c0[2], c0[3], c1[0], c1[1], c1[2], c1[3]}, svv[8] = {s0[0], s0[1], s0[2], s0[3], s1[0], s1[1], s1[2], s1[3]};
#pragma unroll
                for (int i = 0; i < 8; ++i) x[i] = (j8 & 2) ? (y2[i] * svv[i] + x[i] * cvv[i]) : (x[i] * cvv[i] - y2[i] * svv[i]); }
            *(GAS v4u*)(GK + krow * 128 + 8 * lane) = pack8(x);
        } else if (lane < 48) {
            if (!isctx) { const int pv = (j4 < 2) ? gr : gc; const LAS float* cp = dcos + pv * 8; const LAS float* sp = dsin + pv * 8;
                const f32x4 c0 = *(const LAS f32x4*)cp, c1 = *(const LAS f32x4*)(cp + 4), s0 = *(const LAS f32x4*)sp, s1 = *(const LAS f32x4*)(sp + 4);
                const float cvv[8] = {c0[0], c0[1], c0[2], c0[3], c1[0], c1[1], c1[2], c1[3]}, svv[8] = {s0[0], s0[1], s0[2], s0[3], s1[0], s1[1], s1[2], s1[3]};
#pragma unroll
                for (int i = 0; i < 8; ++i) x[i] = (j4 & 1) ? (y1[i] * svv[i] + x[i] * cvv[i]) : (x[i] * cvv[i] - y1[i] * svv[i]); }
            *(GAS v4u*)(DK + krow * 256 + 8 * (lane - 16)) = pack8(x);
        }
        unpack8(cB, x);
        { float ss = 0.f;
#pragma unroll
          for (int i = 0; i < 8; ++i) ss += x[i] * x[i];
          ss += xor1(ss); ss += xor2(ss); dq2 = fmaxf(dq2, ss); }
        }
    }
    }
    dq2 *= (0.17677669529663687f * LOG2E) * (0.17677669529663687f * LOG2E);
#pragma unroll
    for (int o = 1; o < 64; o <<= 1) { dq2 = fmaxf(dq2, __shfl_xor(dq2, o)); dk2 = fmaxf(dk2, __shfl_xor(dk2, o)); }
    LAS float* red = (LAS float*)(F.lds + RING_OFF);
    __syncthreads();
    if (lane == 0) { red[2 * F.wave] = dq2; red[2 * F.wave + 1] = dk2; }
    __syncthreads();
    if (F.tid == 0) { float a = 0.f, b2 = 0.f;
        for (int w = 0; w < NWAVES; ++w) { a = fmaxf(a, red[2 * w]); b2 = fmaxf(b2, red[2 * w + 1]); }
        WSP(float, WS_QKMAX)[2 * blockIdx.x] = a; WSP(float, WS_QKMAX)[2 * blockIdx.x + 1] = b2; }
    __syncthreads();
}

__device__ __forceinline__ void phase_route(Frame& F) {
    RELAUNDER(F);
    const int* toke = WSP(int, WS_TOKE); const float* tokw = WSP(float, WS_TOKW);
    int* rowl = WSP(int, WS_ROWL); float* roww = WSP(float, WS_ROWW); int* pos = WSP(int, WS_POS); int* pane = WSP(int, WS_PANE);
    LAS int* cnt = (LAS int*)(F.lds + RING_OFF);
    LAS int* le = (LAS int*)(F.lds + RING_OFF + 256);
    const int Gq = opaque_s(F.G); const int per = (MLAT + Gq - 1) / Gq; const int bs = (int)blockIdx.x * per; const int be = bs + per < MLAT ? bs + per : MLAT;
    if (F.tid < 32) cnt[F.tid] = 0;
    __syncthreads();
    int tot[8], bef[8];
#pragma unroll
    for (int e = 0; e < 8; ++e) { tot[e] = 0; bef[e] = 0; }
    { typedef int i32x2 __attribute__((ext_vector_type(2))); i32x2 te[MLAT / 512];
#pragma unroll
      for (int q = 0; q < MLAT / 512; ++q) te[q] = *(const i32x2*)(toke + 2 * (F.tid + 512 * q));
#pragma unroll
      for (int q = 0; q < MLAT / 512; ++q) { const int t = F.tid + 512 * q; const int e0 = te[q].x, e1 = te[q].y; const int isb = t < bs ? 1 : 0;
#pragma unroll
        for (int e = 0; e < 8; ++e) { const int hit = (e0 == e) + (e1 == e); tot[e] += hit; bef[e] += hit * isb; } } }
#pragma unroll
    for (int e = 0; e < 8; ++e) {
#pragma unroll
        for (int o = 1; o < 64; o <<= 1) { tot[e] += __shfl_xor(tot[e], o); bef[e] += __shfl_xor(bef[e], o); }
        if (F.lane == 0) { __hip_atomic_fetch_add(&cnt[e], tot[e], __ATOMIC_RELAXED, __HIP_MEMORY_SCOPE_WORKGROUP); __hip_atomic_fetch_add(&cnt[8 + e], bef[e], __ATOMIC_RELAXED, __HIP_MEMORY_SCOPE_WORKGROUP); } }
    for (int t = bs + F.tid; t < be; t += 512) { le[2 * (t - bs)] = toke[2 * t]; le[2 * (t - bs) + 1] = toke[2 * t + 1]; }
    __syncthreads();
    if (F.tid == 0) { int b = 0; for (int e = 0; e < 8; ++e) { cnt[16 + e] = b; b += (cnt[e] + 255) & ~255; } cnt[24] = b; }
    __syncthreads();
    for (int t = bs + F.tid; t < be; t += 512) {
        const int j = t - bs; const int e0 = le[2 * j], e1 = le[2 * j + 1]; int p0 = 0, p1 = 0;
        for (int q = 0; q < j; ++q) { const int a = le[2 * q], b2 = le[2 * q + 1]; p0 += (a == e0) + (b2 == e0); p1 += (a == e1) + (b2 == e1); }
        const int r0 = cnt[16 + e0] + cnt[8 + e0] + p0, r1 = cnt[16 + e1] + cnt[8 + e1] + p1;
        rowl[r0] = t; roww[r0] = tokw[2 * t]; rowl[r1] = t; roww[r1] = tokw[2 * t + 1]; pos[2 * t] = r0; pos[2 * t + 1] = r1;
    }
    if (blockIdx.x == 0) {
        const int np = cnt[24] >> 8;
        for (int p = F.tid; p < 255; p += 512) { int e = 0;
#pragma unroll
            for (int q = 1; q < 8; ++q) if (p * 256 >= cnt[16 + q]) e = q;
            pane[p] = p < np ? e : 0; }
        if (F.tid == 0) pane[255] = np;
        for (int e = 0; e < 8; ++e) { const int lo = cnt[16 + e] + cnt[e], hi = cnt[16 + e + 1]; for (int r = lo + F.tid; r < hi; r += 512) { rowl[r] = 0; roww[r] = 0.f; } }
    }
    __syncthreads();
}

__device__ __forceinline__ void phase_final(Frame& F) {
    RELAUNDER(F);
    const int gw = F.vcu * NWAVES + F.wave, NGW = F.G * NWAVES;
    const bf16* Y2 = WSP(bf16, WS_Y2); const int* pos = WSP(int, WS_POS); const float* mod = WSP(float, WS_MOD) + (size_t)1 * 5 * 6144;
    f32x4 nf[4];
#pragma unroll
    for (int j = 0; j < 4; ++j) nf[j] = *(const f32x4*)(FIN(29) + 4 * F.lane + 256 * j);
    typedef unsigned long long u64;
    int pr0 = 0, pr1 = 0;
    f32x4 nx[4]; u64 na[4], nb[4];
#pragma unroll
    for (int j = 0; j < 4; ++j) { nx[j] = (f32x4){0.f, 0.f, 0.f, 0.f}; na[j] = 0; nb[j] = 0; }
    if (gw < MLAT) { const int r0 = pos[2 * gw], r1 = pos[2 * gw + 1];
#pragma unroll
        for (int j = 0; j < 4; ++j) { const int col = 4 * F.lane + 256 * j; nx[j] = ld4_bf16(WSP(bf16, WS_XB) + (size_t)gw * 1024 + col);
            na[j] = *(const GAS u64*)(Y2 + (size_t)r0 * 1024 + col); nb[j] = *(const GAS u64*)(Y2 + (size_t)r1 * 1024 + col); } }
    if (gw + NGW < MLAT) { pr0 = pos[2 * (gw + NGW)]; pr1 = pos[2 * (gw + NGW) + 1]; }
    for (int row = gw; row < MLAT; row += NGW) {
        const int b = row >> 12; const float* gf = mod + b * 6144 + 5 * 1024;
        f32x4 cx[4]; u64 ca[4], cb[4];
#pragma unroll
        for (int j = 0; j < 4; ++j) { cx[j] = nx[j]; ca[j] = na[j]; cb[j] = nb[j]; }
        const int nrow = row + NGW;
        if (nrow < MLAT) { const int r0 = pr0, r1 = pr1;
#pragma unroll
            for (int j = 0; j < 4; ++j) { const int col = 4 * F.lane + 256 * j; nx[j] = ld4_bf16(WSP(bf16, WS_XB) + (size_t)nrow * 1024 + col);
                na[j] = *(const GAS u64*)(Y2 + (size_t)r0 * 1024 + col); nb[j] = *(const GAS u64*)(Y2 + (size_t)r1 * 1024 + col); }
            if (nrow + NGW < MLAT) { pr0 = pos[2 * (nrow + NGW)]; pr1 = pos[2 * (nrow + NGW) + 1]; } }
        float* xr = F.out + (size_t)row * 1024; f32x4 v[4]; float ss = 0.f;
#pragma unroll
        for (int j = 0; j < 4; ++j) { const int col = 4 * F.lane + 256 * j; const f32x4 g = *(const f32x4*)(gf + col); const u64 a = ca[j], c2 = cb[j];
            f32x4 ya, yb; ya.x = bflo((unsigned)a); ya.y = bfhi((unsigned)a); ya.z = bflo((unsigned)(a >> 32)); ya.w = bfhi((unsigned)(a >> 32));
            yb.x = bflo((unsigned)c2); yb.y = bfhi((unsigned)c2); yb.z = bflo((unsigned)(c2 >> 32)); yb.w = bfhi((unsigned)(c2 >> 32));
            v[j] = cx[j] + g * (ya + yb);
            ss += (v[j].x * v[j].x + v[j].y * v[j].y) + (v[j].z * v[j].z + v[j].w * v[j].w); }
        const float rstd = 1.0f / sqrtf(wave_sum(ss) * (1.0f / 1024.0f) + EPS);
#pragma unroll
        for (int j = 0; j < 4; ++j) __builtin_nontemporal_store(v[j] * rstd * nf[j], (f32x4*)(xr + 4 * F.lane + 256 * j));
    }
}

struct Args { const float* in[30]; float* out; unsigned char* ws; int ph_lo, ph_hi; };
constexpr int PH_PRO = 0, PH_L0 = 9, PH_NORM1 = 1, PH_INPROJ = 2, PH_PPOST = 3, PH_G2 = 4, PH_ATTN = 5, PH_OUTPROJ = 6, PH_NORM2 = 7, PH_F1 = 8, PH_F2 = 9, PH_F3 = 10, PH_F4 = 11;
constexpr int N_PHASES = 1 + 9 + 11;
constexpr bool ALIGN_EPI = true, SP2 = true;
#ifndef FUSE_NORM
#define FUSE_NORM 0
#endif
constexpr bool FUSEN = FUSE_NORM != 0;
#ifndef NBAR
#define NBAR 1
#endif

constexpr int CS_WG = 88, CS_PER = 16, CS_BASE = 43008 + 22528 + 2048 * 5;
static_assert(CS_BASE + CS_WG * NWAVES * CS_PER >= att::HI_ALL, "conversion slot covers the tail");
__device__ __forceinline__ void conv_slot(Frame& F, int idx) {
    const int t_ = ltid(); const int lane = t_ & 63; const int wv = __builtin_amdgcn_readfirstlane(t_ >> 6);
    const att::Conv cv{FIN(26), FIN(27), FIN(28), WSP(unsigned char, WS_MGU), WSP(unsigned char, WS_MDN), 0, 0};
    LAS float* scr = (LAS float*)(F.lds + RING_OFF) + wv * 1056;
    const int h0 = CS_BASE + (idx * NWAVES + wv) * CS_PER;
    __syncthreads();
    float wa[16], wb[16];
    if (h0 < att::HI_ALL) att::conv_load(cv, h0, lane, wa);
#pragma unroll 1
    for (int j = 0; j < CS_PER; j += 2) {
        if (h0 + j + 1 < att::HI_ALL) att::conv_load(cv, h0 + j + 1, lane, wb);
        if (h0 + j < att::HI_ALL) att::conv_store(cv, h0 + j, lane, wa, scr);
        if (j + 2 < CS_PER && h0 + j + 2 < att::HI_ALL) att::conv_load(cv, h0 + j + 2, lane, wa);
        if (h0 + j + 1 < att::HI_ALL) att::conv_store(cv, h0 + j + 1, lane, wb, scr);
    }
    __syncthreads();
}
__global__ void __launch_bounds__(NWAVES * 64, 2) mk_fwd(Args args) {
    extern __shared__ __attribute__((aligned(16))) unsigned char lds[];
    Frame F;
    F.lds = (LAS unsigned char*)lds; F.MISC = (volatile LAS unsigned*)(F.lds + MISC_OFF);
    F.tid = 0; F.lane = 0; F.wave = 0;
    F.G = gridDim.x; { const int bx = blockIdx.x; F.vcu = (F.G % 8 == 0) ? (bx % 8) * (F.G / 8) + bx / 8 : bx; }
    F.ws = args.ws; F.out = args.out; F.ctl = (gu32*)(args.ws + WS_CTL);
    F.in = args.in;
    for (int u = ltid(); u < (LDS_BYTES - LDSCTL_OFF) / 4; u += NWAVES * 64) ((LAS unsigned*)(F.lds + LDSCTL_OFF))[u] = 0u;
    __syncthreads();
#if MK_ONE_LAUNCH
    XcdBarrier bar = xcd_barrier_post((unsigned*)(F.ctl + CW_BAR), F.MISC + 8);
#define GRID_BAR() xcd_barrier(bar)
#else
#define GRID_BAR() do { } while (0)
#endif
    const int lo = args.ph_lo, hi = args.ph_hi;
#ifndef PHMASK
#define PHMASK 0xFFFFFFFFu
#endif
#define PM(b) ((PHMASK >> (b)) & 1u)
#ifndef REPMASK
#define REPMASK 0u
#endif
#define REPS(b) (((REPMASK >> (b)) & 1u) ? 2 : 1)
#define IN(k) (lo <= (k) && (k) < hi)
#define SEAM(k) do { if (IN((k) + 1)) { _Pragma("nounroll") for (int r_ = 0; r_ < NBAR; ++r_) GRID_BAR(); } } while (0)

    if (PM(0) && IN(PH_PRO)) { for (int rep = 0; rep < REPS(0); ++rep) { p0_prologue(F); __syncthreads(); } SEAM(PH_PRO); }

    for (int l = 0; l < 2; ++l) {
        const int pb = l * PH_L0;
        const float* xlat = FIN(0); const float* xctx = FIN(2); (void)xlat; (void)xctx;
        bf16* XB = WSP(bf16, WS_XB); bf16* XBC = WSP(bf16, WS_XBC);
        const float* mod = WSP(float, WS_MOD) + (size_t)l * 5 * 6144;
        if ((l == 0 || !FUSEN) && PM(1) && IN(pb + PH_NORM1)) { for (int rep = 0; rep < REPS(1); ++rep) { if (l == 0) phase_norm<false, false>(F, l, 0, FIN(0), FIN(2)); else phase_norm<false, true>(F, l, 0, XB, XBC); }
            if (FUSEN && l == 0) { bias_rows(F, WSP(bf16, WS_WGU), 2 * DFF, WSP(float, WS_MOD) + 3 * 1024, WSP(float, WS_BIASGU));
            bias_rows(F, WSP(bf16, WS_WIN) + (size_t)NP * D, NP, WSP(float, WS_MOD) + (size_t)5 * 6144 + 0 * 1024, WSP(float, WS_BIASIN)); }
            SEAM(pb + PH_NORM1); }
        if (PM(2) && IN(pb + PH_INPROJ)) { for (int rep = 0; rep < REPS(2); ++rep) {
            pg8::Gemm g{WSP(bf16, WS_H), WSP(bf16, WS_WIN) + (size_t)l * NP * D, MT, NP, D}; pg8::StaticOrder S; S.init(MT, NP, F.G, opaque_s((int)blockIdx.x));
            if (l == 0 || !FUSEN) { pg8::EpiStoreBf16 E{WSP(bf16, WS_P), NP};
                pg8::gemm_phase<pg8::EpiStoreBf16, pg8::StaticOrder, ALIGN_EPI, SP2>(F.lds + RING_OFF, g, S, E); }
            else { pg8::EpiStoreBf16N E{WSP(bf16, WS_P), NP, (const float*)(F.ws + WS_SS1), WSP(float, WS_BIASIN)};
                pg8::gemm_phase<pg8::EpiStoreBf16N, pg8::StaticOrder, ALIGN_EPI, SP2>(F.lds + RING_OFF, g, S, E); }
            { const int ii = idle_index((MT / 256) * (NP / 256), F.G, opaque_s((int)blockIdx.x)); if (l == 0) { if (ii >= 0 && ii < AUX_WG) aux_slot(F, ii); } else if (ii >= 0 && ii < CS_WG) conv_slot(F, ii); } }
            SEAM(pb + PH_INPROJ);
        }
        if (PM(3) && IN(pb + PH_PPOST)) { for (int rep = 0; rep < REPS(3); ++rep) {
            if (l == 0) { const int ic = idle_count((MT / 256) * (NP / 256), F.G); for (int w = (ic < AUX_WG ? ic : AUX_WG) + (int)blockIdx.x; w < AUX_WG; w += F.G) aux_slot(F, w); }
            else { const int ic = idle_count((MT / 256) * (NP / 256), F.G); for (int w = (ic < CS_WG ? ic : CS_WG) + (int)blockIdx.x; w < CS_WG; w += F.G) conv_slot(F, w); }
            for (int rg = 0; rg < REPS(16); ++rg) { gla::g1_phase(F.lds + RING_OFF, WSP(bf16, WS_P), FIN(11) + l * 128, FIN(13) + l * 128, WSP(float, WS_KV), WSP(float, WS_DEC), F.G); __syncthreads(); }
            __syncthreads();
            phase_ppost(F, l); __syncthreads(); }
            SEAM(pb + PH_PPOST);
        }
        if (PM(4) && IN(pb + PH_G2)) {
            gla::g2_scan(WSP(float, WS_KV), WSP(bf16, WS_GQ)  , WSP(float, WS_DEC), opaque_s((int)blockIdx.x) * 512 + ltid(), F.G * 512);
#if MK_ONE_LAUNCH
            {
                const bool scans = opaque_s((int)blockIdx.x) * 512 < 32 * 2048;
                asm volatile("s_waitcnt vmcnt(0)" ::: "memory"); __syncthreads();
                if (scans && ltid() == 0) { __builtin_amdgcn_fence(__ATOMIC_RELEASE, "agent"); asm volatile("s_waitcnt vmcnt(0)" ::: "memory");
                    (void)__hip_atomic_fetch_add((unsigned*)(F.ctl + CW_G2DONE + l), 1u, __ATOMIC_RELAXED, __HIP_MEMORY_SCOPE_AGENT); }
            }
#endif
            float wq = 0.f, wk = 0.f; for (int i = 0; i < 64; ++i) { wq = fmaxf(wq, fabsf(FIN(15)[l * 64 + i])); wk = fmaxf(wk, fabsf(FIN(16)[l * 64 + i])); }
            const bool fast_g = 64.0f * wq * wk * 0.125f * LOG2E < 60.0f;
            bf16* MIX = WSP(bf16, WS_MIX); const bf16 *P = WSP(bf16, WS_P), *GK = WSP(bf16, WS_GK); const float* rope = WSP(float, WS_ROPE);
            const att::QCtx QC{P, rope, rope + 1024, rope + 2048, rope + 2560, FIN(15) + l * 64};
            const int wv_ = __builtin_amdgcn_readfirstlane(ltid() >> 6);
            const int n_gqa = NB * 4 * 16;
            for (int rep = 0; rep < REPS(4); ++rep)
            for (int u = blockIdx.x; u < n_gqa; u += F.G) {
                const int qb = u & 15, hp = (u >> 4) & 3, b = u >> 6; const int hq = 2 * hp; const size_t r0 = (size_t)b * SEQ + qb * 256;
                const bool cskew = opaque_s(F.G) == 256;
                const att::Conv CV{FIN(26), FIN(27), FIN(28), WSP(unsigned char, WS_MGU), WSP(unsigned char, WS_MDN), CONV_IN_ATTN ? l * 43008 + (!cskew ? (u * 8 + wv_) * 11 : u < 128 ? (u * 8 + wv_) * 9 : 128 * 8 * 9 + ((u - 128) * 8 + wv_) * 13) : 0, CONV_IN_ATTN ? (!cskew ? 11 : u < 128 ? 9 : 13) : 0};
                att::gqa_unit2(F.lds + RING_OFF, QC, r0, qb * 256, hq, GK + (size_t)b * LK * 128 + (hq >> 2) * 64, P + (size_t)b * SEQ * NP + PC_GV + (hq >> 2) * 64, P + (size_t)(MLAT + b * CTXL) * NP + PC_GV + (hq >> 2) * 64, SEQ / 64, LK / 64,
                               MIX + r0 * 1024 + 256 + hq * 64, MIX + r0 * 1024 + 256 + (hq + 1) * 64, fast_g, CV);
            }
#if !MK_ONE_LAUNCH
            SEAM(pb + PH_G2);
#endif
        }
        if (PM(5) && IN(pb + PH_ATTN)) { {
            const float linit = 0.8f - 0.6f * expf(-0.3f * (float)l);
            float s1 = 0.f, s2 = 0.f;
            for (int i = 0; i < 32; ++i) { s1 += FIN(17)[l * 32 + i] * FIN(18)[l * 32 + i]; s2 += FIN(19)[l * 32 + i] * FIN(20)[l * 32 + i]; }
            const float lam = expf(s1) - expf(s2) + linit;
            float q2 = 0.f, k2 = 0.f;
            { LAS float* red = (LAS float*)(F.lds + RING_OFF); __syncthreads();
              const int t_ = ltid(); const int wv_ = __builtin_amdgcn_readfirstlane(t_ >> 6);
              float a = 0.f, b2 = 0.f; for (int i = t_; i < F.G; i += 512) { a = fmaxf(a, WSP(float, WS_QKMAX)[2 * i]); b2 = fmaxf(b2, WSP(float, WS_QKMAX)[2 * i + 1]); }
#pragma unroll
              for (int o = 1; o < 64; o <<= 1) { a = fmaxf(a, __shfl_xor(a, o)); b2 = fmaxf(b2, __shfl_xor(b2, o)); }
              if ((t_ & 63) == 0) { red[2 * wv_] = a; red[2 * wv_ + 1] = b2; }
              __syncthreads();
              for (int w = 0; w < NWAVES; ++w) { q2 = fmaxf(q2, red[2 * w]); k2 = fmaxf(k2, red[2 * w + 1]); }
              __syncthreads(); }
            const bool fast_d = sqrtf(q2 * k2) < 60.0f;
            bf16* MIX = WSP(bf16, WS_MIX); const bf16 *P = WSP(bf16, WS_P), *DK = WSP(bf16, WS_DK); const float* rope = WSP(float, WS_ROPE);
            const att::QCtx QC{P, rope, rope + 1024, rope + 2048, rope + 2560, FIN(15) + l * 64};
            const int n_diff = NB * 4 * 16; const int wv_ = __builtin_amdgcn_readfirstlane(ltid() >> 6);
            for (int rep = 0; rep < REPS(5); ++rep)
            for (int u = blockIdx.x; u < n_diff; u += F.G) {
                const int qb = u & 15, h = (u >> 4) & 3, b = u >> 6; const size_t r0 = (size_t)b * SEQ + qb * 256;
                const att::Conv CV{FIN(26), FIN(27), FIN(28), WSP(unsigned char, WS_MGU), WSP(unsigned char, WS_MDN), CONV_IN_ATTN ? l * 43008 + 22528 + (u * 8 + wv_) * (l == 0 ? 10 : 5) : 0, CONV_IN_ATTN ? (l == 0 ? 10 : 5) : 0};
                att::diff_unit2(F.lds + RING_OFF, QC, r0, qb * 256, h, DK + (size_t)b * LK * 256 + h * 64, P + (size_t)b * SEQ * NP + PC_DV + h * 64, P + (size_t)(MLAT + b * CTXL) * NP + PC_DV + h * 64, SEQ / 64, LK / 64,
                                lam, FIN(21) + l * 64, 1.0f - linit, MIX + r0 * 1024 + 768 + h * 64, fast_d, CV);
            }
            if (l == 0) {
                float wq = 0.f, wk = 0.f; for (int i = 0; i < 64; ++i) { wq = fmaxf(wq, fabsf(FIN(15)[l * 64 + i])); wk = fmaxf(wk, fabsf(FIN(16)[l * 64 + i])); }
                const bool fast_g = 64.0f * wq * wk * 0.125f * LOG2E < 60.0f;
                const bf16* GK = WSP(bf16, WS_GK); const att::Conv CV0{FIN(26), FIN(27), FIN(28), WSP(unsigned char, WS_MGU), WSP(unsigned char, WS_MDN), 0, 0};
                for (int v = (int)blockIdx.x - (F.G - 32); v >= 0 && v < 32; v += F.G) {
                    const int b = (v >> 2) & 3, hh = v & 3; const size_t r0 = (size_t)MLAT + b * CTXL; const size_t k0 = (size_t)b * LK + SEQ;
                    if (v < 16) att::diff_unit2(F.lds + RING_OFF, QC, r0, -1, hh, DK + k0 * 256 + hh * 64, P, P + r0 * NP + PC_DV + hh * 64, 0, CTXL / 64, lam, FIN(21) + l * 64, 1.0f - linit, MIX + r0 * 1024 + 768 + hh * 64, fast_d, CV0);
                    else { const int hq = 2 * hh; att::gqa_unit2(F.lds + RING_OFF, QC, r0, -1, hq, GK + k0 * 128 + (hq >> 2) * 64, P, P + r0 * NP + PC_GV + (hq >> 2) * 64, 0, CTXL / 64, MIX + r0 * 1024 + 256 + hq * 64, MIX + r0 * 1024 + 256 + (hq + 1) * 64, fast_g, CV0); }
                }
            }
            __syncthreads();
#if MK_ONE_LAUNCH
            {
                if (ltid() == 0) { const unsigned need = (unsigned)((32 * 2048 + 511) / 512) < (unsigned)F.G ? (unsigned)((32 * 2048 + 511) / 512) : (unsigned)F.G; unsigned sp = 0;
                    while (__hip_atomic_load((unsigned*)(F.ctl + CW_G2DONE + l), __ATOMIC_RELAXED, __HIP_MEMORY_SCOPE_AGENT) < need && ++sp < (1u << 22)) __builtin_amdgcn_s_sleep(1);
                    __builtin_amdgcn_fence(__ATOMIC_ACQUIRE, "agent"); asm volatile("s_waitcnt vmcnt(0)" ::: "memory"); }
                __syncthreads();
            }
#endif
            for (int rep3 = 0; rep3 < REPS(15); ++rep3)
            gla::g3_phase(F.lds + RING_OFF, WSP(bf16, WS_P), l == 0 ? NCH : NCH - 4, FIN(11) + l * 128, FIN(13) + l * 128, WSP(bf16, WS_GQ), FIN(14) + l * 64, MIX, F.G);
            __syncthreads(); }
            SEAM(pb + PH_ATTN);
        }
        if (PM(6) && IN(pb + PH_OUTPROJ)) {
            const int M = l == 0 ? MT : MLAT;
            const int U = (M / 256) * (D / 256); const int Gq = opaque_s(F.G); int R = U / Gq; const int Lc = U - R * Gq; const bool split = Lc > 0 && Lc * 16 <= 2 * Gq; if (!split) R = (U + Gq - 1) / Gq;
            pg8::Gemm g{WSP(bf16, WS_MIX), WSP(bf16, WS_WOUT) + (size_t)l * D * D, M, D, D}; pg8::RoundsOrder S; S.init(M, D, F.G, opaque_s((int)blockIdx.x), R);
            if (l == 0 && FUSEN) {
                pg8::EpiResidNorm E{xlat, xctx, F.out, WSP(float, WS_XCTX), mod + 2 * 1024, WSP(bf16, WS_H), (float*)(F.ws + WS_SS2), FIN(7) + l * 1024, mod + 4 * 1024};
                pg8::gemm_phase<pg8::EpiResidNorm, pg8::RoundsOrder, ALIGN_EPI, SP2>(F.lds + RING_OFF, g, S, E);
                if (split) { tail::EpiResidNorm TE{xlat, xctx, F.out, WSP(float, WS_XCTX), mod + 2 * 1024, WSP(bf16, WS_H), (float*)(F.ws + WS_SS2), FIN(7) + l * 1024, mod + 4 * 1024};
                    for (int q = F.vcu; q < Lc * 16; q += F.G) { pg8::StaticOrder s2; s2.init(M, D, F.G, q >> 4); pg8::Unit u; s2.next(R, u); const int sub = q & 15;
                        tail::subtile<D>(F.lds + RING_OFF, g.A, g.Bt, u.pm * 256 + 64 * (sub >> 2), u.pn * 256 + 64 * (sub & 3), u.pn * 256 + 64 * (sub & 3), TE); } }
            } else {
            if (l == 0) { pg8::EpiResidB<false> E{FIN(0), FIN(2), XB, XBC, mod + 2 * 1024};
                pg8::gemm_phase<pg8::EpiResidB<false>, pg8::RoundsOrder, ALIGN_EPI, SP2>(F.lds + RING_OFF, g, S, E);
                if (split) { tail::EpiResidB<false> TE{FIN(0), FIN(2), XB, XBC, mod + 2 * 1024};
                    for (int q = F.vcu; q < Lc * 16; q += F.G) { pg8::StaticOrder s2; s2.init(M, D, F.G, q >> 4); pg8::Unit u; s2.next(R, u); const int sub = q & 15;
                        tail::subtile<D>(F.lds + RING_OFF, g.A, g.Bt, u.pm * 256 + 64 * (sub >> 2), u.pn * 256 + 64 * (sub & 3), u.pn * 256 + 64 * (sub & 3), TE); } } }
            else { pg8::EpiResidB<true> E{XB, XBC, XB, XBC, mod + 2 * 1024};
                pg8::gemm_phase<pg8::EpiResidB<true>, pg8::RoundsOrder, ALIGN_EPI, SP2>(F.lds + RING_OFF, g, S, E);
                if (split) { tail::EpiResidB<true> TE{XB, XBC, XB, XBC, mod + 2 * 1024};
                    for (int q = F.vcu; q < Lc * 16; q += F.G) { pg8::StaticOrder s2; s2.init(M, D, F.G, q >> 4); pg8::Unit u; s2.next(R, u); const int sub = q & 15;
                        tail::subtile<D>(F.lds + RING_OFF, g.A, g.Bt, u.pm * 256 + 64 * (sub >> 2), u.pn * 256 + 64 * (sub & 3), u.pn * 256 + 64 * (sub & 3), TE); } } }
            }
            SEAM(pb + PH_OUTPROJ);
        }
        if (l == 0) {
            if (!FUSEN && PM(7) && IN(pb + PH_NORM2)) { phase_norm<false, true>(F, l, 1, XB, XBC); SEAM(pb + PH_NORM2); }
            if (PM(8) && IN(pb + PH_F1)) { for (int rep = 0; rep < REPS(8); ++rep) {
                pg8::Gemm g{WSP(bf16, WS_H), WSP(bf16, WS_WGU), MT, 2 * DFF, D}; pg8::StaticOrder S; S.init(MT, 2 * DFF, F.G, opaque_s((int)blockIdx.x));
                if (FUSEN) { pg8::EpiSwiGLUN E{WSP(bf16, WS_ACT), DFF, (const float*)(F.ws + WS_SS2), WSP(float, WS_BIASGU)};
                pg8::gemm_phase<pg8::EpiSwiGLUN, pg8::StaticOrder, ALIGN_EPI, SP2>(F.lds + RING_OFF, g, S, E); }
                else { pg8::EpiSwiGLU E{WSP(bf16, WS_ACT), DFF, 0};
                pg8::gemm_phase<pg8::EpiSwiGLU, pg8::StaticOrder, ALIGN_EPI, SP2>(F.lds + RING_OFF, g, S, E); }
                { const int ii = idle_index((MT / 256) * (2 * DFF / 256), F.G, opaque_s((int)blockIdx.x)); if (ii >= 0 && ii < SLOT_B_WG) moe_slot(F, SLOT_B0, ii, SLOT_B_Q); } }
                SEAM(pb + PH_F1);
            }
            if (PM(9) && IN(pb + PH_F2)) {
                const int U = (MT / 256) * (D / 256); const int Gq = opaque_s(F.G); int R = U / Gq; const int Lc = U - R * Gq; const bool split = Lc > 0 && Lc * 16 <= 2 * Gq; if (!split) R = (U + Gq - 1) / Gq;
                pg8::Gemm g{WSP(bf16, WS_ACT), WSP(bf16, WS_WDN), MT, D, DFF}; pg8::RoundsOrder S; S.init(MT, D, F.G, opaque_s((int)blockIdx.x), R);
                if (FUSEN) {
                const float* mod1 = WSP(float, WS_MOD) + (size_t)5 * 6144;
                pg8::EpiResidNorm E{F.out, WSP(float, WS_XCTX), F.out, WSP(float, WS_XCTX), mod + 5 * 1024, WSP(bf16, WS_H), (float*)(F.ws + WS_SS1), FIN(6) + 1024, mod1 + 1 * 1024};
                pg8::gemm_phase<pg8::EpiResidNorm, pg8::RoundsOrder, ALIGN_EPI, SP2>(F.lds + RING_OFF, g, S, E);
                if (split) { tail::EpiResidNorm TE{F.out, WSP(float, WS_XCTX), F.out, WSP(float, WS_XCTX), mod + 5 * 1024, WSP(bf16, WS_H), (float*)(F.ws + WS_SS1), FIN(6) + 1024, mod1 + 1 * 1024};
                    for (int q = F.vcu; q < Lc * 16; q += F.G) { pg8::StaticOrder s2; s2.init(MT, D, F.G, q >> 4); pg8::Unit u; s2.next(R, u); const int sub = q & 15;
                        tail::subtile<DFF>(F.lds + RING_OFF, g.A, g.Bt, u.pm * 256 + 64 * (sub >> 2), u.pn * 256 + 64 * (sub & 3), u.pn * 256 + 64 * (sub & 3), TE); } }
                } else {
                pg8::EpiResidB<true> E{XB, XBC, XB, XBC, mod + 5 * 1024};
                pg8::gemm_phase<pg8::EpiResidB<true>, pg8::RoundsOrder, ALIGN_EPI, SP2>(F.lds + RING_OFF, g, S, E);
                if (split) { tail::EpiResidB<true> TE{XB, XBC, XB, XBC, mod + 5 * 1024};
                    for (int q = F.vcu; q < Lc * 16; q += F.G) { pg8::StaticOrder s2; s2.init(MT, D, F.G, q >> 4); pg8::Unit u; s2.next(R, u); const int sub = q & 15;
                        tail::subtile<DFF>(F.lds + RING_OFF, g.A, g.Bt, u.pm * 256 + 64 * (sub >> 2), u.pn * 256 + 64 * (sub & 3), u.pn * 256 + 64 * (sub & 3), TE); } }
                }
                SEAM(pb + PH_F2);
            }
        } else {
            if (PM(10) && IN(pb + PH_NORM2)) { phase_norm<true, true>(F, l, 1, XB, XBC); SEAM(pb + PH_NORM2); }
            if (PM(11) && IN(pb + PH_F1)) { phase_route(F);
                slot_leftover(F, SLOT_A0, SLOT_A_WG, (MT / 256) * (NP / 256), SLOT_A_Q); slot_leftover(F, SLOT_B0, SLOT_B_WG, (MT / 256) * (2 * DFF / 256), SLOT_B_Q); slot_leftover(F, SLOT_C0, SLOT_C_WG, (MT / 256) * (NP / 256), SLOT_C_Q);
                SEAM(pb + PH_F1); }
            if (PM(12) && IN(pb + PH_F2)) { for (int rep = 0; rep < REPS(12); ++rep) {
                const int* pane = WSP(int, WS_PANE); const int np = pane[255];
                pg8::Gemm g{WSP(bf16, WS_H), WSP(bf16, WS_MGU), np * 256, 2 * DFFE, D / 2}; pg8::MoeOrder S; S.init(np, 2 * DFFE / 256, F.G, opaque_s((int)blockIdx.x), pane);
                pg8::EpiSwiGLU8 E{WSP(unsigned char, WS_ACT2), DFFE, 2 * DFFE / 256, 2.0f, 0.001953125f  };
                pg8::gemm_phase_gather<pg8::EpiSwiGLU8, pg8::MoeOrder>(F.lds + RING_OFF, g, S, E, WSP(int, WS_ROWL), 0x7D7D7D7D  , 0x78787878  ); }
                SEAM(pb + PH_F2);
            }
            if (PM(13) && IN(pb + PH_F3)) { for (int rep = 0; rep < REPS(13); ++rep) {
                const int* pane = WSP(int, WS_PANE); const int np = pane[255];
                const int U = np * (D / 256); const int Gq = opaque_s(F.G); int R = U / Gq; const int Lc = U - R * Gq; const bool split = Lc > 0 && Lc * 16 <= 2 * Gq; if (!split) R = (U + Gq - 1) / Gq;
                pg8::Gemm g{WSP(bf16, WS_ACT2), WSP(bf16, WS_MDN), np * 256, D, DFFE / 2}; pg8::MoeOrder S; S.init(np, D / 256, F.G, opaque_s((int)blockIdx.x), pane, R);
                pg8::EpiMoeDown E{WSP(bf16, WS_Y2), WSP(float, WS_ROWW), D / 256, 0.00390625f  };
                pg8::gemm_phase_f8<pg8::EpiMoeDown, pg8::MoeOrder, ALIGN_EPI, SP2>(F.lds + RING_OFF, g, S, E, 0x7E7E7E7E  , 0x78787878  );
                if (split) { tail::EpiMoeDown TE{WSP(bf16, WS_Y2), WSP(float, WS_ROWW), 0.00390625f};
                    for (int q = F.vcu; q < Lc * 16; q += F.G) { pg8::StaticOrder s2; s2.init(np * 256, D, F.G, q >> 4); pg8::Unit u; s2.next(R, u); const int sub = q & 15;
                        tail::subtile_f8<DFFE>(F.lds + RING_OFF, WSP(unsigned char, WS_ACT2), WSP(unsigned char, WS_MDN), u.pm * 256 + 64 * (sub >> 2), (pane[u.pm] * (D / 256) + u.pn) * 256 + 64 * (sub & 3), u.pn * 256 + 64 * (sub & 3), TE, 0x7E7E7E7E, 0x78787878); } }
                __syncthreads(); }
                SEAM(pb + PH_F3);
            }
            if (PM(14) && IN(pb + PH_F4)) { phase_final(F); }
        }
    }
#undef IN
#undef SEAM
}

extern "C" void kernel_launch(void* const* d_in, const int* in_sizes, int n_in, void* d_out, int out_size, void* d_ws, size_t ws_size, hipStream_t stream) {
    static int grid = 0;
    if (grid == 0) {
        if (n_in != 30 || out_size != MLAT * D || ws_size < WS_END) { fprintf(stderr, "kernel_launch: expected 30 inputs, %d outputs, >= %zu bytes of workspace; got %d, %d, %zu; nothing launched\n", MLAT * D, (size_t)WS_END, n_in, out_size, ws_size); grid = -1; return; }
        int dev = 0, cus = 0, per_cu = 0;
        if (hipGetDevice(&dev) != hipSuccess || hipDeviceGetAttribute(&cus, hipDeviceAttributeMultiprocessorCount, dev) != hipSuccess) { fprintf(stderr, "kernel_launch: device query failed\n"); grid = -1; return; }
        if (hipFuncSetAttribute((const void*)mk_fwd, hipFuncAttributeMaxDynamicSharedMemorySize, LDS_BYTES) != hipSuccess) { fprintf(stderr, "kernel_launch: hipFuncSetAttribute failed\n"); grid = -1; return; }
        if (hipOccupancyMaxActiveBlocksPerMultiprocessor(&per_cu, (const void*)mk_fwd, NWAVES * 64, LDS_BYTES) != hipSuccess || per_cu < 1)
            fprintf(stderr, "kernel_launch: note: occupancy query reports %d workgroups per CU\n", per_cu);
        (void)hipGetLastError();
        grid = cus;
    }
    if (grid < 0) return;
    if (hipMemsetAsync((char*)d_ws + WS_CTL, 0, CTL_ZERO_BYTES, stream) != hipSuccess) { fprintf(stderr, "kernel_launch: hipMemsetAsync failed\n"); return; }
    Args a{};
    for (int i = 0; i < 30; ++i) a.in[i] = (const float*)d_in[i];
    a.out = (float*)d_out; a.ws = (unsigned char*)d_ws;
#if MK_ONE_LAUNCH
    a.ph_lo = 0; a.ph_hi = N_PHASES;
    hipLaunchKernelGGL(mk_fwd, dim3(grid), dim3(NWAVES * 64), LDS_BYTES, stream, a);
#else
    for (int ph = 0; ph < N_PHASES; ++ph) { a.ph_lo = ph; a.ph_hi = ph + 1; hipLaunchKernelGGL(mk_fwd, dim3(grid), dim3(NWAVES * 64), LDS_BYTES, stream, a); }
#endif
    const hipError_t le = hipPeekAtLastError();
    if (le != hipSuccess) fprintf(stderr, "kernel_launch: launch failed: %s\n", hipGetErrorName(le));
}
```
